# Optimizing an MI355X kernel written in HIP

```python
import math
import jax, jax.numpy as jnp
from jax import lax
import numpy as np

D_MODEL = 1024
BATCH = 8
SEQ = 2048
DEPTH = 2

CTX_LEN = 256
GRID_W = 64
N_BRANCH = 3
BRANCH_W = D_MODEL // 2
RET_HEADS = 4
RET_DK = BRANCH_W // RET_HEADS
DIFF_HEADS = 4
DIFF_DV = BRANCH_W // DIFF_HEADS
DIFF_DQK = DIFF_DV // 2
MLP_GROUPS = 4
MLP_GW = BRANCH_W // MLP_GROUPS
CHUNK = 128
RET_CHUNK = 128
Q_BLOCK = 128
ROPE_BASE = 10000.0
EPS = 1e-6
KV_SIZES = (BRANCH_W, BRANCH_W, BRANCH_W, BRANCH_W)
REST_SIZES = (BRANCH_W,) * 7 + (N_BRANCH * D_MODEL,)
IN_SIZES = KV_SIZES + REST_SIZES
KV_COLS = 4 * BRANCH_W
IN_COLS = KV_COLS + 7 * BRANCH_W + N_BRANCH * D_MODEL

kernel_name = "hybrid_retention_gmlp_diffattn_prefix_dit"


def rms_norm(x, g=None):
    xf = x.astype(jnp.float32)
    y = xf * lax.rsqrt(jnp.mean(xf * xf, axis=-1, keepdims=True) + EPS)
    if g is not None:
        y = y * g.astype(jnp.float32)
    return y.astype(x.dtype)


def layer_norm(x):
    xf = x.astype(jnp.float32)
    mu = jnp.mean(xf, axis=-1, keepdims=True)
    var = jnp.mean(jnp.square(xf - mu), axis=-1, keepdims=True)
    return ((xf - mu) * lax.rsqrt(var + EPS)).astype(x.dtype)


def modulate(x, g, shift, scale):
    return rms_norm(x, g) * (1.0 + scale) + shift


def split_cols(z, sizes):
    idx = np.cumsum(sizes)[:-1].tolist()
    return jnp.split(z, idx, axis=-1)


def to_heads(t, n_heads):
    b, n, w = t.shape
    return t.reshape(b, n, n_heads, w // n_heads).transpose(0, 2, 1, 3)


def to_diff_heads(t):
    b, n, _ = t.shape
    return t.reshape(b, n, DIFF_HEADS, 2, DIFF_DQK).transpose(0, 2, 3, 1, 4)


def from_heads(t):
    b, h, n, d = t.shape
    return t.transpose(0, 2, 1, 3).reshape(b, n, h * d)


def rope_angles(row_pos, col_pos, head_dim):
    n_freq = head_dim // 4
    inv = ROPE_BASE ** (-jnp.arange(n_freq, dtype=jnp.float32) / n_freq)
    ang = jnp.concatenate([row_pos[:, None] * inv, col_pos[:, None] * inv], axis=-1)
    return jnp.cos(ang), jnp.sin(ang)


def apply_rope(x, cos, sin):
    x1, x2 = jnp.split(x, 2, axis=-1)
    cos = cos.astype(x.dtype)
    sin = sin.astype(x.dtype)
    return jnp.concatenate([x1 * cos - x2 * sin, x1 * sin + x2 * cos], axis=-1)


def retention_chunkwise(q, k, v, log_gamma, state0):
    in_dtype = q.dtype
    q, k, v = q.astype(jnp.float32), k.astype(jnp.float32), v.astype(jnp.float32)
    b, h, n, dk = q.shape
    dv = v.shape[-1]
    nc = n // RET_CHUNK
    qc = q.reshape(b, h, nc, RET_CHUNK, dk)
    kc = k.reshape(b, h, nc, RET_CHUNK, dk)
    vc = v.reshape(b, h, nc, RET_CHUNK, dv)
    pos = jnp.arange(RET_CHUNK, dtype=jnp.float32)
    lg = log_gamma.astype(jnp.float32)[:, None]
    dist = pos[:, None] - pos[None, :]
    d_in = jnp.where(dist >= 0, jnp.exp(lg[:, :, None] * jnp.maximum(dist, 0.0)), 0.0)
    q_dec = jnp.exp(lg * (pos + 1.0))
    k_dec = jnp.exp(lg * (RET_CHUNK - 1.0 - pos))
    chunk_dec = jnp.exp(lg[:, 0] * RET_CHUNK)
    s = jnp.einsum('bhnid,bhnjd->bhnij', qc, kc) * d_in[None, :, None]
    inner = jnp.einsum('bhnij,bhnje->bhnie', s, vc)
    kv = jnp.einsum('bhnjd,hj,bhnje->bhnde', kc, k_dec, vc)

    def step(state, kv_n):
        return chunk_dec[None, :, None, None] * state + kv_n, state

    final, prev = lax.scan(step, state0.astype(jnp.float32), jnp.moveaxis(kv, 2, 0))
    prev = jnp.moveaxis(prev, 0, 2)
    cross = jnp.einsum('bhnid,hi,bhnde->bhnie', qc, q_dec, prev)
    out = (inner + cross).reshape(b, h, n, dv)
    return out.astype(in_dtype), final


def retention_final_state(k, v, log_gamma):
    n = k.shape[2]
    w = jnp.exp(log_gamma[:, None] * (n - 1.0 - jnp.arange(n, dtype=jnp.float32)))
    return jnp.einsum('bhjd,hj,bhje->bhde', k.astype(jnp.float32), w, v.astype(jnp.float32))


def bidir_retention(q, k, v, log_gamma, state_f, state_b):
    out_f, fin_f = retention_chunkwise(q, k, v, log_gamma[0], state_f)
    out_b, fin_b = retention_chunkwise(jnp.flip(q, 2), jnp.flip(k, 2), jnp.flip(v, 2), log_gamma[1], state_b)
    return out_f + jnp.flip(out_b, 2), fin_f, fin_b


def diff_attend(q, k, v, lam):
    s = jnp.einsum('bhmqd,bhmkd->bhmqk', q.astype(jnp.float32), k.astype(jnp.float32)) * (DIFF_DQK ** -0.5)
    p = jax.nn.softmax(s, axis=-1)
    a = p[:, :, 0] - lam * p[:, :, 1]
    return jnp.einsum('bhqk,bhkv->bhqv', a, v.astype(jnp.float32)).astype(v.dtype)


def diff_attend_blocked(q, k, v, lam):
    b, h, _, n, d = q.shape
    nb = n // Q_BLOCK
    qb = jnp.moveaxis(q.reshape(b, h, 2, nb, Q_BLOCK, d), 3, 0)
    o = lax.map(lambda blk: diff_attend(blk, k, v, lam), qb)
    return jnp.moveaxis(o, 0, 2).reshape(b, h, n, -1)


def chunk_mlp(u, v, gate, w_s, b_s):
    b, n, _ = u.shape
    nch = n // CHUNK
    vn = layer_norm(v).reshape(b, nch, CHUNK, MLP_GROUPS, MLP_GW)
    sp = jnp.einsum('gij,bnjgc->bnigc', w_s, vn) + b_s.T[:, :, None]
    return u * sp.reshape(b, n, BRANCH_W) * jax.nn.silu(gate)


def merge_branches(o_ret, o_mlp, o_diff, merge_logits, w_bo, w_o):
    g_ret, g_mlp, g_diff = jnp.split(jax.nn.sigmoid(merge_logits), N_BRANCH, axis=-1)
    y = g_ret * (o_ret @ w_bo[0]) + g_mlp * (o_mlp @ w_bo[1]) + g_diff * (o_diff @ w_bo[2])
    return y @ w_o


def setup_inputs(seed: int = 0) -> dict:
    key = jax.random.key(seed)
    ks = jax.random.split(key, 16)
    f32 = jnp.float32
    nrm = jax.random.normal
    x = nrm(ks[0], (BATCH, SEQ, D_MODEL), f32)
    c = nrm(ks[1], (BATCH, D_MODEL), f32)
    ctx = nrm(ks[2], (BATCH, CTX_LEN, D_MODEL), f32)
    c_ctx = nrm(ks[3], (D_MODEL,), f32)
    w_mod = nrm(ks[4], (DEPTH, D_MODEL, 3 * D_MODEL), f32) * (0.5 * D_MODEL ** -0.5)
    b_mod = 0.02 * nrm(ks[5], (DEPTH, 3 * D_MODEL), f32)
    g_pre = 1.0 + 0.05 * nrm(ks[6], (DEPTH, D_MODEL), f32)
    g_post = 1.0 + 0.05 * nrm(ks[7], (DEPTH, D_MODEL), f32)
    w_in = nrm(ks[8], (DEPTH, D_MODEL, IN_COLS), f32) * (D_MODEL ** -0.5)
    base = jnp.log(2.0 ** (5.0 + jnp.arange(RET_HEADS, dtype=f32)) - 1.0)
    ret_decay_logit = base[None, None, :] + 0.1 * nrm(ks[9], (DEPTH, 2, RET_HEADS), f32)
    mlp_w_s = nrm(ks[10], (DEPTH, MLP_GROUPS, CHUNK, CHUNK), f32) * (CHUNK ** -0.5)
    mlp_b_s = 1.0 + 0.1 * nrm(ks[11], (DEPTH, MLP_GROUPS, CHUNK), f32)
    diff_lambda_q = 0.1 * nrm(ks[12], (DEPTH, 2, DIFF_DQK), f32)
    diff_lambda_k = 0.1 * nrm(ks[13], (DEPTH, 2, DIFF_DQK), f32)
    w_branch_out = nrm(ks[14], (DEPTH, N_BRANCH, BRANCH_W, D_MODEL), f32) * (BRANCH_W ** -0.5)
    w_out = nrm(ks[15], (DEPTH, D_MODEL, D_MODEL), f32) * (D_MODEL ** -0.5)
    return {"x": x, "c": c, "ctx": ctx, "c_ctx": c_ctx, "w_mod": w_mod, "b_mod": b_mod,
            "g_pre": g_pre, "g_post": g_post, "w_in": w_in, "ret_decay_logit": ret_decay_logit,
            "mlp_w_s": mlp_w_s, "mlp_b_s": mlp_b_s, "diff_lambda_q": diff_lambda_q,
            "diff_lambda_k": diff_lambda_k, "w_branch_out": w_branch_out, "w_out": w_out}


def reference(x, c, ctx, c_ctx, w_mod, b_mod, g_pre, g_post, w_in, ret_decay_logit,
              mlp_w_s, mlp_b_s, diff_lambda_q, diff_lambda_k, w_branch_out, w_out):
    b = x.shape[0]
    n_lat = x.shape[1]
    rows = n_lat // GRID_W
    row_pos = jnp.repeat(jnp.arange(rows, dtype=jnp.float32), GRID_W)
    col_pos = jnp.tile(jnp.arange(GRID_W, dtype=jnp.float32), rows)
    cos_r, sin_r = rope_angles(row_pos, col_pos, RET_DK)
    cos_d, sin_d = rope_angles(row_pos, col_pos, DIFF_DQK)
    silu_c = jax.nn.silu(c)
    silu_cc = jax.nn.silu(c_ctx)
    ret_scale = RET_DK ** -0.5

    for l in range(DEPTH):
        last = l == DEPTH - 1
        shift, scale, gate = jnp.split((silu_c @ w_mod[l] + b_mod[l])[:, None, :], 3, axis=-1)
        shift_c, scale_c, gate_c = jnp.split(silu_cc @ w_mod[l] + b_mod[l], 3, axis=-1)
        h = modulate(x, g_pre[l], shift, scale)
        hc = modulate(ctx, g_pre[l], shift_c, scale_c)
        log_gamma = -jax.nn.softplus(-ret_decay_logit[l].astype(jnp.float32))
        lam_init = 0.8 - 0.6 * math.exp(-0.3 * l)
        lam = (jnp.exp(jnp.sum(diff_lambda_q[l, 0] * diff_lambda_k[l, 0]))
               - jnp.exp(jnp.sum(diff_lambda_q[l, 1] * diff_lambda_k[l, 1])) + lam_init).astype(jnp.float32)

        if last:
            c_rk, c_rv, c_dk, c_dv = split_cols(hc @ w_in[l][:, :KV_COLS], KV_SIZES)
        else:
            zc = split_cols(hc @ w_in[l], IN_SIZES)
            c_rk, c_rv, c_dk, c_dv = zc[:4]
        crk = to_heads(c_rk, RET_HEADS) * ret_scale
        crv = to_heads(c_rv, RET_HEADS)
        cdk = to_diff_heads(c_dk)
        cdv = to_heads(c_dv, DIFF_HEADS)
        if last:
            s_f = retention_final_state(crk, crv, log_gamma[0])
            s_b = retention_final_state(jnp.flip(crk, 2), jnp.flip(crv, 2), log_gamma[1])
        else:
            c_rq, c_rg, c_dq, c_dg, c_mu, c_mv, c_mg, c_mlog = zc[4:]
            zero = jnp.zeros((b, RET_HEADS, RET_DK, RET_DK), jnp.float32)
            c_ret, s_f, s_b = bidir_retention(to_heads(c_rq, RET_HEADS), crk, crv, log_gamma, zero, zero)
            co_ret = from_heads(rms_norm(c_ret)) * jax.nn.silu(c_rg)
            c_diff = diff_attend(to_diff_heads(c_dq), cdk, cdv, lam)
            co_diff = from_heads(rms_norm(c_diff) * (1.0 - lam_init)) * jax.nn.silu(c_dg)
            co_mlp = chunk_mlp(c_mu, c_mv, c_mg, mlp_w_s[l], mlp_b_s[l])
            c_out = merge_branches(co_ret, co_mlp, co_diff, c_mlog, w_branch_out[l], w_out[l])
            ctx_next = ctx + gate_c * rms_norm(c_out, g_post[l])

        rk_, rv_, dk_, dv_, rq_, rg_, dq_, dg_, mu_, mv_, mg_, mlog_ = split_cols(h @ w_in[l], IN_SIZES)
        rq = apply_rope(to_heads(rq_, RET_HEADS), cos_r, sin_r)
        rk = apply_rope(to_heads(rk_, RET_HEADS), cos_r, sin_r) * ret_scale
        rv = to_heads(rv_, RET_HEADS)
        ret_o, _, _ = bidir_retention(rq, rk, rv, log_gamma, s_f, s_b)
        o_ret = from_heads(rms_norm(ret_o)) * jax.nn.silu(rg_)

        dq = apply_rope(to_diff_heads(dq_), cos_d, sin_d)
        dk = apply_rope(to_diff_heads(dk_), cos_d, sin_d)
        dv = to_heads(dv_, DIFF_HEADS)
        k_all = jnp.concatenate([cdk, dk], axis=3)
        v_all = jnp.concatenate([cdv, dv], axis=2)
        diff_o = diff_attend_blocked(dq, k_all, v_all, lam)
        o_diff = from_heads(rms_norm(diff_o) * (1.0 - lam_init)) * jax.nn.silu(dg_)

        o_mlp = chunk_mlp(mu_, mv_, mg_, mlp_w_s[l], mlp_b_s[l])
        out = merge_branches(o_ret, o_mlp, o_diff, mlog_, w_branch_out[l], w_out[l])
        x = x + gate * rms_norm(out, g_post[l])
        if not last:
            ctx = ctx_next
    return x
```

```cpp
#include <hip/hip_runtime.h>
#include <cstdio>
#include <cstdint>

#define DI __device__ __forceinline__
#define LAS __attribute__((address_space(3)))
typedef unsigned short bf16_t;
typedef short bf16x8 __attribute__((ext_vector_type(8)));
typedef float f32x16 __attribute__((ext_vector_type(16)));
typedef float f32x4 __attribute__((ext_vector_type(4)));
typedef float f32x2 __attribute__((ext_vector_type(2)));
typedef unsigned u32x4 __attribute__((ext_vector_type(4)));
typedef unsigned u32x2 __attribute__((ext_vector_type(2)));
#define MFMA(a, b, c) __builtin_amdgcn_mfma_f32_32x32x16_bf16((a), (b), (c), 0, 0, 0)

#define XB_TMO      128
#define XB_XCNT(j)  (256  + 64 * (j))
#define XB_XSUB(j)  (1280 + 64 * (j))
#define XB_XGEN(j)  (2304 + 64 * (j))
#define XB_TOP      3328
#define XB_TOPGEN   3392
#define XCD_BAR_WORDS 3456
#define XB_SPIN_CAP (1u << 22)
DI unsigned xb_ld(unsigned* p)              { return __hip_atomic_load(p, __ATOMIC_RELAXED, __HIP_MEMORY_SCOPE_AGENT); }
DI unsigned xb_add(unsigned* p, unsigned v) { return __hip_atomic_fetch_add(p, v, __ATOMIC_RELAXED, __HIP_MEMORY_SCOPE_AGENT); }
DI unsigned xb_xcc_id() { return (unsigned)__builtin_amdgcn_s_getreg((3 << 11) | 20) & 0xFu; }
#define XB_SPIN(cond, bar) do { unsigned _sp = 0; while (cond) { __builtin_amdgcn_s_sleep(1); \
    if ((++_sp & 255u) == 0u) { if (xb_ld(&(bar)[XB_TMO])) break; if (_sp > XB_SPIN_CAP) { atomicAdd(&(bar)[XB_TMO], 1u); break; } } } } while (0)
struct XcdBarrier { unsigned* bar; unsigned x; volatile LAS unsigned* st; };
DI XcdBarrier xcd_barrier_post(unsigned* bar, volatile LAS unsigned* st) {
    XcdBarrier b; b.bar = bar; b.x = xb_xcc_id(); b.st = st;
    if (threadIdx.x == 0) (void)xb_add(&bar[XB_XCNT(b.x)], 1u);
    return b;
}
DI void xcd_barrier_complete(unsigned* bar, unsigned x, unsigned& nloc, unsigned& nx) {
    const unsigned G = gridDim.x * gridDim.y * gridDim.z;
    unsigned sum, cnt, mine, sp = 0u;
    for (;;) {
        sum = 0u; cnt = 0u; mine = 0u;
#pragma unroll
        for (unsigned j = 0; j < 16; ++j) { const unsigned c = xb_ld(&bar[XB_XCNT(j)]); sum += c; cnt += (c > 0u) ? 1u : 0u; mine = (j == x) ? c : mine; }
        if (sum == G) break;
        __builtin_amdgcn_s_sleep(1);
        if ((++sp & 255u) == 0u) { if (xb_ld(&bar[XB_TMO])) break; if (sp > XB_SPIN_CAP) { atomicAdd(&bar[XB_TMO], 1u); break; } }
    }
    nloc = mine > 0u ? mine : 1u; nx = cnt > 0u ? cnt : 1u;
}
DI void xcd_barrier(const XcdBarrier& b) {
    asm volatile("s_waitcnt vmcnt(0)" ::: "memory");
    __syncthreads();
    if (threadIdx.x == 0) {
        unsigned* bar = b.bar;
        __builtin_amdgcn_s_waitcnt(0);
        unsigned nloc = b.st[0], nx = b.st[1];
        if (nloc == 0u) { xcd_barrier_complete(bar, b.x, nloc, nx); b.st[0] = nloc; b.st[1] = nx; }
        const unsigned old = xb_add(&bar[XB_XSUB(b.x)], 1u);
        const unsigned gen = old / nloc;
        if (old + 1u == (gen + 1u) * nloc) {
            __builtin_amdgcn_fence(__ATOMIC_RELEASE, "agent");
            asm volatile("s_waitcnt vmcnt(0)" ::: "memory");
            const unsigned og = xb_add(&bar[XB_TOP], 1u);
            const unsigned tg = og / nx;
            if (og + 1u == (tg + 1u) * nx) xb_add(&bar[XB_TOPGEN], 1u);
            else XB_SPIN(xb_ld(&bar[XB_TOPGEN]) == tg, bar);
            __builtin_amdgcn_fence(__ATOMIC_ACQUIRE, "agent");
            xb_add(&bar[XB_XGEN(b.x)], 1u);
            asm volatile("s_waitcnt vmcnt(0)" ::: "memory");
        } else {
            XB_SPIN(xb_ld(&bar[XB_XGEN(b.x)]) == gen, bar);
            __builtin_amdgcn_fence(__ATOMIC_ACQUIRE, "agent");
            asm volatile("s_waitcnt vmcnt(0)" ::: "memory");
        }
    }
    __syncthreads();
}

constexpr int DM = 1024, SEQL = 2048, CTXL = 256, PP = 2304  ;
constexpr int NBG = 4  , NGRP = 2, NT = NBG * PP  ;
constexpr int INC = 8704, NCH = 18  ;
constexpr float EPS = 1e-6f;
constexpr float LOG2E = 1.4426950408889634f;

constexpr size_t TB = (size_t)NT * 512 * 2;
constexpr size_t OFF_BAR = 0;
constexpr size_t OFF_MOD = 16384;
constexpr size_t OFF_WIN = OFF_MOD + 262144;
constexpr size_t OFF_WBO = OFF_WIN + (size_t)2 * INC * 1024 * 2;
constexpr size_t OFF_WO  = OFF_WBO + (size_t)2 * 3 * 1024 * 512 * 2;
constexpr size_t OFF_H   = OFF_WO + (size_t)2 * 1024 * 1024 * 2;
constexpr size_t OFF_RK  = OFF_H + 2 * TB;
constexpr size_t OFF_RKT = OFF_RK + TB;
constexpr size_t OFF_RVT = OFF_RKT + TB;
constexpr size_t OFF_DK  = OFF_RVT + TB;
constexpr size_t OFF_DVT = OFF_DK + TB;
constexpr size_t OFF_RQ  = OFF_DVT + TB;
constexpr size_t OFF_RG  = OFF_RQ + TB;
constexpr size_t OFF_DQ  = OFF_RG + TB;
constexpr size_t OFF_DG  = OFF_DQ + TB;
constexpr size_t OFF_MU  = OFF_DG + TB;
constexpr size_t OFF_MV  = OFF_MU + TB;
constexpr size_t OFF_MG  = OFF_MV + TB;
constexpr size_t OFF_MLOG = OFF_MG + TB;
constexpr size_t OFF_OMLP = OFF_MLOG + 6 * TB;
constexpr size_t OFF_ODIFF = OFF_OMLP + TB;
constexpr size_t WS_END = OFF_ODIFF + TB;
constexpr size_t OFF_ST = OFF_H;
constexpr size_t OFF_ORET = OFF_DK;
constexpr size_t OFF_Y = OFF_RK;
constexpr size_t OFF_OUT = OFF_MLOG;

struct Params {
    const float* in[16];
    float* out;
    unsigned char* ws;
};

struct Ctx {
    const float *x, *c, *ctx, *c_ctx, *w_mod, *b_mod, *g_pre, *g_post, *w_in, *decay, *w_s, *b_s, *lq, *lk, *w_bo, *w_out;
    float* out;
    unsigned char* ws;
    unsigned char* smem;
    const float* cst;
    int tid, lane, w, l31, hl;
};

DI unsigned pk2(float lo, float hi) {
    typedef __bf16 b2 __attribute__((ext_vector_type(2)));
    f32x2 v = {lo, hi};
    b2 r = __builtin_convertvector(v, b2);
    return __builtin_bit_cast(unsigned, r);
}
DI bf16_t f2bf(float x) { return (bf16_t)(pk2(x, 0.f) & 0xffffu); }
DI float bflo(unsigned u) { return __uint_as_float(u << 16); }
DI float bfhi(unsigned u) { return __uint_as_float(u & 0xffff0000u); }
DI int crow(int r, int hl) { return (r & 3) + 8 * (r >> 2) + 4 * hl; }
DI float wave_sum(float v) {
#pragma unroll
    for (int o = 1; o < 64; o <<= 1) v += __shfl_xor(v, o);
    return v;
}
DI float silu_f(float x) { return x / (1.f + __expf(-x)); }
DI float sigmoid_f(float x) { return 1.f / (1.f + __expf(-x)); }

DI void gemm_core(const Ctx& c, const bf16_t* __restrict__ Wt, int ldw, const bf16_t* __restrict__ Act, int lda, int K, f32x16 (&acc)[2][2]) {
    bf16_t* Ws = (bf16_t*)c.smem;
    bf16_t* As = Ws + 128 * 72;
    const int wn = c.w >> 1, wm = c.w & 1;
    const int lrow = c.tid >> 3, lseg = c.tid & 7;
    u32x4 rw[4], ra[4];
#pragma unroll
    for (int it = 0; it < 4; ++it) {
        rw[it] = *(const u32x4*)(Wt + (size_t)(lrow + 32 * it) * ldw + lseg * 8);
        ra[it] = *(const u32x4*)(Act + (size_t)(lrow + 32 * it) * lda + lseg * 8);
    }
    for (int k0 = 0; k0 < K; k0 += 64) {
        __syncthreads();
#pragma unroll
        for (int it = 0; it < 4; ++it) {
            *(u32x4*)(Ws + (lrow + 32 * it) * 72 + lseg * 8) = rw[it];
            *(u32x4*)(As + (lrow + 32 * it) * 72 + lseg * 8) = ra[it];
        }
        __syncthreads();
        if (k0 + 64 < K) {
#pragma unroll
            for (int it = 0; it < 4; ++it) {
                rw[it] = *(const u32x4*)(Wt + (size_t)(lrow + 32 * it) * ldw + k0 + 64 + lseg * 8);
                ra[it] = *(const u32x4*)(Act + (size_t)(lrow + 32 * it) * lda + k0 + 64 + lseg * 8);
            }
        }
#pragma unroll
        for (int ks = 0; ks < 4; ++ks) {
            const bf16x8 a0 = *(const bf16x8*)(Ws + (wn * 64 + c.l31) * 72 + ks * 16 + c.hl * 8);
            const bf16x8 a1 = *(const bf16x8*)(Ws + (wn * 64 + 32 + c.l31) * 72 + ks * 16 + c.hl * 8);
            const bf16x8 b0 = *(const bf16x8*)(As + (wm * 64 + c.l31) * 72 + ks * 16 + c.hl * 8);
            const bf16x8 b1 = *(const bf16x8*)(As + (wm * 64 + 32 + c.l31) * 72 + ks * 16 + c.hl * 8);
            acc[0][0] = MFMA(a0, b0, acc[0][0]);
            acc[0][1] = MFMA(a0, b1, acc[0][1]);
            acc[1][0] = MFMA(a1, b0, acc[1][0]);
            acc[1][1] = MFMA(a1, b1, acc[1][1]);
        }
    }
}
DI void zero_acc(f32x16 (&acc)[2][2]) {
#pragma unroll
    for (int i = 0; i < 2; ++i)
#pragma unroll
        for (int j = 0; j < 2; ++j)
#pragma unroll
            for (int r = 0; r < 16; ++r) acc[i][j][r] = 0.f;
}

DI void transpose_item(const Ctx& c, const float* __restrict__ src, int N, int k0, int n0, int mapk, bf16_t* __restrict__ dst, int ldk) {
    float* T = (float*)c.smem;
    __syncthreads();
#pragma unroll
    for (int it = 0; it < 8; ++it) {
        const int idx = c.tid + 256 * it, r = idx >> 5, c4 = idx & 31;
        const f32x4 v = *(const f32x4*)(src + (size_t)(k0 + r) * N + n0 + c4 * 4);
        float* t = T + r * 129 + c4 * 4;
        t[0] = v[0]; t[1] = v[1]; t[2] = v[2]; t[3] = v[3];
    }
    __syncthreads();
#pragma unroll
    for (int it = 0; it < 4; ++it) {
        const int idx = c.tid + 256 * it, np = idx >> 3, ch = idx & 7;
        int cs = np;
        if (mapk == 1) cs = (np >> 1) + 64 * (np & 1);
        else if (mapk == 2) { const int r = np & 63; cs = (np & 64) + (r >> 1) + 32 * (r & 1); }
        const float* t = T + (ch * 8) * 129 + cs;
        u32x4 o;
        o[0] = pk2(t[0], t[129]); o[1] = pk2(t[2 * 129], t[3 * 129]); o[2] = pk2(t[4 * 129], t[5 * 129]); o[3] = pk2(t[6 * 129], t[7 * 129]);
        *(u32x4*)(dst + (size_t)(n0 + np) * ldk + k0 + ch * 8) = o;
    }
}
DI void mod_item(const Ctx& c, int l, int jb) {
    float* sv = (float*)c.smem;
    float* red = sv + 9 * 1024;
    __syncthreads();
    for (int idx = c.tid; idx < 9216; idx += 256) {
        const int v = idx >> 10, k = idx & 1023;
        const float x = v < 8 ? c.c[v * 1024 + k] : c.c_ctx[k];
        sv[idx] = x / (1.f + expf(-x));
    }
    __syncthreads();
    const int kk = c.tid >> 5, jj = c.tid & 31, j = jb * 32 + jj;
    float a[9];
#pragma unroll
    for (int v = 0; v < 9; ++v) a[v] = 0.f;
    const float* wp = c.w_mod + (size_t)l * 1024 * 3072 + j;
#pragma unroll 4
    for (int i = 0; i < 128; ++i) {
        const int k = kk + 8 * i;
        const float wv = wp[(size_t)k * 3072];
#pragma unroll
        for (int v = 0; v < 9; ++v) a[v] += sv[v * 1024 + k] * wv;
    }
#pragma unroll
    for (int v = 0; v < 9; ++v) red[(kk * 9 + v) * 32 + jj] = a[v];
    __syncthreads();
    float* MOD = (float*)(c.ws + OFF_MOD);
    for (int idx = c.tid; idx < 288; idx += 256) {
        const int v = idx >> 5, j2 = idx & 31;
        float s = 0.f;
#pragma unroll
        for (int k2 = 0; k2 < 8; ++k2) s += red[(k2 * 9 + v) * 32 + j2];
        MOD[(size_t)(l * 9 + v) * 3072 + jb * 32 + j2] = s + c.b_mod[l * 3072 + jb * 32 + j2];
    }
}
DI void p0_item(const Ctx& c, int it) {
    if (it < 2 * 1408) {
        const int l = it / 1408; int r = it % 1408;
        if (r < 1088) {
            const int ct = r % 68, kb = r / 68;
            const int kind = ct >> 2;
            const int mapk = (kind == 0 || kind == 4) ? 1 : ((kind == 2 || kind == 6) ? 2 : 0);
            transpose_item(c, c.w_in + (size_t)l * 1024 * INC, INC, kb * 64, ct * 128, mapk, (bf16_t*)(c.ws + OFF_WIN) + (size_t)l * INC * 1024, 1024);
            return;
        }
        r -= 1088;
        if (r < 192) {
            const int br = r / 64, q = r % 64, kb = q >> 3, nb = q & 7;
            transpose_item(c, c.w_bo + (size_t)(l * 3 + br) * 512 * 1024, 1024, kb * 64, nb * 128, 0,
                           (bf16_t*)(c.ws + OFF_WBO) + (size_t)(l * 3 + br) * 1024 * 512, 512);
            return;
        }
        r -= 192;
        { const int kb = r >> 3, nb = r & 7;
          transpose_item(c, c.w_out + (size_t)l * 1024 * 1024, 1024, kb * 64, nb * 128, 0, (bf16_t*)(c.ws + OFF_WO) + (size_t)l * 1024 * 1024, 1024); }
        return;
    }
    it -= 2 * 1408;
    mod_item(c, it / 96, it % 96);
}

DI void modulate_row(const f32x4 (&x)[4], const float* gpre, const float* mod  , bf16_t* hrow, int lane) {
    float ss = 0.f;
#pragma unroll
    for (int j = 0; j < 4; ++j) ss += x[j][0] * x[j][0] + x[j][1] * x[j][1] + x[j][2] * x[j][2] + x[j][3] * x[j][3];
    ss = wave_sum(ss);
    const float r = rsqrtf(ss * (1.f / 1024.f) + EPS);
#pragma unroll
    for (int j = 0; j < 4; ++j) {
        const int col = lane * 4 + 256 * j;
        const f32x4 g = *(const f32x4*)(gpre + col), sh = *(const f32x4*)(mod + col), sc = *(const f32x4*)(mod + 1024 + col);
        f32x4 h;
#pragma unroll
        for (int e = 0; e < 4; ++e) h[e] = x[j][e] * r * g[e] * (1.f + sc[e]) + sh[e];
        u32x2 o; o[0] = pk2(h[0], h[1]); o[1] = pk2(h[2], h[3]);
        *(u32x2*)(hrow + col) = o;
    }
}
DI void ph_item(const Ctx& c, int g, int item) {
    const int tok = item * 4 + c.w, bl = tok / PP, p = tok % PP, b = g * NBG + bl;
    const float* src = p < CTXL ? c.ctx + ((size_t)b * CTXL + p) * DM : c.x + ((size_t)b * SEQL + (p - CTXL)) * DM;
    f32x4 x[4];
#pragma unroll
    for (int j = 0; j < 4; ++j) x[j] = *(const f32x4*)(src + c.lane * 4 + 256 * j);
    const float* mod = (const float*)(c.ws + OFF_MOD) + (size_t)(0 * 9 + (p < CTXL ? 8 : b)) * 3072;
    modulate_row(x, c.g_pre, mod, (bf16_t*)(c.ws + OFF_H) + (size_t)tok * DM, c.lane);
}
DI void pr_item(const Ctx& c, int l, int g, int item) {
    const int tok = item * 4 + c.w, bl = tok / PP, p = tok % PP, b = g * NBG + bl;
    if (l == 1 && p < CTXL) return;
    const float* orow = (const float*)(c.ws + OFF_OUT) + (size_t)tok * DM;
    const int v = p < CTXL ? 8 : b;
    const float* mod = (const float*)(c.ws + OFF_MOD) + (size_t)(l * 9 + v) * 3072;
    float* xo_lat = c.out + ((size_t)b * SEQL + (p - CTXL)) * DM;
    const float* xold = p < CTXL ? c.ctx + ((size_t)b * CTXL + p) * DM : (l == 0 ? c.x + ((size_t)b * SEQL + (p - CTXL)) * DM : xo_lat);
    f32x4 o[4]; float ss = 0.f;
#pragma unroll
    for (int j = 0; j < 4; ++j) { o[j] = *(const f32x4*)(orow + c.lane * 4 + 256 * j); ss += o[j][0] * o[j][0] + o[j][1] * o[j][1] + o[j][2] * o[j][2] + o[j][3] * o[j][3]; }
    ss = wave_sum(ss);
    const float r = rsqrtf(ss * (1.f / 1024.f) + EPS);
    f32x4 xn[4];
#pragma unroll
    for (int j = 0; j < 4; ++j) {
        const int col = c.lane * 4 + 256 * j;
        const f32x4 gp = *(const f32x4*)(c.g_post + l * 1024 + col), gt = *(const f32x4*)(mod + 2048 + col), xv = *(const f32x4*)(xold + col);
#pragma unroll
        for (int e = 0; e < 4; ++e) xn[j][e] = xv[e] + gt[e] * (o[j][e] * r * gp[e]);
        if (p >= CTXL) *(f32x4*)(xo_lat + col) = xn[j];
    }
    if (l == 0) {
        const float* mod1 = (const float*)(c.ws + OFF_MOD) + (size_t)(1 * 9 + v) * 3072;
        modulate_row(xn, c.g_pre + 1024, mod1, (bf16_t*)(c.ws + OFF_H) + (size_t)tok * DM, c.lane);
    }
}

DI void pz_item(const Ctx& c, int l, int rt, int ct) {
    f32x16 acc[2][2];
    zero_acc(acc);
    gemm_core(c, (const bf16_t*)(c.ws + OFF_WIN) + ((size_t)l * INC + (size_t)ct * 128) * 1024, 1024,
              (const bf16_t*)(c.ws + OFF_H) + (size_t)rt * 128 * 1024, 1024, 1024, acc);
    const int wn = c.w >> 1, wm = c.w & 1;
    const int bl = rt / NCH, pt = rt % NCH;
    const int kind = ct >> 2, h = ct & 3;
    constexpr float L2B = 13.287712379549449f;
#pragma unroll
    for (int j = 0; j < 2; ++j) {
        const int m = wm * 64 + j * 32 + c.l31;
        const int p = pt * 128 + m;
        const size_t tok = (size_t)rt * 128 + m;
        const bool latent = p >= CTXL;
        const int lp = p - CTXL;
        const float rowp = (float)(lp >> 6), colp = (float)(lp & 63);
#pragma unroll
        for (int i = 0; i < 2; ++i) {
#pragma unroll
            for (int q = 0; q < 4; ++q) {
                const int n0 = wn * 64 + i * 32 + 8 * q + 4 * c.hl;
                float v0 = acc[i][j][4 * q + 0], v1 = acc[i][j][4 * q + 1], v2 = acc[i][j][4 * q + 2], v3 = acc[i][j][4 * q + 3];
                if (kind == 0 || kind == 4 || kind == 2 || kind == 6) {
                    if (latent) {
                        int c0; float fsc; int nf;
                        if (kind == 0 || kind == 4) { c0 = n0 >> 1; nf = 32; fsc = L2B / 32.f; }
                        else { c0 = (n0 & 63) >> 1; nf = 16; fsc = L2B / 16.f; }
                        const int c1 = c0 + 1;
                        const float a0 = (c0 < nf ? rowp : colp) * exp2f(-(float)(c0 & (nf - 1)) * fsc);
                        const float a1 = (c1 < nf ? rowp : colp) * exp2f(-(float)(c1 & (nf - 1)) * fsc);
                        const float cs0 = __cosf(a0), sn0 = __sinf(a0), cs1 = __cosf(a1), sn1 = __sinf(a1);
                        const float t0 = v0 * cs0 - v1 * sn0, t1 = v0 * sn0 + v1 * cs0;
                        const float t2 = v2 * cs1 - v3 * sn1, t3 = v2 * sn1 + v3 * cs1;
                        v0 = t0; v1 = t1; v2 = t2; v3 = t3;
                    }
                    if (kind == 0) { const float s = 0.08838834764831845f; v0 *= s; v1 *= s; v2 *= s; v3 *= s; }
                    if (kind == 6) { const float s = 0.125f * LOG2E; v0 *= s; v1 *= s; v2 *= s; v3 *= s; }
                } else if (kind == 5 || kind == 7 || kind == 10) {
                    v0 = silu_f(v0); v1 = silu_f(v1); v2 = silu_f(v2); v3 = silu_f(v3);
                } else if (kind >= 11) {
                    v0 = sigmoid_f(v0); v1 = sigmoid_f(v1); v2 = sigmoid_f(v2); v3 = sigmoid_f(v3);
                }
                if (kind >= 11) {
                    u32x2 o; o[0] = pk2(v0, v1); o[1] = pk2(v2, v3);
                    *(u32x2*)((bf16_t*)(c.ws + OFF_MLOG) + tok * 3072 + (size_t)(ct - 44) * 128 + n0) = o;
                } else {
                    if (kind == 0 || kind == 1 || kind == 3) {
                        const size_t off = kind == 0 ? OFF_RKT : (kind == 1 ? OFF_RVT : OFF_DVT);
                        bf16_t* tp = (bf16_t*)(c.ws + off) + ((size_t)(bl * 4 + h) * 128 + n0) * PP + p;
                        tp[0] = f2bf(v0); tp[PP] = f2bf(v1); tp[2 * PP] = f2bf(v2); tp[3 * PP] = f2bf(v3);
                    }
                    if (kind != 1 && kind != 3) {
                        size_t off;
                        switch (kind) { case 0: off = OFF_RK; break; case 2: off = OFF_DK; break; case 4: off = OFF_RQ; break; case 5: off = OFF_RG; break;
                                        case 6: off = OFF_DQ; break; case 7: off = OFF_DG; break; case 8: off = OFF_MU; break; case 9: off = OFF_MV; break; default: off = OFF_MG; break; }
                        u32x2 o; o[0] = pk2(v0, v1); o[1] = pk2(v2, v3);
                        *(u32x2*)((bf16_t*)(c.ws + off) + tok * 512 + h * 128 + n0) = o;
                    }
                }
            }
        }
    }
}

DI void attn_item(const Ctx& c, int l, int bl, int h, int q0, int nk) {
    bf16_t* Ks = (bf16_t*)c.smem;
    bf16_t* Vs = Ks + 64 * 136;
    const int mp = c.w >> 1, qs = c.w & 1;
    const int qpos = q0 + qs * 32 + c.l31;
    const size_t qtok = (size_t)bl * PP + qpos;
    const bf16_t* DQ = (const bf16_t*)(c.ws + OFF_DQ);
    const bf16_t* DK = (const bf16_t*)(c.ws + OFF_DK) + (size_t)bl * PP * 512 + h * 128;
    const bf16_t* DVT = (const bf16_t*)(c.ws + OFF_DVT) + (size_t)(bl * 4 + h) * 128 * PP;
    bf16x8 qf[4];
#pragma unroll
    for (int ks = 0; ks < 4; ++ks) qf[ks] = *(const bf16x8*)(DQ + qtok * 512 + h * 128 + mp * 64 + ks * 16 + c.hl * 8);
    f32x16 o[4];
#pragma unroll
    for (int et = 0; et < 4; ++et)
#pragma unroll
        for (int r = 0; r < 16; ++r) o[et][r] = 0.f;
    float mrun = -1e30f, lrun = 0.f;
    u32x4 rk[4], rv[4];
#pragma unroll
    for (int it = 0; it < 4; ++it) {
        const int idx = c.tid + 256 * it;
        rk[it] = *(const u32x4*)(DK + (size_t)(idx >> 4) * 512 + (idx & 15) * 8);
        rv[it] = *(const u32x4*)(DVT + (size_t)(idx >> 3) * PP + (idx & 7) * 8);
    }
    for (int kt0 = 0; kt0 < nk; kt0 += 64) {
        __syncthreads();
#pragma unroll
        for (int it = 0; it < 4; ++it) {
            const int idx = c.tid + 256 * it;
            *(u32x4*)(Ks + (idx >> 4) * 136 + (idx & 15) * 8) = rk[it];
            *(u32x4*)(Vs + (idx >> 3) * 72 + (idx & 7) * 8) = rv[it];
        }
        __syncthreads();
        if (kt0 + 64 < nk) {
#pragma unroll
            for (int it = 0; it < 4; ++it) {
                const int idx = c.tid + 256 * it;
                rk[it] = *(const u32x4*)(DK + (size_t)(kt0 + 64 + (idx >> 4)) * 512 + (idx & 15) * 8);
                rv[it] = *(const u32x4*)(DVT + (size_t)(idx >> 3) * PP + kt0 + 64 + (idx & 7) * 8);
            }
        }
        f32x16 s[2];
#pragma unroll
        for (int kt = 0; kt < 2; ++kt) {
#pragma unroll
            for (int r = 0; r < 16; ++r) s[kt][r] = 0.f;
#pragma unroll
            for (int ks = 0; ks < 4; ++ks) {
                const bf16x8 a = *(const bf16x8*)(Ks + (kt * 32 + c.l31) * 136 + mp * 64 + ks * 16 + c.hl * 8);
                s[kt] = MFMA(a, qf[ks], s[kt]);
            }
        }
        float mx = s[0][0];
#pragma unroll
        for (int r = 0; r < 16; ++r) { mx = fmaxf(mx, s[0][r]); mx = fmaxf(mx, s[1][r]); }
        mx = fmaxf(mx, __shfl_xor(mx, 32));
        const float mnew = fmaxf(mrun, mx);
        const float alpha = exp2f(mrun - mnew);
        mrun = mnew;
        float lsum = 0.f;
#pragma unroll
        for (int kt = 0; kt < 2; ++kt)
#pragma unroll
            for (int r = 0; r < 16; ++r) { const float pv = exp2f(s[kt][r] - mnew); s[kt][r] = pv; lsum += pv; }
        lrun = lrun * alpha + lsum;
#pragma unroll
        for (int et = 0; et < 4; ++et)
#pragma unroll
            for (int r = 0; r < 16; ++r) o[et][r] *= alpha;
#pragma unroll
        for (int kt = 0; kt < 2; ++kt) {
#pragma unroll
            for (int st = 0; st < 2; ++st) {
                u32x4 pp;
                pp[0] = pk2(s[kt][8 * st + 0], s[kt][8 * st + 1]); pp[1] = pk2(s[kt][8 * st + 2], s[kt][8 * st + 3]);
                pp[2] = pk2(s[kt][8 * st + 4], s[kt][8 * st + 5]); pp[3] = pk2(s[kt][8 * st + 6], s[kt][8 * st + 7]);
                const bf16x8 pf = __builtin_bit_cast(bf16x8, pp);
#pragma unroll
                for (int et = 0; et < 4; ++et) {
                    const bf16_t* vp = Vs + (et * 32 + c.l31) * 72 + kt * 32 + 16 * st + 4 * c.hl;
                    const u32x2 lo = *(const u32x2*)vp, hi = *(const u32x2*)(vp + 8);
                    u32x4 av; av[0] = lo[0]; av[1] = lo[1]; av[2] = hi[0]; av[3] = hi[1];
                    o[et] = MFMA(__builtin_bit_cast(bf16x8, av), pf, o[et]);
                }
            }
        }
    }
    const float ltot = lrun + __shfl_xor(lrun, 32);
    const float linv = 1.f / ltot;
    __syncthreads();
    float* Oc = (float*)c.smem;
    if (mp == 1) {
#pragma unroll
        for (int et = 0; et < 4; ++et)
#pragma unroll
            for (int r = 0; r < 16; ++r) Oc[(qs * 128 + et * 32 + crow(r, c.hl)) * 32 + c.l31] = o[et][r] * linv;
    }
    __syncthreads();
    if (mp == 0) {
        const float lam = c.cst[l], lam_init = c.cst[2 + l];
        float ss = 0.f;
#pragma unroll
        for (int et = 0; et < 4; ++et)
#pragma unroll
            for (int r = 0; r < 16; ++r) {
                const float d = o[et][r] * linv - lam * Oc[(qs * 128 + et * 32 + crow(r, c.hl)) * 32 + c.l31];
                o[et][r] = d; ss += d * d;
            }
        ss += __shfl_xor(ss, 32);
        const float rn = rsqrtf(ss * (1.f / 128.f) + EPS) * (1.f - lam_init);
        const bf16_t* DG = (const bf16_t*)(c.ws + OFF_DG) + qtok * 512 + h * 128;
        bf16_t* OD = (bf16_t*)(c.ws + OFF_ODIFF) + qtok * 512 + h * 128;
#pragma unroll
        for (int et = 0; et < 4; ++et)
#pragma unroll
            for (int q = 0; q < 4; ++q) {
                const int e0 = et * 32 + 8 * q + 4 * c.hl;
                const u32x2 g = *(const u32x2*)(DG + e0);
                u32x2 ov;
                ov[0] = pk2(o[et][4 * q + 0] * rn * bflo(g[0]), o[et][4 * q + 1] * rn * bfhi(g[0]));
                ov[1] = pk2(o[et][4 * q + 2] * rn * bflo(g[1]), o[et][4 * q + 3] * rn * bfhi(g[1]));
                *(u32x2*)(OD + e0) = ov;
            }
    }
}

DI void scan_item(const Ctx& c, int l, int bl, int h, int dir, int es) {
    const float lg2 = c.cst[4 + l * 8 + dir * 4 + h];
    const float decayC = exp2f(lg2 * 128.f);
    f32x16 st;
#pragma unroll
    for (int r = 0; r < 16; ++r) st[r] = 0.f;
    const bf16_t* vt = (const bf16_t*)(c.ws + OFF_RVT) + ((size_t)(bl * 4 + h) * 128 + es * 32 + c.l31) * PP;
    const bf16_t* kt = (const bf16_t*)(c.ws + OFF_RKT) + ((size_t)(bl * 4 + h) * 128 + c.w * 32 + c.l31) * PP;
    bf16_t* stbase = (bf16_t*)(c.ws + OFF_ST) + (size_t)(((bl * 4 + h) * 2 + dir) * NCH) * 16384;
#pragma unroll 1
    for (int step = 0; step < NCH; ++step) {
        const int m = dir == 0 ? step : (step < 2 ? 1 - step : 19 - step);
        bf16_t* sp = stbase + (size_t)m * 16384;
#pragma unroll
        for (int r = 0; r < 16; ++r) sp[(es * 32 + crow(r, c.hl)) * 128 + c.w * 32 + c.l31] = f2bf(st[r]);
        if (step == NCH - 1) break;
#pragma unroll
        for (int r = 0; r < 16; ++r) st[r] *= decayC;
#pragma unroll
        for (int ks = 0; ks < 8; ++ks) {
            const int j0 = ks * 16 + c.hl * 8;
            const u32x4 av = *(const u32x4*)(vt + m * 128 + j0);
            const u32x4 bv = *(const u32x4*)(kt + m * 128 + j0);
            u32x4 as;
#pragma unroll
            for (int e = 0; e < 4; ++e) {
                const int ja = j0 + 2 * e;
                const float e0 = dir == 0 ? (float)(127 - ja) : (float)ja;
                const float e1 = dir == 0 ? (float)(126 - ja) : (float)(ja + 1);
                const float w0 = exp2f(lg2 * e0), w1 = exp2f(lg2 * e1);
                as[e] = pk2(bflo(av[e]) * w0, bfhi(av[e]) * w1);
            }
            st = MFMA(__builtin_bit_cast(bf16x8, as), __builtin_bit_cast(bf16x8, bv), st);
        }
    }
}

DI void mlp_item(const Ctx& c, int l, int bl, int m, int g) {
    bf16_t* Vn = (bf16_t*)c.smem;
    bf16_t* Wsm = Vn + 128 * 136;
    float* stat = (float*)(Wsm + 128 * 136);
    const size_t tok0 = (size_t)bl * PP + m * 128;
    const bf16_t* MV = (const bf16_t*)(c.ws + OFF_MV);
    __syncthreads();
    for (int rr = 0; rr < 32; ++rr) {
        const int row = c.w * 32 + rr;
        const u32x4 v = *(const u32x4*)(MV + (tok0 + row) * 512 + c.lane * 8);
        float xv[8];
#pragma unroll
        for (int e = 0; e < 4; ++e) { xv[2 * e] = bflo(v[e]); xv[2 * e + 1] = bfhi(v[e]); }
        float s = 0.f;
#pragma unroll
        for (int e = 0; e < 8; ++e) s += xv[e];
        s = wave_sum(s);
        const float mu = s * (1.f / 512.f);
        float ss = 0.f;
#pragma unroll
        for (int e = 0; e < 8; ++e) { const float d = xv[e] - mu; ss += d * d; }
        ss = wave_sum(ss);
        if (c.lane == 0) { stat[row] = mu; stat[128 + row] = rsqrtf(ss * (1.f / 512.f) + EPS); }
    }
    __syncthreads();
#pragma unroll
    for (int it = 0; it < 8; ++it) {
        const int idx = c.tid + 256 * it, j = idx >> 4, seg = idx & 15;
        const u32x4 v = *(const u32x4*)(MV + (tok0 + j) * 512 + g * 128 + seg * 8);
        const float mu = stat[j], rs = stat[128 + j];
#pragma unroll
        for (int e = 0; e < 4; ++e) {
            Vn[(seg * 8 + 2 * e) * 136 + j] = f2bf((bflo(v[e]) - mu) * rs);
            Vn[(seg * 8 + 2 * e + 1) * 136 + j] = f2bf((bfhi(v[e]) - mu) * rs);
        }
    }
    const float* wsrc = c.w_s + (size_t)(l * 4 + g) * 128 * 128;
#pragma unroll
    for (int it = 0; it < 16; ++it) {
        const int idx = c.tid + 256 * it, i = idx >> 5, seg = idx & 31;
        const f32x4 wv = *(const f32x4*)(wsrc + i * 128 + seg * 4);
        u32x2 o; o[0] = pk2(wv[0], wv[1]); o[1] = pk2(wv[2], wv[3]);
        *(u32x2*)(Wsm + i * 136 + seg * 4) = o;
    }
    __syncthreads();
    const int wc = c.w >> 1, wi = c.w & 1;
    f32x16 acc[2][2];
    zero_acc(acc);
#pragma unroll
    for (int ks = 0; ks < 8; ++ks) {
        const bf16x8 a0 = *(const bf16x8*)(Vn + (wc * 64 + c.l31) * 136 + ks * 16 + c.hl * 8);
        const bf16x8 a1 = *(const bf16x8*)(Vn + (wc * 64 + 32 + c.l31) * 136 + ks * 16 + c.hl * 8);
        const bf16x8 b0 = *(const bf16x8*)(Wsm + (wi * 64 + c.l31) * 136 + ks * 16 + c.hl * 8);
        const bf16x8 b1 = *(const bf16x8*)(Wsm + (wi * 64 + 32 + c.l31) * 136 + ks * 16 + c.hl * 8);
        acc[0][0] = MFMA(a0, b0, acc[0][0]); acc[0][1] = MFMA(a0, b1, acc[0][1]);
        acc[1][0] = MFMA(a1, b0, acc[1][0]); acc[1][1] = MFMA(a1, b1, acc[1][1]);
    }
    const bf16_t* MU = (const bf16_t*)(c.ws + OFF_MU);
    const bf16_t* MG = (const bf16_t*)(c.ws + OFF_MG);
    bf16_t* OM = (bf16_t*)(c.ws + OFF_OMLP);
#pragma unroll
    for (int ii = 0; ii < 2; ++ii) {
        const int i = wi * 64 + ii * 32 + c.l31;
        const size_t tok = tok0 + i;
        const float bs = c.b_s[(l * 4 + g) * 128 + i];
#pragma unroll
        for (int ci = 0; ci < 2; ++ci)
#pragma unroll
            for (int q = 0; q < 4; ++q) {
                const int c0 = g * 128 + wc * 64 + ci * 32 + 8 * q + 4 * c.hl;
                const u32x2 u = *(const u32x2*)(MU + tok * 512 + c0), gg = *(const u32x2*)(MG + tok * 512 + c0);
                u32x2 ov;
                ov[0] = pk2(bflo(u[0]) * (acc[ci][ii][4 * q + 0] + bs) * bflo(gg[0]), bfhi(u[0]) * (acc[ci][ii][4 * q + 1] + bs) * bfhi(gg[0]));
                ov[1] = pk2(bflo(u[1]) * (acc[ci][ii][4 * q + 2] + bs) * bflo(gg[1]), bfhi(u[1]) * (acc[ci][ii][4 * q + 3] + bs) * bfhi(gg[1]));
                *(u32x2*)(OM + tok * 512 + c0) = ov;
            }
    }
}

DI void retout_item(const Ctx& c, int l, int bl, int h, int m) {
    bf16_t* Ks = (bf16_t*)c.smem;
    bf16_t* Vs = Ks + 128 * 136;
    const size_t tok0 = (size_t)bl * PP + m * 128;
    const bf16_t* RK = (const bf16_t*)(c.ws + OFF_RK) + tok0 * 512 + h * 128;
    const bf16_t* RVT = (const bf16_t*)(c.ws + OFF_RVT) + (size_t)(bl * 4 + h) * 128 * PP + m * 128;
    __syncthreads();
#pragma unroll
    for (int it = 0; it < 8; ++it) {
        const int idx = c.tid + 256 * it, row = idx >> 4, seg = idx & 15;
        *(u32x4*)(Ks + row * 136 + seg * 8) = *(const u32x4*)(RK + (size_t)row * 512 + seg * 8);
        *(u32x4*)(Vs + row * 136 + seg * 8) = *(const u32x4*)(RVT + (size_t)row * PP + seg * 8);
    }
    __syncthreads();
    const int i = c.w * 32 + c.l31;
    const size_t tok = tok0 + i;
    const float lgf = c.cst[4 + l * 8 + h], lgb = c.cst[4 + l * 8 + 4 + h];
    bf16x8 qf[8];
    const bf16_t* RQ = (const bf16_t*)(c.ws + OFF_RQ) + tok * 512 + h * 128;
#pragma unroll
    for (int ks = 0; ks < 8; ++ks) qf[ks] = *(const bf16x8*)(RQ + ks * 16 + c.hl * 8);
    f32x16 o[4];
    const bf16_t* stf = (const bf16_t*)(c.ws + OFF_ST) + (size_t)(((bl * 4 + h) * 2 + 0) * NCH + m) * 16384;
    const bf16_t* stb = (const bf16_t*)(c.ws + OFF_ST) + (size_t)(((bl * 4 + h) * 2 + 1) * NCH + m) * 16384;
    const float qdf = exp2f(lgf * (float)(i + 1)), qdb = exp2f(lgb * (float)(128 - i));
#pragma unroll
    for (int et = 0; et < 4; ++et) {
        f32x16 tf, tb;
#pragma unroll
        for (int r = 0; r < 16; ++r) { tf[r] = 0.f; tb[r] = 0.f; }
#pragma unroll
        for (int ks = 0; ks < 8; ++ks) {
            const bf16x8 a = *(const bf16x8*)(stf + (et * 32 + c.l31) * 128 + ks * 16 + c.hl * 8);
            const bf16x8 b = *(const bf16x8*)(stb + (et * 32 + c.l31) * 128 + ks * 16 + c.hl * 8);
            tf = MFMA(a, qf[ks], tf);
            tb = MFMA(b, qf[ks], tb);
        }
#pragma unroll
        for (int r = 0; r < 16; ++r) o[et][r] = tf[r] * qdf + tb[r] * qdb;
        __builtin_amdgcn_sched_barrier(0);
    }
#pragma unroll
    for (int jt = 0; jt < 4; ++jt) {
        f32x16 sc;
#pragma unroll
        for (int r = 0; r < 16; ++r) sc[r] = 0.f;
#pragma unroll
        for (int ks = 0; ks < 8; ++ks) {
            const bf16x8 a = *(const bf16x8*)(Ks + (jt * 32 + c.l31) * 136 + ks * 16 + c.hl * 8);
            sc = MFMA(a, qf[ks], sc);
        }
#pragma unroll
        for (int r = 0; r < 16; ++r) {
            const int j = jt * 32 + crow(r, c.hl);
            const int dl = i - j;
            const float arg = dl > 0 ? lgf * (float)dl : -lgb * (float)dl;
            float f = exp2f(arg);
            f = dl == 0 ? 2.f : f;
            sc[r] *= f;
        }
#pragma unroll
        for (int s2 = 0; s2 < 2; ++s2) {
            u32x4 pp;
            pp[0] = pk2(sc[8 * s2 + 0], sc[8 * s2 + 1]); pp[1] = pk2(sc[8 * s2 + 2], sc[8 * s2 + 3]);
            pp[2] = pk2(sc[8 * s2 + 4], sc[8 * s2 + 5]); pp[3] = pk2(sc[8 * s2 + 6], sc[8 * s2 + 7]);
            const bf16x8 pf = __builtin_bit_cast(bf16x8, pp);
#pragma unroll
            for (int et = 0; et < 4; ++et) {
                const bf16_t* vp = Vs + (et * 32 + c.l31) * 136 + jt * 32 + 16 * s2 + 4 * c.hl;
                const u32x2 lo = *(const u32x2*)vp, hi = *(const u32x2*)(vp + 8);
                u32x4 av; av[0] = lo[0]; av[1] = lo[1]; av[2] = hi[0]; av[3] = hi[1];
                o[et] = MFMA(__builtin_bit_cast(bf16x8, av), pf, o[et]);
            }
        }
        __builtin_amdgcn_sched_barrier(0);
    }
    float ss = 0.f;
#pragma unroll
    for (int et = 0; et < 4; ++et)
#pragma unroll
        for (int r = 0; r < 16; ++r) ss += o[et][r] * o[et][r];
    ss += __shfl_xor(ss, 32);
    const float rn = rsqrtf(ss * (1.f / 128.f) + EPS);
    const bf16_t* RG = (const bf16_t*)(c.ws + OFF_RG) + tok * 512 + h * 128;
    bf16_t* OR = (bf16_t*)(c.ws + OFF_ORET) + tok * 512 + h * 128;
#pragma unroll
    for (int et = 0; et < 4; ++et)
#pragma unroll
        for (int q = 0; q < 4; ++q) {
            const int e0 = et * 32 + 8 * q + 4 * c.hl;
            const u32x2 g = *(const u32x2*)(RG + e0);
            u32x2 ov;
            ov[0] = pk2(o[et][4 * q + 0] * rn * bflo(g[0]), o[et][4 * q + 1] * rn * bfhi(g[0]));
            ov[1] = pk2(o[et][4 * q + 2] * rn * bflo(g[1]), o[et][4 * q + 3] * rn * bfhi(g[1]));
            *(u32x2*)(OR + e0) = ov;
        }
}

DI void pm_item(const Ctx& c, int l, int rt, int nt) {
    f32x16 y[2][2], acc[2][2];
    zero_acc(y);
    const int wn = c.w >> 1, wm = c.w & 1;
    const bf16_t* MLOG = (const bf16_t*)(c.ws + OFF_MLOG);
#pragma unroll 1
    for (int br = 0; br < 3; ++br) {
        const size_t ooff = br == 0 ? OFF_ORET : (br == 1 ? OFF_OMLP : OFF_ODIFF);
        zero_acc(acc);
        gemm_core(c, (const bf16_t*)(c.ws + OFF_WBO) + ((size_t)(l * 3 + br) * 1024 + (size_t)nt * 128) * 512, 512,
                  (const bf16_t*)(c.ws + ooff) + (size_t)rt * 128 * 512, 512, 512, acc);
#pragma unroll
        for (int j = 0; j < 2; ++j) {
            const size_t tok = (size_t)rt * 128 + wm * 64 + j * 32 + c.l31;
#pragma unroll
            for (int i = 0; i < 2; ++i)
#pragma unroll
                for (int q = 0; q < 4; ++q) {
                    const int n0 = nt * 128 + wn * 64 + i * 32 + 8 * q + 4 * c.hl;
                    const u32x2 g = *(const u32x2*)(MLOG + tok * 3072 + br * 1024 + n0);
                    y[i][j][4 * q + 0] += bflo(g[0]) * acc[i][j][4 * q + 0];
                    y[i][j][4 * q + 1] += bfhi(g[0]) * acc[i][j][4 * q + 1];
                    y[i][j][4 * q + 2] += bflo(g[1]) * acc[i][j][4 * q + 2];
                    y[i][j][4 * q + 3] += bfhi(g[1]) * acc[i][j][4 * q + 3];
                }
        }
    }
    bf16_t* Y = (bf16_t*)(c.ws + OFF_Y);
#pragma unroll
    for (int j = 0; j < 2; ++j) {
        const size_t tok = (size_t)rt * 128 + wm * 64 + j * 32 + c.l31;
#pragma unroll
        for (int i = 0; i < 2; ++i)
#pragma unroll
            for (int q = 0; q < 4; ++q) {
                const int n0 = nt * 128 + wn * 64 + i * 32 + 8 * q + 4 * c.hl;
                u32x2 ov; ov[0] = pk2(y[i][j][4 * q + 0], y[i][j][4 * q + 1]); ov[1] = pk2(y[i][j][4 * q + 2], y[i][j][4 * q + 3]);
                *(u32x2*)(Y + tok * 1024 + n0) = ov;
            }
    }
}
DI void po_item(const Ctx& c, int l, int rt, int nt) {
    f32x16 acc[2][2];
    zero_acc(acc);
    gemm_core(c, (const bf16_t*)(c.ws + OFF_WO) + ((size_t)l * 1024 + (size_t)nt * 128) * 1024, 1024,
              (const bf16_t*)(c.ws + OFF_Y) + (size_t)rt * 128 * 1024, 1024, 1024, acc);
    const int wn = c.w >> 1, wm = c.w & 1;
    float* OUT = (float*)(c.ws + OFF_OUT);
#pragma unroll
    for (int j = 0; j < 2; ++j) {
        const size_t tok = (size_t)rt * 128 + wm * 64 + j * 32 + c.l31;
#pragma unroll
        for (int i = 0; i < 2; ++i)
#pragma unroll
            for (int q = 0; q < 4; ++q) {
                const int n0 = nt * 128 + wn * 64 + i * 32 + 8 * q + 4 * c.hl;
                f32x4 ov; ov[0] = acc[i][j][4 * q + 0]; ov[1] = acc[i][j][4 * q + 1]; ov[2] = acc[i][j][4 * q + 2]; ov[3] = acc[i][j][4 * q + 3];
                *(f32x4*)(OUT + tok * 1024 + n0) = ov;
            }
    }
}

extern __shared__ __attribute__((aligned(16))) unsigned char dynsmem[];
constexpr int LDS_BYTES = 72 * 1024;

DI Ctx mk_ctx(const Params& p, const float* cst) {
    Ctx c;
    c.x = p.in[0]; c.c = p.in[1]; c.ctx = p.in[2]; c.c_ctx = p.in[3]; c.w_mod = p.in[4]; c.b_mod = p.in[5]; c.g_pre = p.in[6]; c.g_post = p.in[7];
    c.w_in = p.in[8]; c.decay = p.in[9]; c.w_s = p.in[10]; c.b_s = p.in[11]; c.lq = p.in[12]; c.lk = p.in[13]; c.w_bo = p.in[14]; c.w_out = p.in[15];
    c.out = p.out; c.ws = p.ws; c.smem = dynsmem; c.cst = cst;
    int tid = threadIdx.x;
    asm volatile("" : "+v"(tid));
    asm volatile("" : "+s"(c.ws));
    c.tid = tid; c.lane = tid & 63; c.w = tid >> 6; c.l31 = c.lane & 31; c.hl = c.lane >> 5;
    return c;
}
DI void relaunder(Ctx& c) {
    int t = c.tid;
    asm volatile("" : "+v"(t));
    c.tid = t; c.lane = t & 63; c.w = t >> 6; c.l31 = c.lane & 31; c.hl = c.lane >> 5;
}

__global__ void __launch_bounds__(256, 2) mega(Params p) {
    __shared__ uint4 xbw;
    __shared__ float cst[32];
    Ctx c = mk_ctx(p, cst);
    if (c.tid == 0) xbw = make_uint4(0u, 0u, 0u, 0u);
    if (c.tid < 64) {
        for (int l = 0; l < 2; ++l) {
            float a = c.lq[(l * 2 + 0) * 64 + c.tid] * c.lk[(l * 2 + 0) * 64 + c.tid];
            float b = c.lq[(l * 2 + 1) * 64 + c.tid] * c.lk[(l * 2 + 1) * 64 + c.tid];
            a = wave_sum(a); b = wave_sum(b);
            const float lam_init = 0.8f - 0.6f * expf(-0.3f * (float)l);
            if (c.tid == 0) { cst[l] = expf(a) - expf(b) + lam_init; cst[2 + l] = lam_init; }
        }
        if (c.tid < 16) {
            const float z = c.decay[c.tid];
            cst[4 + c.tid] = -log1pf(expf(-z)) * LOG2E;
        }
    }
    __syncthreads();
    XcdBarrier bar = xcd_barrier_post((unsigned*)(p.ws + OFF_BAR), (volatile LAS unsigned*)&xbw);
    const int G = gridDim.x, bid = blockIdx.x;
    constexpr int NPH = 1 + NGRP * 13;
#pragma unroll 1
    for (int ph = 0; ph < NPH; ++ph) {
        c = mk_ctx(p, cst);
        int kind, g = 0, l = 0;
        if (ph == 0) kind = 0;
        else { const int q = ph - 1; g = q / 13; const int r = q % 13; if (r == 0) kind = 1; else { l = (r - 1) / 6; kind = 2 + (r - 1) % 6; } }
        switch (kind) {
        case 0:
#pragma unroll 1
            for (int it = bid; it < 2 * 1408 + 192; it += G) { relaunder(c); p0_item(c, it); }
            break;
        case 1:
#pragma unroll 1
            for (int it = bid; it < NT / 4; it += G) { relaunder(c); ph_item(c, g, it); }
            break;
        case 2:
#pragma unroll 1
            for (int it = bid; it < 72 * 68; it += G) {
                const int ct = it % 68, rt = it / 68;
                if (l == 1 && (rt % NCH) < 2 && ct >= 16) continue;
                relaunder(c);
                pz_item(c, l, rt, ct);
            }
            break;
        case 3: {
            const int n_att = 512, n_catt = (l == 0) ? 64 : 0, n_scan = 128, n_mlp = (l == 0) ? 288 : 256;
            const int total = n_att + n_catt + n_scan + n_mlp;
#pragma unroll 1
            for (int it = bid; it < total; it += G) {
                int r = it;
                relaunder(c);
                if (r < n_att + n_catt) {
                    int bl, h, q0, nk;
                    if (r < n_att) { bl = r >> 7; h = (r >> 5) & 3; q0 = CTXL + (r & 31) * 64; nk = PP; }
                    else { r -= n_att; bl = r >> 4; h = (r >> 2) & 3; q0 = (r & 3) * 64; nk = CTXL; }
                    attn_item(c, l, bl, h, q0, nk);
                    continue;
                }
                r -= n_att + n_catt;
                if (r < n_scan) { const int bl = r >> 5, h = (r >> 3) & 3, dir = (r >> 2) & 1, es = r & 3; scan_item(c, l, bl, h, dir, es); continue; }
                r -= n_scan;
                int bl, m, gg;
                if (l == 0) { bl = r / 72; const int q = r % 72; m = q >> 2; gg = q & 3; }
                else { bl = r >> 6; const int q = r & 63; m = 2 + (q >> 2); gg = q & 3; }
                mlp_item(c, l, bl, m, gg);
            }
            break; }
        case 4: {
            const int total = (l == 0) ? 288 : 256;
#pragma unroll 1
            for (int it = bid; it < total; it += G) {
                int bl, m, h;
                if (l == 0) { bl = it / 72; const int q = it % 72; h = q & 3; m = q >> 2; }
                else { bl = it >> 6; const int q = it & 63; h = q & 3; m = 2 + (q >> 2); }
                relaunder(c);
                retout_item(c, l, bl, h, m);
            }
            break; }
        case 5: {
            const int nrt = (l == 0) ? 72 : 64;
#pragma unroll 1
            for (int it = bid; it < nrt * 8; it += G) {
                const int nt = it & 7, rr = it >> 3;
                const int rt = (l == 0) ? rr : (rr >> 4) * NCH + 2 + (rr & 15);
                relaunder(c);
                pm_item(c, l, rt, nt);
            }
            break; }
        case 6: {
            const int nrt = (l == 0) ? 72 : 64;
#pragma unroll 1
            for (int it = bid; it < nrt * 8; it += G) {
                const int nt = it & 7, rr = it >> 3;
                const int rt = (l == 0) ? rr : (rr >> 4) * NCH + 2 + (rr & 15);
                relaunder(c);
                po_item(c, l, rt, nt);
            }
            break; }
        default:
#pragma unroll 1
            for (int it = bid; it < NT / 4; it += G) { relaunder(c); pr_item(c, l, g, it); }
            break;
        }
        if (ph + 1 < NPH) xcd_barrier(bar);
    }
}

extern "C" void kernel_launch(void* const* d_in, const int* in_sizes, int n_in, void* d_out, int out_size, void* d_ws, size_t ws_size, hipStream_t stream) {
    static int grid = 0;
    if (grid == 0) {
        int dev = 0, cus = 0, per_cu = 0;
        hipGetDevice(&dev);
        hipDeviceGetAttribute(&cus, hipDeviceAttributeMultiprocessorCount, dev);
        hipFuncSetAttribute((const void*)mega, hipFuncAttributeMaxDynamicSharedMemorySize, LDS_BYTES);
        hipOccupancyMaxActiveBlocksPerMultiprocessor(&per_cu, (const void*)mega, 256, LDS_BYTES);
        if (per_cu > 2) per_cu = 2;
        if (per_cu < 1) per_cu = 1;
        grid = cus * per_cu;
        if (ws_size < WS_END) { fprintf(stderr, "workspace too small: %zu < %zu\n", ws_size, (size_t)WS_END); grid = -1; }
    }
    if (grid < 0) return;
    hipMemsetAsync((unsigned char*)d_ws + OFF_BAR, 0, XCD_BAR_WORDS * 4, stream);
    Params p{};
    for (int i = 0; i < 16; ++i) p.in[i] = (const float*)d_in[i];
    p.out = (float*)d_out; p.ws = (unsigned char*)d_ws;
    void* args[] = {&p};
    hipError_t e = hipLaunchCooperativeKernel((const void*)mega, dim3(grid), dim3(256), args, LDS_BYTES, stream);
    if (e != hipSuccess) fprintf(stderr, "cooperative launch failed: %s (grid %d)\n", hipGetErrorString(e), grid);
}
```

```cpp
#include <hip/hip_runtime.h>
#include <cstdio>
#include <cstdint>

#define DI __device__ __forceinline__
#define LAS __attribute__((address_space(3)))
typedef unsigned short bf16_t;
typedef short bf16x8 __attribute__((ext_vector_type(8)));
typedef float f32x16 __attribute__((ext_vector_type(16)));
typedef float f32x4 __attribute__((ext_vector_type(4)));
typedef float f32x2 __attribute__((ext_vector_type(2)));
typedef unsigned u32x4 __attribute__((ext_vector_type(4)));
typedef unsigned u32x2 __attribute__((ext_vector_type(2)));
#define MFMA(a, b, c) __builtin_amdgcn_mfma_f32_32x32x16_bf16((a), (b), (c), 0, 0, 0)

#define XB_TMO      128
#define XB_XCNT(j)  (256  + 64 * (j))
#define XB_XSUB(j)  (1280 + 64 * (j))
#define XB_XGEN(j)  (2304 + 64 * (j))
#define XB_TOP      3328
#define XB_TOPGEN   3392
#define XCD_BAR_WORDS 3456
#define XB_SPIN_CAP (1u << 22)
DI unsigned xb_ld(unsigned* p)              { return __hip_atomic_load(p, __ATOMIC_RELAXED, __HIP_MEMORY_SCOPE_AGENT); }
DI unsigned xb_add(unsigned* p, unsigned v) { return __hip_atomic_fetch_add(p, v, __ATOMIC_RELAXED, __HIP_MEMORY_SCOPE_AGENT); }
DI unsigned xb_xcc_id() { return (unsigned)__builtin_amdgcn_s_getreg((3 << 11) | 20) & 0xFu; }
#define XB_SPIN(cond, bar) do { unsigned _sp = 0; while (cond) { __builtin_amdgcn_s_sleep(1); \
    if ((++_sp & 255u) == 0u) { if (xb_ld(&(bar)[XB_TMO])) break; if (_sp > XB_SPIN_CAP) { atomicAdd(&(bar)[XB_TMO], 1u); break; } } } } while (0)
struct XcdBarrier { unsigned* bar; unsigned x; volatile LAS unsigned* st; };
DI XcdBarrier xcd_barrier_post(unsigned* bar, volatile LAS unsigned* st, bool t0) {
    XcdBarrier b; b.bar = bar; b.x = xb_xcc_id(); b.st = st;
    if (t0) (void)xb_add(&bar[XB_XCNT(b.x)], 1u);
    return b;
}
DI void xcd_barrier_complete(unsigned* bar, unsigned x, unsigned& nloc, unsigned& nx) {
    const unsigned G = gridDim.x * gridDim.y * gridDim.z;
    unsigned sum, cnt, mine, sp = 0u;
    for (;;) {
        sum = 0u; cnt = 0u; mine = 0u;
#pragma unroll
        for (unsigned j = 0; j < 16; ++j) { const unsigned c = xb_ld(&bar[XB_XCNT(j)]); sum += c; cnt += (c > 0u) ? 1u : 0u; mine = (j == x) ? c : mine; }
        if (sum == G) break;
        __builtin_amdgcn_s_sleep(1);
        if ((++sp & 255u) == 0u) { if (xb_ld(&bar[XB_TMO])) break; if (sp > XB_SPIN_CAP) { atomicAdd(&bar[XB_TMO], 1u); break; } }
    }
    nloc = mine > 0u ? mine : 1u; nx = cnt > 0u ? cnt : 1u;
}
DI void xcd_barrier(const XcdBarrier& b, bool t0) {
    asm volatile("s_waitcnt vmcnt(0)" ::: "memory");
    __syncthreads();
    if (t0) {
        unsigned* bar = b.bar;
        __builtin_amdgcn_s_waitcnt(0);
        unsigned nloc = b.st[0], nx = b.st[1];
        if (nloc == 0u) { xcd_barrier_complete(bar, b.x, nloc, nx); b.st[0] = nloc; b.st[1] = nx; }
        const unsigned old = xb_add(&bar[XB_XSUB(b.x)], 1u);
        const unsigned gen = old / nloc;
        if (old + 1u == (gen + 1u) * nloc) {
            __builtin_amdgcn_fence(__ATOMIC_RELEASE, "agent");
            asm volatile("s_waitcnt vmcnt(0)" ::: "memory");
            const unsigned og = xb_add(&bar[XB_TOP], 1u);
            const unsigned tg = og / nx;
            if (og + 1u == (tg + 1u) * nx) xb_add(&bar[XB_TOPGEN], 1u);
            else XB_SPIN(xb_ld(&bar[XB_TOPGEN]) == tg, bar);
            __builtin_amdgcn_fence(__ATOMIC_ACQUIRE, "agent");
            xb_add(&bar[XB_XGEN(b.x)], 1u);
            asm volatile("s_waitcnt vmcnt(0)" ::: "memory");
        } else {
            XB_SPIN(xb_ld(&bar[XB_XGEN(b.x)]) == gen, bar);
            __builtin_amdgcn_fence(__ATOMIC_ACQUIRE, "agent");
            asm volatile("s_waitcnt vmcnt(0)" ::: "memory");
        }
    }
    __syncthreads();
}

constexpr int DM = 1024, SEQL = 2048, CTXL = 256, PP = 2304  ;
constexpr int NBG = 4  , NGRP = 2, NT = NBG * PP  ;
constexpr int INC = 8704, NCH = 18  ;
constexpr int LDH = 1088, LDW = 1088;
constexpr float EPS = 1e-6f;
constexpr float LOG2E = 1.4426950408889634f;

constexpr size_t TB = (size_t)NT * 512 * 2;
constexpr size_t OFF_BAR = 0;
constexpr size_t OFF_MOD = 16384;
constexpr size_t OFF_WIN = OFF_MOD + 262144;
constexpr size_t OFF_WBO = OFF_WIN + (size_t)2 * INC * LDW * 2;
constexpr size_t OFF_WO  = OFF_WBO + (size_t)2 * 3 * 1024 * 512 * 2;
constexpr size_t OFF_H   = OFF_WO + (size_t)2 * 1024 * 1024 * 2;
constexpr size_t OFF_RK  = OFF_H + (size_t)NT * LDH * 2;
constexpr size_t OFF_RKT = OFF_RK + TB;
constexpr size_t OFF_RVT = OFF_RKT + TB;
constexpr size_t OFF_DK  = OFF_RVT + TB;
constexpr size_t OFF_DVT = OFF_DK + TB;
constexpr size_t OFF_RQ  = OFF_DVT + TB;
constexpr size_t OFF_RG  = OFF_RQ + TB;
constexpr size_t OFF_DQ  = OFF_RG + TB;
constexpr size_t OFF_DG  = OFF_DQ + TB;
constexpr size_t OFF_MU  = OFF_DG + TB;
constexpr size_t OFF_MV  = OFF_MU + TB;
constexpr size_t OFF_MG  = OFF_MV + TB;
constexpr size_t OFF_MLOG = OFF_MG + TB;
constexpr size_t OFF_OMLP = OFF_MLOG + 6 * TB;
constexpr size_t OFF_ODIFF = OFF_OMLP + TB;
constexpr size_t OFF_ROPE = OFF_ODIFF + TB;
constexpr size_t WS_END = OFF_ROPE + (size_t)2048 * 96 * 8;
constexpr size_t OFF_ST = OFF_H;
constexpr size_t OFF_ORET = OFF_DK;
constexpr size_t OFF_Y = OFF_RK;
constexpr size_t OFF_OUT = OFF_MLOG;

struct Params {
    const float* in[16];
    float* out;
    unsigned char* ws;
};

struct Ctx {
    const float *x, *c, *ctx, *c_ctx, *w_mod, *b_mod, *g_pre, *g_post, *w_in, *decay, *w_s, *b_s, *lq, *lk, *w_bo, *w_out;
    float* out;
    unsigned char* ws;
    unsigned char* smem;
    const float* cst;
    int tid, lane, w, l31, hl;
};

DI unsigned pk2(float lo, float hi) {
    typedef __bf16 b2 __attribute__((ext_vector_type(2)));
    f32x2 v = {lo, hi};
    b2 r = __builtin_convertvector(v, b2);
    return __builtin_bit_cast(unsigned, r);
}
DI bf16_t f2bf(float x) { return (bf16_t)(pk2(x, 0.f) & 0xffffu); }
DI float bflo(unsigned u) { return __uint_as_float(u << 16); }
DI float bfhi(unsigned u) { return __uint_as_float(u & 0xffff0000u); }
DI int crow(int r, int hl) { return (r & 3) + 8 * (r >> 2) + 4 * hl; }
DI float wave_sum(float v) {
#pragma unroll
    for (int o = 1; o < 64; o <<= 1) v += __shfl_xor(v, o);
    return v;
}
DI float fsig(float x) { return __builtin_amdgcn_rcpf(1.f + __builtin_amdgcn_exp2f(-LOG2E * x)); }
DI void sincos_rev(float rev, float& sn, float& cs) {
    const float g = __builtin_amdgcn_fractf(rev) - 0.5f;
    const bool fold = fabsf(g) > 0.25f;
    const float h = fold ? (copysignf(0.5f, g) - g) : g;
    const float x = h * 6.283185307179586f;
    const float x2 = x * x;
    const float sp = x * (1.f + x2 * (-1.6666667e-1f + x2 * (8.3333333e-3f + x2 * (-1.9841270e-4f + x2 * (2.7557319e-6f - x2 * 2.5052108e-8f)))));
    const float cp = 1.f + x2 * (-0.5f + x2 * (4.1666667e-2f + x2 * (-1.3888889e-3f + x2 * (2.4801587e-5f + x2 * (-2.7557319e-7f + x2 * 2.0876757e-9f)))));
    sn = -sp;
    cs = fold ? cp : -cp;
}
DI float silu_f(float x) { return x / (1.f + __expf(-x)); }
DI float sigmoid_f(float x) { return 1.f / (1.f + __expf(-x)); }

DI void gemm_core(const Ctx& c, const bf16_t* __restrict__ Wt, int ldw, const bf16_t* __restrict__ Act, int lda, int K, f32x16 (&acc)[2][2]) {
    bf16_t* Ws = (bf16_t*)c.smem;
    bf16_t* As = Ws + 128 * 72;
    const int wn = c.w >> 1, wm = c.w & 1;
    const int lrow = c.tid >> 3, lseg = c.tid & 7;
    u32x4 rw[4], ra[4];
#pragma unroll
    for (int it = 0; it < 4; ++it) {
        rw[it] = *(const u32x4*)(Wt + (size_t)(lrow + 32 * it) * ldw + lseg * 8);
        ra[it] = *(const u32x4*)(Act + (size_t)(lrow + 32 * it) * lda + lseg * 8);
    }
    for (int k0 = 0; k0 < K; k0 += 64) {
        __syncthreads();
#pragma unroll
        for (int it = 0; it < 4; ++it) {
            *(u32x4*)(Ws + (lrow + 32 * it) * 72 + lseg * 8) = rw[it];
            *(u32x4*)(As + (lrow + 32 * it) * 72 + lseg * 8) = ra[it];
        }
        __syncthreads();
        if (k0 + 64 < K) {
#pragma unroll
            for (int it = 0; it < 4; ++it) {
                rw[it] = *(const u32x4*)(Wt + (size_t)(lrow + 32 * it) * ldw + k0 + 64 + lseg * 8);
                ra[it] = *(const u32x4*)(Act + (size_t)(lrow + 32 * it) * lda + k0 + 64 + lseg * 8);
            }
        }
#pragma unroll
        for (int ks = 0; ks < 4; ++ks) {
            const bf16x8 a0 = *(const bf16x8*)(Ws + (wn * 64 + c.l31) * 72 + ks * 16 + c.hl * 8);
            const bf16x8 a1 = *(const bf16x8*)(Ws + (wn * 64 + 32 + c.l31) * 72 + ks * 16 + c.hl * 8);
            const bf16x8 b0 = *(const bf16x8*)(As + (wm * 64 + c.l31) * 72 + ks * 16 + c.hl * 8);
            const bf16x8 b1 = *(const bf16x8*)(As + (wm * 64 + 32 + c.l31) * 72 + ks * 16 + c.hl * 8);
            acc[0][0] = MFMA(a0, b0, acc[0][0]);
            acc[0][1] = MFMA(a0, b1, acc[0][1]);
            acc[1][0] = MFMA(a1, b0, acc[1][0]);
            acc[1][1] = MFMA(a1, b1, acc[1][1]);
        }
    }
}
DI void zero_acc(f32x16 (&acc)[2][2]) {
#pragma unroll
    for (int i = 0; i < 2; ++i)
#pragma unroll
        for (int j = 0; j < 2; ++j)
#pragma unroll
            for (int r = 0; r < 16; ++r) acc[i][j][r] = 0.f;
}


DI void gemm_core2(const Ctx& c, const bf16_t* __restrict__ Wt, int ldw, const bf16_t* __restrict__ Act, int lda, int K, f32x16 (&acc)[2][4]) {
    constexpr int RS = 32;
    constexpr int STG = 384 * RS;
    bf16_t* S = (bf16_t*)c.smem;
    const int wn = c.w >> 1, wm = c.w & 1;
    const int lrow = c.tid >> 2, lseg = c.tid & 3;
    const int scol = (lseg ^ ((c.tid >> 4) & 3)) * 8;
    const int rsw = (c.l31 >> 2) & 3;
    const bf16_t* wp = Wt + (size_t)lrow * ldw + lseg * 8;
    const bf16_t* ap = Act + (size_t)lrow * lda + lseg * 8;
    u32x4 rw[2], ra[4];
#pragma unroll
    for (int it = 0; it < 2; ++it) rw[it] = *(const u32x4*)(wp + (size_t)(64 * it) * ldw);
#pragma unroll
    for (int it = 0; it < 4; ++it) ra[it] = *(const u32x4*)(ap + (size_t)(64 * it) * lda);
    __syncthreads();
#pragma unroll
    for (int it = 0; it < 2; ++it) *(u32x4*)(S + (lrow + 64 * it) * RS + scol) = rw[it];
#pragma unroll
    for (int it = 0; it < 4; ++it) *(u32x4*)(S + (128 + lrow + 64 * it) * RS + scol) = ra[it];
    if (K > 32) {
#pragma unroll
        for (int it = 0; it < 2; ++it) rw[it] = *(const u32x4*)(wp + (size_t)(64 * it) * ldw + 32);
#pragma unroll
        for (int it = 0; it < 4; ++it) ra[it] = *(const u32x4*)(ap + (size_t)(64 * it) * lda + 32);
    }
    __syncthreads();
    for (int k0 = 0; k0 < K; k0 += 32) {
        const int s = (k0 >> 5) & 1;
        bf16_t* Sc = S + s * STG;
        bf16_t* Sn = S + (s ^ 1) * STG;
        if (k0 + 32 < K) {
#pragma unroll
            for (int it = 0; it < 2; ++it) *(u32x4*)(Sn + (lrow + 64 * it) * RS + scol) = rw[it];
#pragma unroll
            for (int it = 0; it < 4; ++it) *(u32x4*)(Sn + (128 + lrow + 64 * it) * RS + scol) = ra[it];
            if (k0 + 64 < K) {
#pragma unroll
                for (int it = 0; it < 2; ++it) rw[it] = *(const u32x4*)(wp + (size_t)(64 * it) * ldw + k0 + 64);
#pragma unroll
                for (int it = 0; it < 4; ++it) ra[it] = *(const u32x4*)(ap + (size_t)(64 * it) * lda + k0 + 64);
            }
        }
#pragma unroll
        for (int ks = 0; ks < 2; ++ks) {
            const int rcol = ((ks * 2 + c.hl) ^ rsw) * 8;
            bf16x8 a[2], b[4];
#pragma unroll
            for (int i = 0; i < 2; ++i) a[i] = *(const bf16x8*)(Sc + (wn * 64 + i * 32 + c.l31) * RS + rcol);
#pragma unroll
            for (int j = 0; j < 4; ++j) b[j] = *(const bf16x8*)(Sc + (128 + wm * 128 + j * 32 + c.l31) * RS + rcol);
#pragma unroll
            for (int i = 0; i < 2; ++i)
#pragma unroll
                for (int j = 0; j < 4; ++j) acc[i][j] = MFMA(a[i], b[j], acc[i][j]);
        }
        __syncthreads();
    }
}
DI void zero_acc2(f32x16 (&acc)[2][4]) {
#pragma unroll
    for (int i = 0; i < 2; ++i)
#pragma unroll
        for (int j = 0; j < 4; ++j)
#pragma unroll
            for (int r = 0; r < 16; ++r) acc[i][j][r] = 0.f;
}

DI void transpose_item(const Ctx& c, const float* __restrict__ src, int N, int k0, int n0, int mapk, bf16_t* __restrict__ dst, int ldk) {
    float* T = (float*)c.smem;
    __syncthreads();
#pragma unroll
    for (int it = 0; it < 8; ++it) {
        const int idx = c.tid + 256 * it, r = idx >> 5, c4 = idx & 31;
        const f32x4 v = *(const f32x4*)(src + (size_t)(k0 + r) * N + n0 + c4 * 4);
        float* t = T + r * 129 + c4 * 4;
        t[0] = v[0]; t[1] = v[1]; t[2] = v[2]; t[3] = v[3];
    }
    __syncthreads();
#pragma unroll
    for (int it = 0; it < 4; ++it) {
        const int idx = c.tid + 256 * it, np = idx >> 3, ch = idx & 7;
        int cs = np;
        if (mapk == 1) cs = (np >> 1) + 64 * (np & 1);
        else if (mapk == 2) { const int r = np & 63; cs = (np & 64) + (r >> 1) + 32 * (r & 1); }
        const float* t = T + (ch * 8) * 129 + cs;
        u32x4 o;
        o[0] = pk2(t[0], t[129]); o[1] = pk2(t[2 * 129], t[3 * 129]); o[2] = pk2(t[4 * 129], t[5 * 129]); o[3] = pk2(t[6 * 129], t[7 * 129]);
        *(u32x4*)(dst + (size_t)(n0 + np) * ldk + k0 + ch * 8) = o;
    }
}
DI void mod_item(const Ctx& c, int l, int jb) {
    float* sv = (float*)c.smem;
    float* red = sv + 9 * 1024;
    __syncthreads();
    for (int idx = c.tid; idx < 9216; idx += 256) {
        const int v = idx >> 10, k = idx & 1023;
        const float x = v < 8 ? c.c[v * 1024 + k] : c.c_ctx[k];
        sv[idx] = x / (1.f + expf(-x));
    }
    __syncthreads();
    const int kk = c.tid >> 5, jj = c.tid & 31, j = jb * 32 + jj;
    float a[9];
#pragma unroll
    for (int v = 0; v < 9; ++v) a[v] = 0.f;
    const float* wp = c.w_mod + (size_t)l * 1024 * 3072 + j;
#pragma unroll 4
    for (int i = 0; i < 128; ++i) {
        const int k = kk + 8 * i;
        const float wv = wp[(size_t)k * 3072];
#pragma unroll
        for (int v = 0; v < 9; ++v) a[v] += sv[v * 1024 + k] * wv;
    }
#pragma unroll
    for (int v = 0; v < 9; ++v) red[(kk * 9 + v) * 32 + jj] = a[v];
    __syncthreads();
    float* MOD = (float*)(c.ws + OFF_MOD);
    for (int idx = c.tid; idx < 288; idx += 256) {
        const int v = idx >> 5, j2 = idx & 31;
        float s = 0.f;
#pragma unroll
        for (int k2 = 0; k2 < 8; ++k2) s += red[(k2 * 9 + v) * 32 + j2];
        MOD[(size_t)(l * 9 + v) * 3072 + jb * 32 + j2] = s + c.b_mod[l * 3072 + jb * 32 + j2];
    }
}

DI void rope_item(const Ctx& c, int it) {
    constexpr float L2B = 13.287712379549449f;
    f32x2* T = (f32x2*)(c.ws + OFF_ROPE);
#pragma unroll 1
    for (int e = 0; e < 8; ++e) {
        const int idx = (it * 8 + e) * 256 + c.tid;
        const int lp = idx / 96, a = idx % 96;
        const float rowp = (float)(lp >> 6), colp = (float)(lp & 63);
        float ang;
        if (a < 64) { const int f = a & 31; ang = (a < 32 ? rowp : colp) * exp2f(-(float)f * (L2B / 32.f)); }
        else { const int a2 = a - 64, f = a2 & 15; ang = (a2 < 16 ? rowp : colp) * exp2f(-(float)f * (L2B / 16.f)); }
        f32x2 v; v[0] = cosf(ang); v[1] = sinf(ang);
        T[idx] = v;
    }
}
DI void p0_item(const Ctx& c, int it) {
    if (it < 2 * 1408) {
        const int l = it / 1408; int r = it % 1408;
        if (r < 1088) {
            const int ct = r % 68, kb = r / 68;
            const int kind = ct >> 2;
            const int mapk = (kind == 0 || kind == 4) ? 1 : ((kind == 2 || kind == 6) ? 2 : 0);
            transpose_item(c, c.w_in + (size_t)l * 1024 * INC, INC, kb * 64, ct * 128, mapk, (bf16_t*)(c.ws + OFF_WIN) + (size_t)l * INC * LDW, LDW);
            return;
        }
        r -= 1088;
        if (r < 192) {
            const int br = r / 64, q = r % 64, kb = q >> 3, nb = q & 7;
            transpose_item(c, c.w_bo + (size_t)(l * 3 + br) * 512 * 1024, 1024, kb * 64, nb * 128, 0,
                           (bf16_t*)(c.ws + OFF_WBO) + (size_t)(l * 3 + br) * 1024 * 512, 512);
            return;
        }
        r -= 192;
        { const int kb = r >> 3, nb = r & 7;
          transpose_item(c, c.w_out + (size_t)l * 1024 * 1024, 1024, kb * 64, nb * 128, 0, (bf16_t*)(c.ws + OFF_WO) + (size_t)l * 1024 * 1024, 1024); }
        return;
    }
    it -= 2 * 1408;
    mod_item(c, it / 96, it % 96);
}

DI void modulate_row(const f32x4 (&x)[4], const float* gpre, const float* mod  , bf16_t* hrow, int lane) {
    float ss = 0.f;
#pragma unroll
    for (int j = 0; j < 4; ++j) ss += x[j][0] * x[j][0] + x[j][1] * x[j][1] + x[j][2] * x[j][2] + x[j][3] * x[j][3];
    ss = wave_sum(ss);
    const float r = rsqrtf(ss * (1.f / 1024.f) + EPS);
#pragma unroll
    for (int j = 0; j < 4; ++j) {
        const int col = lane * 4 + 256 * j;
        const f32x4 g = *(const f32x4*)(gpre + col), sh = *(const f32x4*)(mod + col), sc = *(const f32x4*)(mod + 1024 + col);
        f32x4 h;
#pragma unroll
        for (int e = 0; e < 4; ++e) h[e] = x[j][e] * r * g[e] * (1.f + sc[e]) + sh[e];
        u32x2 o; o[0] = pk2(h[0], h[1]); o[1] = pk2(h[2], h[3]);
        *(u32x2*)(hrow + col) = o;
    }
}
DI void ph_item(const Ctx& c, int g, int item) {
    const int tok = item * 4 + c.w, bl = tok / PP, p = tok % PP, b = g * NBG + bl;
    const float* src = p < CTXL ? c.ctx + ((size_t)b * CTXL + p) * DM : c.x + ((size_t)b * SEQL + (p - CTXL)) * DM;
    f32x4 x[4];
#pragma unroll
    for (int j = 0; j < 4; ++j) x[j] = *(const f32x4*)(src + c.lane * 4 + 256 * j);
    const float* mod = (const float*)(c.ws + OFF_MOD) + (size_t)(0 * 9 + (p < CTXL ? 8 : b)) * 3072;
    modulate_row(x, c.g_pre, mod, (bf16_t*)(c.ws + OFF_H) + (size_t)tok * LDH, c.lane);
}
DI void pr_item(const Ctx& c, int l, int g, int item) {
    const int tok = item * 4 + c.w, bl = tok / PP, p = tok % PP, b = g * NBG + bl;
    if (l == 1 && p < CTXL) return;
    const float* orow = (const float*)(c.ws + OFF_OUT) + (size_t)tok * DM;
    const int v = p < CTXL ? 8 : b;
    const float* mod = (const float*)(c.ws + OFF_MOD) + (size_t)(l * 9 + v) * 3072;
    float* xo_lat = c.out + ((size_t)b * SEQL + (p - CTXL)) * DM;
    const float* xold = p < CTXL ? c.ctx + ((size_t)b * CTXL + p) * DM : (l == 0 ? c.x + ((size_t)b * SEQL + (p - CTXL)) * DM : xo_lat);
    f32x4 o[4]; float ss = 0.f;
#pragma unroll
    for (int j = 0; j < 4; ++j) { o[j] = *(const f32x4*)(orow + c.lane * 4 + 256 * j); ss += o[j][0] * o[j][0] + o[j][1] * o[j][1] + o[j][2] * o[j][2] + o[j][3] * o[j][3]; }
    ss = wave_sum(ss);
    const float r = rsqrtf(ss * (1.f / 1024.f) + EPS);
    f32x4 xn[4];
#pragma unroll
    for (int j = 0; j < 4; ++j) {
        const int col = c.lane * 4 + 256 * j;
        const f32x4 gp = *(const f32x4*)(c.g_post + l * 1024 + col), gt = *(const f32x4*)(mod + 2048 + col), xv = *(const f32x4*)(xold + col);
#pragma unroll
        for (int e = 0; e < 4; ++e) xn[j][e] = xv[e] + gt[e] * (o[j][e] * r * gp[e]);
        if (p >= CTXL) *(f32x4*)(xo_lat + col) = xn[j];
    }
    if (l == 0) {
        const float* mod1 = (const float*)(c.ws + OFF_MOD) + (size_t)(1 * 9 + v) * 3072;
        modulate_row(xn, c.g_pre + 1024, mod1, (bf16_t*)(c.ws + OFF_H) + (size_t)tok * LDH, c.lane);
    }
}

DI void pz_item(const Ctx& c, int l, int rt2, int ct) {
    f32x16 acc[2][4];
    zero_acc2(acc);
    gemm_core2(c, (const bf16_t*)(c.ws + OFF_WIN) + ((size_t)l * INC + (size_t)ct * 128) * LDW, LDW,
               (const bf16_t*)(c.ws + OFF_H) + (size_t)rt2 * 256 * LDH, LDH, 1024, acc);
    const int wn = c.w >> 1, wm = c.w & 1;
    const int bl = rt2 / 9, pt2 = rt2 % 9;
    const int kind = ct >> 2, h = ct & 3;
    const bool roped = (kind == 0 || kind == 4 || kind == 2 || kind == 6);
    const bool retk = (kind == 0 || kind == 4);
    bf16_t* E = (bf16_t*)c.smem;
    constexpr int ES = 136, ETS = 264;
    const float rsc = kind == 0 ? 0.08838834764831845f : (kind == 6 ? 0.125f * LOG2E : 1.f);
    const bool latent = pt2 > 0;
    const bool mulx = (kind == 5 || kind == 7 || kind == 10);
#define XF_PLAIN  { v0 *= rsc; v1 *= rsc; v2 *= rsc; v3 *= rsc; }
#define XF_SIG    { v0 = fsig(v0); v1 = fsig(v1); v2 = fsig(v2); v3 = fsig(v3); }
#define XF_SILU   { v0 *= fsig(v0); v1 *= fsig(v1); v2 *= fsig(v2); v3 *= fsig(v3); }
#define PZ_STAGE(PASS, XF) \
    _Pragma("unroll") for (int j = 0; j < 4; ++j) { \
        const int m = wm * 128 + j * 32 + c.l31; \
        _Pragma("unroll") for (int i = 0; i < 2; ++i) \
        _Pragma("unroll") for (int q = 0; q < 4; ++q) { \
            const int n0 = wn * 64 + i * 32 + 8 * q + 4 * c.hl; \
            float v0 = acc[i][j][4 * q + 0], v1 = acc[i][j][4 * q + 1], v2 = acc[i][j][4 * q + 2], v3 = acc[i][j][4 * q + 3]; \
            XF \
            if (PASS == 0) { \
                u32x2 o; o[0] = pk2(v0, v1); o[1] = pk2(v2, v3); \
                *(u32x2*)(E + m * ES + n0) = o; \
            } else { \
                E[(n0 + 0) * ETS + m] = f2bf(v0); E[(n0 + 1) * ETS + m] = f2bf(v1); E[(n0 + 2) * ETS + m] = f2bf(v2); E[(n0 + 3) * ETS + m] = f2bf(v3); \
            } \
        } \
    }
    const int cls = roped ? (latent ? 0 : 1) : (kind >= 11 ? 2 : (mulx ? 3 : 1));
    const int nfq = retk ? 32 : 16;
    const float fsc = retk ? (13.287712379549449f / 32.f) : (13.287712379549449f / 16.f);
    if (cls == 0) {
        const int lbase = pt2 * 256 + wm * 128 - CTXL;
        const float rowA = (float)(lbase >> 6), colA = (float)c.l31;
#pragma unroll
        for (int i = 0; i < 2; ++i) {
            const bool rowpart = retk ? (wn == 0) : (i == 0);
            const float posA = rowpart ? rowA : colA;
            const float posB = rowpart ? rowA + 1.f : colA + 32.f;
#pragma unroll
            for (int q = 0; q < 4; ++q) {
                const int n0 = wn * 64 + i * 32 + 8 * q + 4 * c.hl;
                const int c0 = retk ? (n0 >> 1) : ((n0 & 63) >> 1);
                const float iv0 = __builtin_amdgcn_exp2f(-(float)(c0 & (nfq - 1)) * fsc) * 0.15915494309189535f;
                const float iv1 = __builtin_amdgcn_exp2f(-(float)((c0 + 1) & (nfq - 1)) * fsc) * 0.15915494309189535f;
#define ROPE_APPLY(POS, JA, JB) { float s0, c0f, s1, c1f; sincos_rev((POS) * iv0, s0, c0f); sincos_rev((POS) * iv1, s1, c1f); \
                    { const float v0 = acc[i][JA][4 * q + 0], v1 = acc[i][JA][4 * q + 1], v2 = acc[i][JA][4 * q + 2], v3 = acc[i][JA][4 * q + 3]; \
                      acc[i][JA][4 * q + 0] = v0 * c0f - v1 * s0; acc[i][JA][4 * q + 1] = v0 * s0 + v1 * c0f; acc[i][JA][4 * q + 2] = v2 * c1f - v3 * s1; acc[i][JA][4 * q + 3] = v2 * s1 + v3 * c1f; } \
                    { const float v0 = acc[i][JB][4 * q + 0], v1 = acc[i][JB][4 * q + 1], v2 = acc[i][JB][4 * q + 2], v3 = acc[i][JB][4 * q + 3]; \
                      acc[i][JB][4 * q + 0] = v0 * c0f - v1 * s0; acc[i][JB][4 * q + 1] = v0 * s0 + v1 * c0f; acc[i][JB][4 * q + 2] = v2 * c1f - v3 * s1; acc[i][JB][4 * q + 3] = v2 * s1 + v3 * c1f; } }
                if (rowpart) { ROPE_APPLY(posA, 0, 1) ROPE_APPLY(posB, 2, 3) }
                else { ROPE_APPLY(posA, 0, 2) ROPE_APPLY(posB, 1, 3) }
#undef ROPE_APPLY
            }
        }
    }
    if (kind != 1 && kind != 3) {
        if (cls <= 1) { PZ_STAGE(0, XF_PLAIN) }
        else if (cls == 2) { PZ_STAGE(0, XF_SIG) }
        else { PZ_STAGE(0, XF_SILU) }
        __syncthreads();
        bf16_t* dst; size_t ld;
        if (kind >= 11) { dst = (bf16_t*)(c.ws + OFF_MLOG) + (size_t)(ct - 44) * 128; ld = 3072; }
        else {
            size_t off;
            switch (kind) { case 0: off = OFF_RK; break; case 2: off = OFF_DK; break; case 4: off = OFF_RQ; break; case 5: off = OFF_RG; break;
                            case 6: off = OFF_DQ; break; case 7: off = OFF_DG; break; case 8: off = OFF_MU; break; case 9: off = OFF_MV; break; default: off = OFF_MG; break; }
            dst = (bf16_t*)(c.ws + off) + h * 128; ld = 512;
        }
        dst += (size_t)rt2 * 256 * ld;
#pragma unroll 4
        for (int it = 0; it < 16; ++it) {
            const int id = c.tid + 256 * it, row = id >> 4, seg = id & 15;
            *(u32x4*)(dst + (size_t)row * ld + seg * 8) = *(const u32x4*)(E + row * ES + seg * 8);
        }
    }
    if (kind == 0 || kind == 1 || kind == 3) {
        if (kind == 0) __syncthreads();
        PZ_STAGE(1, XF_PLAIN)
        __syncthreads();
        const size_t off = kind == 0 ? OFF_RKT : (kind == 1 ? OFF_RVT : OFF_DVT);
        bf16_t* dst = (bf16_t*)(c.ws + off) + (size_t)(bl * 4 + h) * 128 * PP + pt2 * 256;
#pragma unroll 4
        for (int it = 0; it < 16; ++it) {
            const int id = c.tid + 256 * it, n = id >> 5, seg = id & 31;
            *(u32x4*)(dst + (size_t)n * PP + seg * 8) = *(const u32x4*)(E + n * ETS + seg * 8);
        }
    }
    __builtin_amdgcn_s_setprio(0);
#undef PZ_STAGE
#undef XF_PLAIN
#undef XF_SIG
#undef XF_SILU
}

DI void attn_item(const Ctx& c, int l, int bl, int h, int q0, int nk) {
    bf16_t* Ks = (bf16_t*)c.smem;
    bf16_t* Vs = Ks + 64 * 136;
    const int mp = c.w >> 1, qs = c.w & 1;
    const int qpos = q0 + qs * 32 + c.l31;
    const size_t qtok = (size_t)bl * PP + qpos;
    const bf16_t* DQ = (const bf16_t*)(c.ws + OFF_DQ);
    const bf16_t* DK = (const bf16_t*)(c.ws + OFF_DK) + (size_t)bl * PP * 512 + h * 128;
    const bf16_t* DVT = (const bf16_t*)(c.ws + OFF_DVT) + (size_t)(bl * 4 + h) * 128 * PP;
    bf16x8 qf[4];
#pragma unroll
    for (int ks = 0; ks < 4; ++ks) qf[ks] = *(const bf16x8*)(DQ + qtok * 512 + h * 128 + mp * 64 + ks * 16 + c.hl * 8);
    f32x16 o[4];
#pragma unroll
    for (int et = 0; et < 4; ++et)
#pragma unroll
        for (int r = 0; r < 16; ++r) o[et][r] = 0.f;
    float mrun = -1e30f, lrun = 0.f;
    u32x4 rk[4], rv[4];
    constexpr int BUF = 64 * 136 + 128 * 68;
#define AT_LOAD(KT0) { _Pragma("unroll") for (int it = 0; it < 4; ++it) { const int idx = c.tid + 256 * it; \
        rk[it] = *(const u32x4*)(DK + (size_t)((KT0) + (idx >> 4)) * 512 + (idx & 15) * 8); \
        rv[it] = *(const u32x4*)(DVT + (size_t)(idx >> 3) * PP + (KT0) + (idx & 7) * 8); } }
#define AT_STORE(BP) { _Pragma("unroll") for (int it = 0; it < 4; ++it) { const int idx = c.tid + 256 * it; \
        *(u32x4*)((BP) + (idx >> 4) * 136 + (idx & 15) * 8) = rk[it]; \
        u32x2 lo2, hi2; lo2[0] = rv[it][0]; lo2[1] = rv[it][1]; hi2[0] = rv[it][2]; hi2[1] = rv[it][3]; \
        *(u32x2*)((BP) + 64 * 136 + (idx >> 3) * 68 + (idx & 7) * 8) = lo2; *(u32x2*)((BP) + 64 * 136 + (idx >> 3) * 68 + (idx & 7) * 8 + 4) = hi2; } }
    AT_LOAD(0)
    __syncthreads();
    AT_STORE(Ks)
    if (64 < nk) AT_LOAD(64)
    __syncthreads();
    for (int kt0 = 0; kt0 < nk; kt0 += 64) {
        const int cb = (kt0 >> 6) & 1;
        const bf16_t* Kc = Ks + cb * BUF;
        const bf16_t* Vc = Kc + 64 * 136;
        if (kt0 + 64 < nk) {
            AT_STORE(Ks + (cb ^ 1) * BUF)
            if (kt0 + 128 < nk) AT_LOAD(kt0 + 128)
        }
        f32x16 s[2];
#pragma unroll
        for (int kt = 0; kt < 2; ++kt) {
#pragma unroll
            for (int r = 0; r < 16; ++r) s[kt][r] = 0.f;
#pragma unroll
            for (int ks = 0; ks < 4; ++ks) {
                const bf16x8 a = *(const bf16x8*)(Kc + (kt * 32 + c.l31) * 136 + mp * 64 + ks * 16 + c.hl * 8);
                s[kt] = MFMA(a, qf[ks], s[kt]);
            }
        }
        float mx = s[0][0];
#pragma unroll
        for (int r = 0; r < 16; ++r) { mx = fmaxf(mx, s[0][r]); mx = fmaxf(mx, s[1][r]); }
        mx = fmaxf(mx, __shfl_xor(mx, 32));
        const float mold = mrun;
        const float mnew = fmaxf(mrun, mx);
        const float alpha = __builtin_amdgcn_exp2f(mrun - mnew);
        mrun = mnew;
        float lsum = 0.f;
#pragma unroll
        for (int kt = 0; kt < 2; ++kt)
#pragma unroll
            for (int r = 0; r < 16; ++r) { const float pv = __builtin_amdgcn_exp2f(s[kt][r] - mnew); s[kt][r] = pv; lsum += pv; }
        lrun = lrun * alpha + lsum;
        if (__any(mx > mold)) {
#pragma unroll
            for (int et = 0; et < 4; ++et)
#pragma unroll
                for (int r = 0; r < 16; ++r) o[et][r] *= alpha;
        }
#pragma unroll
        for (int kt = 0; kt < 2; ++kt) {
#pragma unroll
            for (int st = 0; st < 2; ++st) {
                u32x4 pp;
                pp[0] = pk2(s[kt][8 * st + 0], s[kt][8 * st + 1]); pp[1] = pk2(s[kt][8 * st + 2], s[kt][8 * st + 3]);
                pp[2] = pk2(s[kt][8 * st + 4], s[kt][8 * st + 5]); pp[3] = pk2(s[kt][8 * st + 6], s[kt][8 * st + 7]);
                const bf16x8 pf = __builtin_bit_cast(bf16x8, pp);
#pragma unroll
                for (int et = 0; et < 4; ++et) {
                    const bf16_t* vp = Vc + (et * 32 + c.l31) * 68 + kt * 32 + 16 * st + 4 * c.hl;
                    const u32x2 lo = *(const u32x2*)vp, hi = *(const u32x2*)(vp + 8);
                    u32x4 av; av[0] = lo[0]; av[1] = lo[1]; av[2] = hi[0]; av[3] = hi[1];
                    o[et] = MFMA(__builtin_bit_cast(bf16x8, av), pf, o[et]);
                }
            }
        }
        __syncthreads();
    }
#undef AT_LOAD
#undef AT_STORE
    const float ltot = lrun + __shfl_xor(lrun, 32);
    const float linv = 1.f / ltot;
    float* Oc = (float*)c.smem;
    if (mp == 1) {
#pragma unroll
        for (int et = 0; et < 4; ++et)
#pragma unroll
            for (int r = 0; r < 16; ++r) Oc[(qs * 128 + et * 32 + crow(r, c.hl)) * 32 + c.l31] = o[et][r] * linv;
    }
    __syncthreads();
    if (mp == 0) {
        const float lam = c.cst[l], lam_init = c.cst[2 + l];
        float ss = 0.f;
#pragma unroll
        for (int et = 0; et < 4; ++et)
#pragma unroll
            for (int r = 0; r < 16; ++r) {
                const float d = o[et][r] * linv - lam * Oc[(qs * 128 + et * 32 + crow(r, c.hl)) * 32 + c.l31];
                o[et][r] = d; ss += d * d;
            }
        ss += __shfl_xor(ss, 32);
        const float rn = rsqrtf(ss * (1.f / 128.f) + EPS) * (1.f - lam_init);
        const bf16_t* DG = (const bf16_t*)(c.ws + OFF_DG) + qtok * 512 + h * 128;
        bf16_t* OD = (bf16_t*)(c.ws + OFF_ODIFF) + qtok * 512 + h * 128;
#pragma unroll
        for (int et = 0; et < 4; ++et)
#pragma unroll
            for (int q = 0; q < 4; ++q) {
                const int e0 = et * 32 + 8 * q + 4 * c.hl;
                const u32x2 g = *(const u32x2*)(DG + e0);
                u32x2 ov;
                ov[0] = pk2(o[et][4 * q + 0] * rn * bflo(g[0]), o[et][4 * q + 1] * rn * bfhi(g[0]));
                ov[1] = pk2(o[et][4 * q + 2] * rn * bflo(g[1]), o[et][4 * q + 3] * rn * bfhi(g[1]));
                *(u32x2*)(OD + e0) = ov;
            }
    }
}

DI void scan_item(const Ctx& c, int l, int bl, int h, int dir, int es) {
    const float lg2 = c.cst[4 + l * 8 + dir * 4 + h];
    const float decayC = __builtin_amdgcn_exp2f(lg2 * 128.f);
    f32x16 st;
#pragma unroll
    for (int r = 0; r < 16; ++r) st[r] = 0.f;
    const bf16_t* vt = (const bf16_t*)(c.ws + OFF_RVT) + ((size_t)(bl * 4 + h) * 128 + es * 32 + c.l31) * PP;
    const bf16_t* kt = (const bf16_t*)(c.ws + OFF_RKT) + ((size_t)(bl * 4 + h) * 128 + c.w * 32 + c.l31) * PP;
    bf16_t* stbase = (bf16_t*)(c.ws + OFF_ST) + (size_t)(((bl * 4 + h) * 2 + dir) * NCH) * 16384;
#pragma unroll 1
    for (int step = 0; step < NCH; ++step) {
        const int m = dir == 0 ? step : (step < 2 ? 1 - step : 19 - step);
        bf16_t* sp = stbase + (size_t)m * 16384;
#pragma unroll
        for (int r = 0; r < 16; ++r) sp[(es * 32 + crow(r, c.hl)) * 128 + c.w * 32 + c.l31] = f2bf(st[r]);
        if (step == NCH - 1) break;
#pragma unroll
        for (int r = 0; r < 16; ++r) st[r] *= decayC;
#pragma unroll
        for (int ks = 0; ks < 8; ++ks) {
            const int j0 = ks * 16 + c.hl * 8;
            const u32x4 av = *(const u32x4*)(vt + m * 128 + j0);
            const u32x4 bv = *(const u32x4*)(kt + m * 128 + j0);
            u32x4 as;
#pragma unroll
            for (int e = 0; e < 4; ++e) {
                const int ja = j0 + 2 * e;
                const float e0 = dir == 0 ? (float)(127 - ja) : (float)ja;
                const float e1 = dir == 0 ? (float)(126 - ja) : (float)(ja + 1);
                const float w0 = __builtin_amdgcn_exp2f(lg2 * e0), w1 = __builtin_amdgcn_exp2f(lg2 * e1);
                as[e] = pk2(bflo(av[e]) * w0, bfhi(av[e]) * w1);
            }
            st = MFMA(__builtin_bit_cast(bf16x8, as), __builtin_bit_cast(bf16x8, bv), st);
        }
    }
}

DI void mlp_item(const Ctx& c, int l, int bl, int m, int g) {
    bf16_t* Vn = (bf16_t*)c.smem;
    bf16_t* Wsm = Vn + 128 * 136;
    float* stat = (float*)(Wsm + 128 * 136);
    const size_t tok0 = (size_t)bl * PP + m * 128;
    const bf16_t* MV = (const bf16_t*)(c.ws + OFF_MV);
    __syncthreads();
    for (int rr = 0; rr < 32; ++rr) {
        const int row = c.w * 32 + rr;
        const u32x4 v = *(const u32x4*)(MV + (tok0 + row) * 512 + c.lane * 8);
        float xv[8];
#pragma unroll
        for (int e = 0; e < 4; ++e) { xv[2 * e] = bflo(v[e]); xv[2 * e + 1] = bfhi(v[e]); }
        float s = 0.f;
#pragma unroll
        for (int e = 0; e < 8; ++e) s += xv[e];
        s = wave_sum(s);
        const float mu = s * (1.f / 512.f);
        float ss = 0.f;
#pragma unroll
        for (int e = 0; e < 8; ++e) { const float d = xv[e] - mu; ss += d * d; }
        ss = wave_sum(ss);
        if (c.lane == 0) { stat[row] = mu; stat[128 + row] = rsqrtf(ss * (1.f / 512.f) + EPS); }
    }
    __syncthreads();
#pragma unroll
    for (int it = 0; it < 8; ++it) {
        const int idx = c.tid + 256 * it, j = idx >> 4, seg = idx & 15;
        const u32x4 v = *(const u32x4*)(MV + (tok0 + j) * 512 + g * 128 + seg * 8);
        const float mu = stat[j], rs = stat[128 + j];
#pragma unroll
        for (int e = 0; e < 4; ++e) {
            Vn[(seg * 8 + 2 * e) * 136 + j] = f2bf((bflo(v[e]) - mu) * rs);
            Vn[(seg * 8 + 2 * e + 1) * 136 + j] = f2bf((bfhi(v[e]) - mu) * rs);
        }
    }
    const float* wsrc = c.w_s + (size_t)(l * 4 + g) * 128 * 128;
#pragma unroll
    for (int it = 0; it < 16; ++it) {
        const int idx = c.tid + 256 * it, i = idx >> 5, seg = idx & 31;
        const f32x4 wv = *(const f32x4*)(wsrc + i * 128 + seg * 4);
        u32x2 o; o[0] = pk2(wv[0], wv[1]); o[1] = pk2(wv[2], wv[3]);
        *(u32x2*)(Wsm + i * 136 + seg * 4) = o;
    }
    __syncthreads();
    const int wc = c.w >> 1, wi = c.w & 1;
    f32x16 acc[2][2];
    zero_acc(acc);
#pragma unroll
    for (int ks = 0; ks < 8; ++ks) {
        const bf16x8 a0 = *(const bf16x8*)(Vn + (wc * 64 + c.l31) * 136 + ks * 16 + c.hl * 8);
        const bf16x8 a1 = *(const bf16x8*)(Vn + (wc * 64 + 32 + c.l31) * 136 + ks * 16 + c.hl * 8);
        const bf16x8 b0 = *(const bf16x8*)(Wsm + (wi * 64 + c.l31) * 136 + ks * 16 + c.hl * 8);
        const bf16x8 b1 = *(const bf16x8*)(Wsm + (wi * 64 + 32 + c.l31) * 136 + ks * 16 + c.hl * 8);
        acc[0][0] = MFMA(a0, b0, acc[0][0]); acc[0][1] = MFMA(a0, b1, acc[0][1]);
        acc[1][0] = MFMA(a1, b0, acc[1][0]); acc[1][1] = MFMA(a1, b1, acc[1][1]);
    }
    const bf16_t* MU = (const bf16_t*)(c.ws + OFF_MU);
    const bf16_t* MG = (const bf16_t*)(c.ws + OFF_MG);
    bf16_t* OM = (bf16_t*)(c.ws + OFF_OMLP);
#pragma unroll
    for (int ii = 0; ii < 2; ++ii) {
        const int i = wi * 64 + ii * 32 + c.l31;
        const size_t tok = tok0 + i;
        const float bs = c.b_s[(l * 4 + g) * 128 + i];
#pragma unroll
        for (int ci = 0; ci < 2; ++ci)
#pragma unroll
            for (int q = 0; q < 4; ++q) {
                const int c0 = g * 128 + wc * 64 + ci * 32 + 8 * q + 4 * c.hl;
                const u32x2 u = *(const u32x2*)(MU + tok * 512 + c0), gg = *(const u32x2*)(MG + tok * 512 + c0);
                u32x2 ov;
                ov[0] = pk2(bflo(u[0]) * (acc[ci][ii][4 * q + 0] + bs) * bflo(gg[0]), bfhi(u[0]) * (acc[ci][ii][4 * q + 1] + bs) * bfhi(gg[0]));
                ov[1] = pk2(bflo(u[1]) * (acc[ci][ii][4 * q + 2] + bs) * bflo(gg[1]), bfhi(u[1]) * (acc[ci][ii][4 * q + 3] + bs) * bfhi(gg[1]));
                *(u32x2*)(OM + tok * 512 + c0) = ov;
            }
    }
}

DI void retout_item(const Ctx& c, int l, int bl, int h, int m) {
    bf16_t* Ks = (bf16_t*)c.smem;
    bf16_t* Vs = Ks + 128 * 136;
    const size_t tok0 = (size_t)bl * PP + m * 128;
    const bf16_t* RK = (const bf16_t*)(c.ws + OFF_RK) + tok0 * 512 + h * 128;
    const bf16_t* RVT = (const bf16_t*)(c.ws + OFF_RVT) + (size_t)(bl * 4 + h) * 128 * PP + m * 128;
    __syncthreads();
#pragma unroll
    for (int it = 0; it < 8; ++it) {
        const int idx = c.tid + 256 * it, row = idx >> 4, seg = idx & 15;
        *(u32x4*)(Ks + row * 136 + seg * 8) = *(const u32x4*)(RK + (size_t)row * 512 + seg * 8);
        { const u32x4 vv = *(const u32x4*)(RVT + (size_t)row * PP + seg * 8); u32x2 lo2, hi2; lo2[0] = vv[0]; lo2[1] = vv[1]; hi2[0] = vv[2]; hi2[1] = vv[3];
          *(u32x2*)(Vs + row * 132 + seg * 8) = lo2; *(u32x2*)(Vs + row * 132 + seg * 8 + 4) = hi2; }
    }
    __syncthreads();
    const int i = c.w * 32 + c.l31;
    const size_t tok = tok0 + i;
    const float lgf = c.cst[4 + l * 8 + h], lgb = c.cst[4 + l * 8 + 4 + h];
    bf16x8 qf[8];
    const bf16_t* RQ = (const bf16_t*)(c.ws + OFF_RQ) + tok * 512 + h * 128;
#pragma unroll
    for (int ks = 0; ks < 8; ++ks) qf[ks] = *(const bf16x8*)(RQ + ks * 16 + c.hl * 8);
    f32x16 o[4];
    const bf16_t* stf = (const bf16_t*)(c.ws + OFF_ST) + (size_t)(((bl * 4 + h) * 2 + 0) * NCH + m) * 16384;
    const bf16_t* stb = (const bf16_t*)(c.ws + OFF_ST) + (size_t)(((bl * 4 + h) * 2 + 1) * NCH + m) * 16384;
    const float qdf = __builtin_amdgcn_exp2f(lgf * (float)(i + 1)), qdb = __builtin_amdgcn_exp2f(lgb * (float)(128 - i));
#pragma unroll
    for (int et = 0; et < 4; ++et) {
        f32x16 tf, tb;
#pragma unroll
        for (int r = 0; r < 16; ++r) { tf[r] = 0.f; tb[r] = 0.f; }
#pragma unroll
        for (int ks = 0; ks < 8; ++ks) {
            const bf16x8 a = *(const bf16x8*)(stf + (et * 32 + c.l31) * 128 + ks * 16 + c.hl * 8);
            const bf16x8 b = *(const bf16x8*)(stb + (et * 32 + c.l31) * 128 + ks * 16 + c.hl * 8);
            tf = MFMA(a, qf[ks], tf);
            tb = MFMA(b, qf[ks], tb);
        }
#pragma unroll
        for (int r = 0; r < 16; ++r) o[et][r] = tf[r] * qdf + tb[r] * qdb;
        __builtin_amdgcn_sched_barrier(0);
    }
#pragma unroll
    for (int jt = 0; jt < 4; ++jt) {
        f32x16 sc;
#pragma unroll
        for (int r = 0; r < 16; ++r) sc[r] = 0.f;
#pragma unroll
        for (int ks = 0; ks < 8; ++ks) {
            const bf16x8 a = *(const bf16x8*)(Ks + (jt * 32 + c.l31) * 136 + ks * 16 + c.hl * 8);
            sc = MFMA(a, qf[ks], sc);
        }
#pragma unroll
        for (int r = 0; r < 16; ++r) {
            const int j = jt * 32 + crow(r, c.hl);
            const int dl = i - j;
            const float arg = dl > 0 ? lgf * (float)dl : -lgb * (float)dl;
            float f = __builtin_amdgcn_exp2f(arg);
            f = dl == 0 ? 2.f : f;
            sc[r] *= f;
        }
#pragma unroll
        for (int s2 = 0; s2 < 2; ++s2) {
            u32x4 pp;
            pp[0] = pk2(sc[8 * s2 + 0], sc[8 * s2 + 1]); pp[1] = pk2(sc[8 * s2 + 2], sc[8 * s2 + 3]);
            pp[2] = pk2(sc[8 * s2 + 4], sc[8 * s2 + 5]); pp[3] = pk2(sc[8 * s2 + 6], sc[8 * s2 + 7]);
            const bf16x8 pf = __builtin_bit_cast(bf16x8, pp);
#pragma unroll
            for (int et = 0; et < 4; ++et) {
                const bf16_t* vp = Vs + (et * 32 + c.l31) * 132 + jt * 32 + 16 * s2 + 4 * c.hl;
                const u32x2 lo = *(const u32x2*)vp, hi = *(const u32x2*)(vp + 8);
                u32x4 av; av[0] = lo[0]; av[1] = lo[1]; av[2] = hi[0]; av[3] = hi[1];
                o[et] = MFMA(__builtin_bit_cast(bf16x8, av), pf, o[et]);
            }
        }
        __builtin_amdgcn_sched_barrier(0);
    }
    float ss = 0.f;
#pragma unroll
    for (int et = 0; et < 4; ++et)
#pragma unroll
        for (int r = 0; r < 16; ++r) ss += o[et][r] * o[et][r];
    ss += __shfl_xor(ss, 32);
    const float rn = rsqrtf(ss * (1.f / 128.f) + EPS);
    const bf16_t* RG = (const bf16_t*)(c.ws + OFF_RG) + tok * 512 + h * 128;
    bf16_t* OR = (bf16_t*)(c.ws + OFF_ORET) + tok * 512 + h * 128;
#pragma unroll
    for (int et = 0; et < 4; ++et)
#pragma unroll
        for (int q = 0; q < 4; ++q) {
            const int e0 = et * 32 + 8 * q + 4 * c.hl;
            const u32x2 g = *(const u32x2*)(RG + e0);
            u32x2 ov;
            ov[0] = pk2(o[et][4 * q + 0] * rn * bflo(g[0]), o[et][4 * q + 1] * rn * bfhi(g[0]));
            ov[1] = pk2(o[et][4 * q + 2] * rn * bflo(g[1]), o[et][4 * q + 3] * rn * bfhi(g[1]));
            *(u32x2*)(OR + e0) = ov;
        }
}

DI void pm_item(const Ctx& c, int l, int rt, int nt) {
    f32x16 y[2][2], acc[2][2];
    zero_acc(y);
    const int wn = c.w >> 1, wm = c.w & 1;
    const bf16_t* MLOG = (const bf16_t*)(c.ws + OFF_MLOG);
#pragma unroll 1
    for (int br = 0; br < 3; ++br) {
        const size_t ooff = br == 0 ? OFF_ORET : (br == 1 ? OFF_OMLP : OFF_ODIFF);
        zero_acc(acc);
        gemm_core(c, (const bf16_t*)(c.ws + OFF_WBO) + ((size_t)(l * 3 + br) * 1024 + (size_t)nt * 128) * 512, 512,
                  (const bf16_t*)(c.ws + ooff) + (size_t)rt * 128 * 512, 512, 512, acc);
#pragma unroll
        for (int j = 0; j < 2; ++j) {
            const size_t tok = (size_t)rt * 128 + wm * 64 + j * 32 + c.l31;
#pragma unroll
            for (int i = 0; i < 2; ++i)
#pragma unroll
                for (int q = 0; q < 4; ++q) {
                    const int n0 = nt * 128 + wn * 64 + i * 32 + 8 * q + 4 * c.hl;
                    const u32x2 g = *(const u32x2*)(MLOG + tok * 3072 + br * 1024 + n0);
                    y[i][j][4 * q + 0] += bflo(g[0]) * acc[i][j][4 * q + 0];
                    y[i][j][4 * q + 1] += bfhi(g[0]) * acc[i][j][4 * q + 1];
                    y[i][j][4 * q + 2] += bflo(g[1]) * acc[i][j][4 * q + 2];
                    y[i][j][4 * q + 3] += bfhi(g[1]) * acc[i][j][4 * q + 3];
                }
        }
    }
    bf16_t* Y = (bf16_t*)(c.ws + OFF_Y);
#pragma unroll
    for (int j = 0; j < 2; ++j) {
        const size_t tok = (size_t)rt * 128 + wm * 64 + j * 32 + c.l31;
#pragma unroll
        for (int i = 0; i < 2; ++i)
#pragma unroll
            for (int q = 0; q < 4; ++q) {
                const int n0 = nt * 128 + wn * 64 + i * 32 + 8 * q + 4 * c.hl;
                u32x2 ov; ov[0] = pk2(y[i][j][4 * q + 0], y[i][j][4 * q + 1]); ov[1] = pk2(y[i][j][4 * q + 2], y[i][j][4 * q + 3]);
                *(u32x2*)(Y + tok * 1024 + n0) = ov;
            }
    }
}
DI void po_item(const Ctx& c, int l, int rt2, int nt) {
    f32x16 acc[2][4];
    zero_acc2(acc);
    gemm_core2(c, (const bf16_t*)(c.ws + OFF_WO) + ((size_t)l * 1024 + (size_t)nt * 128) * 1024, 1024,
               (const bf16_t*)(c.ws + OFF_Y) + (size_t)rt2 * 256 * 1024, 1024, 1024, acc);
    const int wn = c.w >> 1, wm = c.w & 1;
    float* OUT = (float*)(c.ws + OFF_OUT);
#pragma unroll
    for (int j = 0; j < 4; ++j) {
        const size_t tok = (size_t)rt2 * 256 + wm * 128 + j * 32 + c.l31;
#pragma unroll
        for (int i = 0; i < 2; ++i)
#pragma unroll
            for (int q = 0; q < 4; ++q) {
                const int n0 = nt * 128 + wn * 64 + i * 32 + 8 * q + 4 * c.hl;
                f32x4 ov; ov[0] = acc[i][j][4 * q + 0]; ov[1] = acc[i][j][4 * q + 1]; ov[2] = acc[i][j][4 * q + 2]; ov[3] = acc[i][j][4 * q + 3];
                *(f32x4*)(OUT + tok * 1024 + n0) = ov;
            }
    }
}

extern __shared__ __attribute__((aligned(16))) unsigned char dynsmem[];
constexpr int LDS_BYTES = 72 * 1024;

DI Ctx mk_ctx(const Params& p, const float* cst, int wv) {
    Ctx c;
    c.x = p.in[0]; c.c = p.in[1]; c.ctx = p.in[2]; c.c_ctx = p.in[3]; c.w_mod = p.in[4]; c.b_mod = p.in[5]; c.g_pre = p.in[6]; c.g_post = p.in[7];
    c.w_in = p.in[8]; c.decay = p.in[9]; c.w_s = p.in[10]; c.b_s = p.in[11]; c.lq = p.in[12]; c.lk = p.in[13]; c.w_bo = p.in[14]; c.w_out = p.in[15];
    c.out = p.out; c.ws = p.ws; c.smem = dynsmem; c.cst = cst;
    unsigned zl = 0u;
    asm volatile("" : "+v"(zl));
    int tid = wv * 64 + (int)__builtin_amdgcn_mbcnt_hi(~0u, __builtin_amdgcn_mbcnt_lo(~0u, zl));
    asm volatile("" : "+v"(tid));
    size_t zoff = 0;
    asm volatile("" : "+s"(zoff));
    c.ws = p.ws + zoff;
    c.tid = tid; c.lane = tid & 63; c.w = tid >> 6; c.l31 = c.lane & 31; c.hl = c.lane >> 5;
    return c;
}
DI void relaunder(Ctx& c) {
    int t = c.tid;
    asm volatile("" : "+v"(t));
    c.tid = t; c.lane = t & 63; c.w = t >> 6; c.l31 = c.lane & 31; c.hl = c.lane >> 5;
}

__global__ void __launch_bounds__(256, 2) mega(Params p) {
    __shared__ uint4 xbw;
    __shared__ float cst[32];
    const int wv = __builtin_amdgcn_readfirstlane((int)threadIdx.x >> 6);
    Ctx c = mk_ctx(p, cst, wv);
    if (c.tid == 0) xbw = make_uint4(0u, 0u, 0u, 0u);
    if (c.tid < 64) {
        for (int l = 0; l < 2; ++l) {
            float a = c.lq[(l * 2 + 0) * 64 + c.tid] * c.lk[(l * 2 + 0) * 64 + c.tid];
            float b = c.lq[(l * 2 + 1) * 64 + c.tid] * c.lk[(l * 2 + 1) * 64 + c.tid];
            a = wave_sum(a); b = wave_sum(b);
            const float lam_init = 0.8f - 0.6f * expf(-0.3f * (float)l);
            if (c.tid == 0) { cst[l] = expf(a) - expf(b) + lam_init; cst[2 + l] = lam_init; }
        }
        if (c.tid < 16) {
            const float z = c.decay[c.tid];
            cst[4 + c.tid] = -log1pf(expf(-z)) * LOG2E;
        }
    }
    __syncthreads();
    XcdBarrier bar = xcd_barrier_post((unsigned*)(p.ws + OFF_BAR), (volatile LAS unsigned*)&xbw, c.tid == 0);
    const int G = gridDim.x, bid = blockIdx.x;
    constexpr int NPH = 2 + NGRP * 12;
#pragma unroll 1
    for (int ph = 0; ph < NPH; ++ph) {
        c = mk_ctx(p, cst, wv);
        int kind, g = 0, l = 0;
        if (ph == 0) kind = 0;
        else if (ph == 1) kind = 1;
        else { const int q = ph - 2; g = q / 12; const int r = q % 12; l = r / 6; kind = 2 + r % 6; }
#ifndef ECHO_KIND
#define ECHO_KIND -1
#endif
        const unsigned long long tph0 = (ECHO_KIND >= 0) ? __builtin_amdgcn_s_memrealtime() : 0ull;
        switch (kind) {
        case 0:
#pragma unroll 1
            for (int it = bid; it < 2 * 1408 + 192; it += G) { relaunder(c); p0_item(c, it); }
            break;
        case 1:
#pragma unroll 1
            for (int it = bid; it < NT / 4; it += G) { relaunder(c); ph_item(c, g, it); }
            break;
        case 2:
            if ((G & 7) == 0) {
                const int x = bid & 7, jl = bid >> 3, GL = G >> 3;
#pragma unroll 1
                for (int k = jl; k < 306; k += GL) {
                    int ct, rt2;
                    if (k < 288) { ct = 8 * (k & 7) + x; rt2 = k >> 3; }
                    else { ct = 64 + (x >> 1); rt2 = (x & 1) * 18 + (k - 288); }
                    if (l == 1 && (rt2 % 9) == 0 && ct >= 16) continue;
                    relaunder(c);
                    pz_item(c, l, rt2, ct);
                }
            } else {
#pragma unroll 1
                for (int it = bid; it < 36 * 68; it += G) {
                    const int ct = it % 68, rt2 = it / 68;
                    if (l == 1 && (rt2 % 9) == 0 && ct >= 16) continue;
                    relaunder(c);
                    pz_item(c, l, rt2, ct);
                }
            }
            break;
        case 3: {
            const int n_att = 512, n_catt = (l == 0) ? 64 : 0, n_scan = 128, n_mlp = (l == 0) ? 288 : 256;
            const int total = n_att + n_catt + n_scan + n_mlp;
#pragma unroll 1
            for (int it = bid; it < total; it += G) {
                int r = it;
                relaunder(c);
                if (r < n_att + n_catt) {
                    int bl, h, q0, nk;
                    if (r < n_att) { bl = r >> 7; h = (r >> 5) & 3; q0 = CTXL + (r & 31) * 64; nk = PP; }
                    else { r -= n_att; bl = r >> 4; h = (r >> 2) & 3; q0 = (r & 3) * 64; nk = CTXL; }
                    attn_item(c, l, bl, h, q0, nk);
                    continue;
                }
                r -= n_att + n_catt;
                if (r < n_scan) { const int bl = r >> 5, h = (r >> 3) & 3, dir = (r >> 2) & 1, es = r & 3; scan_item(c, l, bl, h, dir, es); continue; }
                r -= n_scan;
                int bl, m, gg;
                if (l == 0) { bl = r / 72; const int q = r % 72; m = q >> 2; gg = q & 3; }
                else { bl = r >> 6; const int q = r & 63; m = 2 + (q >> 2); gg = q & 3; }
                mlp_item(c, l, bl, m, gg);
            }
            break; }
        case 4: {
            const int total = (l == 0) ? 288 : 256;
#pragma unroll 1
            for (int it = bid; it < total; it += G) {
                int bl, m, h;
                if (l == 0) { bl = it / 72; const int q = it % 72; h = q & 3; m = q >> 2; }
                else { bl = it >> 6; const int q = it & 63; h = q & 3; m = 2 + (q >> 2); }
                relaunder(c);
                retout_item(c, l, bl, h, m);
            }
            break; }
        case 5: {
            const int nrt = (l == 0) ? 72 : 64;
#pragma unroll 1
            for (int it = bid; it < nrt * 8; it += G) {
                const int nt = it & 7, rr = it >> 3;
                const int rt = (l == 0) ? rr : (rr >> 4) * NCH + 2 + (rr & 15);
                relaunder(c);
                pm_item(c, l, rt, nt);
            }
            break; }
        case 6: {
            const int nrt = (l == 0) ? 72 : 64;
#pragma unroll 1
            for (int it = bid; it < (nrt / 2) * 8; it += G) {
                const int nt = it & 7, rr = it >> 3;
                const int rt2 = (l == 0) ? rr : (rr >> 3) * 9 + 1 + (rr & 7);
                relaunder(c);
                po_item(c, l, rt2, nt);
            }
            break; }
        default:
#pragma unroll 1
            for (int it = bid; it < NT / 4; it += G) { relaunder(c); pr_item(c, l, g, it); }
            if (g + 1 < NGRP && l == 1) {
#pragma unroll 1
                for (int it = bid; it < NT / 4; it += G) { relaunder(c); ph_item(c, g + 1, it); }
            }
            break;
        }
        if (ECHO_KIND >= 0 && kind == ECHO_KIND) { __syncthreads(); const unsigned long long tb = __builtin_amdgcn_s_memrealtime(), dt = tb - tph0; while (__builtin_amdgcn_s_memrealtime() - tb < dt) __builtin_amdgcn_s_sleep(8); }
        if (ph + 1 < NPH) xcd_barrier(bar, c.tid == 0);
    }
}

extern "C" void kernel_launch(void* const* d_in, const int* in_sizes, int n_in, void* d_out, int out_size, void* d_ws, size_t ws_size, hipStream_t stream) {
    static int grid = 0;
    if (grid == 0) {
        int dev = 0, cus = 0, per_cu = 0;
        hipGetDevice(&dev);
        hipDeviceGetAttribute(&cus, hipDeviceAttributeMultiprocessorCount, dev);
        hipFuncSetAttribute((const void*)mega, hipFuncAttributeMaxDynamicSharedMemorySize, LDS_BYTES);
        hipOccupancyMaxActiveBlocksPerMultiprocessor(&per_cu, (const void*)mega, 256, LDS_BYTES);
        if (per_cu > 2) per_cu = 2;
        if (per_cu < 1) per_cu = 1;
        grid = cus * per_cu;
        if (ws_size < WS_END) { fprintf(stderr, "workspace too small: %zu < %zu\n", ws_size, (size_t)WS_END); grid = -1; }
    }
    if (grid < 0) return;
    hipMemsetAsync((unsigned char*)d_ws + OFF_BAR, 0, XCD_BAR_WORDS * 4, stream);
    Params p{};
    for (int i = 0; i < 16; ++i) p.in[i] = (const float*)d_in[i];
    p.out = (float*)d_out; p.ws = (unsigned char*)d_ws;
    void* args[] = {&p};
    hipError_t e = hipLaunchCooperativeKernel((const void*)mega, dim3(grid), dim3(256), args, LDS_BYTES, stream);
    if (e != hipSuccess) fprintf(stderr, "cooperative launch failed: %s (grid %d)\n", hipGetErrorString(e), grid);
}
```

```cpp
#include <hip/hip_runtime.h>
#include <cstdio>
#include <cstdint>

#define DI __device__ __forceinline__
#define LAS __attribute__((address_space(3)))
typedef unsigned short bf16_t;
typedef short bf16x8 __attribute__((ext_vector_type(8)));
typedef float f32x16 __attribute__((ext_vector_type(16)));
typedef float f32x4 __attribute__((ext_vector_type(4)));
typedef float f32x2 __attribute__((ext_vector_type(2)));
typedef unsigned u32x4 __attribute__((ext_vector_type(4)));
typedef unsigned u32x2 __attribute__((ext_vector_type(2)));
#define MFMA(a, b, c) __builtin_amdgcn_mfma_f32_32x32x16_bf16((a), (b), (c), 0, 0, 0)

#define XB_TMO      128
#define XB_XCNT(j)  (256  + 64 * (j))
#define XB_XSUB(j)  (1280 + 64 * (j))
#define XB_XGEN(j)  (2304 + 64 * (j))
#define XB_TOP      3328
#define XB_TOPGEN   3392
#define XCD_BAR_WORDS 3456
#define XB_SPIN_CAP (1u << 22)
DI unsigned xb_ld(unsigned* p)              { return __hip_atomic_load(p, __ATOMIC_RELAXED, __HIP_MEMORY_SCOPE_AGENT); }
DI unsigned xb_add(unsigned* p, unsigned v) { return __hip_atomic_fetch_add(p, v, __ATOMIC_RELAXED, __HIP_MEMORY_SCOPE_AGENT); }
DI unsigned xb_xcc_id() { return (unsigned)__builtin_amdgcn_s_getreg((3 << 11) | 20) & 0xFu; }
#define XB_SPIN(cond, bar) do { unsigned _sp = 0; while (cond) { __builtin_amdgcn_s_sleep(1); \
    if ((++_sp & 255u) == 0u) { if (xb_ld(&(bar)[XB_TMO])) break; if (_sp > XB_SPIN_CAP) { atomicAdd(&(bar)[XB_TMO], 1u); break; } } } } while (0)
struct XcdBarrier { unsigned* bar; unsigned x; volatile LAS unsigned* st; };
DI XcdBarrier xcd_barrier_post(unsigned* bar, volatile LAS unsigned* st, bool t0) {
    XcdBarrier b; b.bar = bar; b.x = xb_xcc_id(); b.st = st;
    if (t0) (void)xb_add(&bar[XB_XCNT(b.x)], 1u);
    return b;
}
DI void xcd_barrier_complete(unsigned* bar, unsigned x, unsigned& nloc, unsigned& nx) {
    const unsigned G = gridDim.x * gridDim.y * gridDim.z;
    unsigned sum, cnt, mine, sp = 0u;
    for (;;) {
        sum = 0u; cnt = 0u; mine = 0u;
#pragma unroll
        for (unsigned j = 0; j < 16; ++j) { const unsigned c = xb_ld(&bar[XB_XCNT(j)]); sum += c; cnt += (c > 0u) ? 1u : 0u; mine = (j == x) ? c : mine; }
        if (sum == G) break;
        __builtin_amdgcn_s_sleep(1);
        if ((++sp & 255u) == 0u) { if (xb_ld(&bar[XB_TMO])) break; if (sp > XB_SPIN_CAP) { atomicAdd(&bar[XB_TMO], 1u); break; } }
    }
    nloc = mine > 0u ? mine : 1u; nx = cnt > 0u ? cnt : 1u;
}
DI void xcd_barrier(const XcdBarrier& b, bool t0) {
    asm volatile("s_waitcnt vmcnt(0)" ::: "memory");
    __syncthreads();
    if (t0) {
        unsigned* bar = b.bar;
        __builtin_amdgcn_s_waitcnt(0);
        unsigned nloc = b.st[0], nx = b.st[1];
        if (nloc == 0u) { xcd_barrier_complete(bar, b.x, nloc, nx); b.st[0] = nloc; b.st[1] = nx; }
        const unsigned old = xb_add(&bar[XB_XSUB(b.x)], 1u);
        const unsigned gen = old / nloc;
        if (old + 1u == (gen + 1u) * nloc) {
            __builtin_amdgcn_fence(__ATOMIC_RELEASE, "agent");
            asm volatile("s_waitcnt vmcnt(0)" ::: "memory");
            const unsigned og = xb_add(&bar[XB_TOP], 1u);
            const unsigned tg = og / nx;
            if (og + 1u == (tg + 1u) * nx) xb_add(&bar[XB_TOPGEN], 1u);
            else XB_SPIN(xb_ld(&bar[XB_TOPGEN]) == tg, bar);
            __builtin_amdgcn_fence(__ATOMIC_ACQUIRE, "agent");
            xb_add(&bar[XB_XGEN(b.x)], 1u);
            asm volatile("s_waitcnt vmcnt(0)" ::: "memory");
        } else {
            XB_SPIN(xb_ld(&bar[XB_XGEN(b.x)]) == gen, bar);
            __builtin_amdgcn_fence(__ATOMIC_ACQUIRE, "agent");
            asm volatile("s_waitcnt vmcnt(0)" ::: "memory");
        }
    }
    __syncthreads();
}

constexpr int DM = 1024, SEQL = 2048, CTXL = 256, PP = 2304  ;
constexpr int NBG = 4  , NGRP = 2, NT = NBG * PP  ;
constexpr int INC = 8704, NCH = 18  ;
constexpr int LDH = 1088, LDW = 1088;
constexpr float EPS = 1e-6f;
constexpr float LOG2E = 1.4426950408889634f;

constexpr size_t TB = (size_t)NT * 512 * 2;
constexpr size_t OFF_BAR = 0;
constexpr size_t OFF_MOD = 16384;
constexpr size_t OFF_WIN = OFF_MOD + 262144;
constexpr size_t OFF_WBO = OFF_WIN + (size_t)2 * INC * LDW * 2;
constexpr size_t OFF_WO  = OFF_WBO + (size_t)2 * 3 * 1024 * 512 * 2;
constexpr size_t OFF_H   = OFF_WO + (size_t)2 * 1024 * 1024 * 2;
constexpr size_t OFF_RK  = OFF_H + (size_t)NT * LDH * 2;
constexpr size_t OFF_RKT = OFF_RK + TB;
constexpr size_t OFF_RVT = OFF_RKT + TB;
constexpr size_t OFF_DK  = OFF_RVT + TB;
constexpr size_t OFF_DVT = OFF_DK + TB;
constexpr size_t OFF_RQ  = OFF_DVT + TB;
constexpr size_t OFF_RG  = OFF_RQ + TB;
constexpr size_t OFF_DQ  = OFF_RG + TB;
constexpr size_t OFF_DG  = OFF_DQ + TB;
constexpr size_t OFF_MU  = OFF_DG + TB;
constexpr size_t OFF_MV  = OFF_MU + TB;
constexpr size_t OFF_MG  = OFF_MV + TB;
constexpr size_t OFF_MLOG = OFF_MG + TB;
constexpr size_t OFF_OMLP = OFF_MLOG + 6 * TB;
constexpr size_t OFF_ODIFF = OFF_OMLP + TB;
constexpr size_t OFF_ROPE = OFF_ODIFF + TB;
constexpr size_t WS_END = OFF_ROPE + (size_t)2048 * 96 * 8;
constexpr size_t OFF_ST = OFF_H;
constexpr size_t OFF_ORET = OFF_DK;
constexpr size_t OFF_Y = OFF_RK;
constexpr size_t OFF_OUT = OFF_MLOG;

struct Params {
    const float* in[16];
    float* out;
    unsigned char* ws;
};

struct Ctx {
    const float *x, *c, *ctx, *c_ctx, *w_mod, *b_mod, *g_pre, *g_post, *w_in, *decay, *w_s, *b_s, *lq, *lk, *w_bo, *w_out;
    float* out;
    unsigned char* ws;
    unsigned char* smem;
    const float* cst;
    int tid, lane, w, l31, hl;
};

DI unsigned pk2(float lo, float hi) {
    typedef __bf16 b2 __attribute__((ext_vector_type(2)));
    f32x2 v = {lo, hi};
    b2 r = __builtin_convertvector(v, b2);
    return __builtin_bit_cast(unsigned, r);
}
DI bf16_t f2bf(float x) { return (bf16_t)(pk2(x, 0.f) & 0xffffu); }
DI float bflo(unsigned u) { return __uint_as_float(u << 16); }
DI float bfhi(unsigned u) { return __uint_as_float(u & 0xffff0000u); }
DI int crow(int r, int hl) { return (r & 3) + 8 * (r >> 2) + 4 * hl; }
DI float wave_sum(float v) {
#pragma unroll
    for (int o = 1; o < 64; o <<= 1) v += __shfl_xor(v, o);
    return v;
}
DI float fsig(float x) { return __builtin_amdgcn_rcpf(1.f + __builtin_amdgcn_exp2f(-LOG2E * x)); }
DI void sincos_rev(float rev, float& sn, float& cs) {
    const float g = __builtin_amdgcn_fractf(rev) - 0.5f;
    const bool fold = fabsf(g) > 0.25f;
    const float h = fold ? (copysignf(0.5f, g) - g) : g;
    const float x = h * 6.283185307179586f;
    const float x2 = x * x;
    const float sp = x * (1.f + x2 * (-1.6666667e-1f + x2 * (8.3333333e-3f + x2 * (-1.9841270e-4f + x2 * (2.7557319e-6f - x2 * 2.5052108e-8f)))));
    const float cp = 1.f + x2 * (-0.5f + x2 * (4.1666667e-2f + x2 * (-1.3888889e-3f + x2 * (2.4801587e-5f + x2 * (-2.7557319e-7f + x2 * 2.0876757e-9f)))));
    sn = -sp;
    cs = fold ? cp : -cp;
}
DI float silu_f(float x) { return x / (1.f + __expf(-x)); }
DI float sigmoid_f(float x) { return 1.f / (1.f + __expf(-x)); }

DI void gemm_core(const Ctx& c, const bf16_t* __restrict__ Wt, int ldw, const bf16_t* __restrict__ Act, int lda, int K, f32x16 (&acc)[2][2]) {
    bf16_t* Ws = (bf16_t*)c.smem;
    bf16_t* As = Ws + 128 * 72;
    const int wn = c.w >> 1, wm = c.w & 1;
    const int lrow = c.tid >> 3, lseg = c.tid & 7;
    u32x4 rw[4], ra[4];
#pragma unroll
    for (int it = 0; it < 4; ++it) {
        rw[it] = *(const u32x4*)(Wt + (size_t)(lrow + 32 * it) * ldw + lseg * 8);
        ra[it] = *(const u32x4*)(Act + (size_t)(lrow + 32 * it) * lda + lseg * 8);
    }
    for (int k0 = 0; k0 < K; k0 += 64) {
        __syncthreads();
#pragma unroll
        for (int it = 0; it < 4; ++it) {
            *(u32x4*)(Ws + (lrow + 32 * it) * 72 + lseg * 8) = rw[it];
            *(u32x4*)(As + (lrow + 32 * it) * 72 + lseg * 8) = ra[it];
        }
        __syncthreads();
        if (k0 + 64 < K) {
#pragma unroll
            for (int it = 0; it < 4; ++it) {
                rw[it] = *(const u32x4*)(Wt + (size_t)(lrow + 32 * it) * ldw + k0 + 64 + lseg * 8);
                ra[it] = *(const u32x4*)(Act + (size_t)(lrow + 32 * it) * lda + k0 + 64 + lseg * 8);
            }
        }
#pragma unroll
        for (int ks = 0; ks < 4; ++ks) {
            const bf16x8 a0 = *(const bf16x8*)(Ws + (wn * 64 + c.l31) * 72 + ks * 16 + c.hl * 8);
            const bf16x8 a1 = *(const bf16x8*)(Ws + (wn * 64 + 32 + c.l31) * 72 + ks * 16 + c.hl * 8);
            const bf16x8 b0 = *(const bf16x8*)(As + (wm * 64 + c.l31) * 72 + ks * 16 + c.hl * 8);
            const bf16x8 b1 = *(const bf16x8*)(As + (wm * 64 + 32 + c.l31) * 72 + ks * 16 + c.hl * 8);
            acc[0][0] = MFMA(a0, b0, acc[0][0]);
            acc[0][1] = MFMA(a0, b1, acc[0][1]);
            acc[1][0] = MFMA(a1, b0, acc[1][0]);
            acc[1][1] = MFMA(a1, b1, acc[1][1]);
        }
    }
}
DI void zero_acc(f32x16 (&acc)[2][2]) {
#pragma unroll
    for (int i = 0; i < 2; ++i)
#pragma unroll
        for (int j = 0; j < 2; ++j)
#pragma unroll
            for (int r = 0; r < 16; ++r) acc[i][j][r] = 0.f;
}


DI void gemm_core2(const Ctx& c, const bf16_t* __restrict__ Wt, int ldw, const bf16_t* __restrict__ Act, int lda, int K, f32x16 (&acc)[2][4]) {
    constexpr int RS = 32;
    constexpr int STG = 384 * RS;
    bf16_t* S = (bf16_t*)c.smem;
    const int wn = c.w >> 1, wm = c.w & 1;
    const int lrow = c.tid >> 2, lseg = c.tid & 3;
    const int scol = (lseg ^ ((c.tid >> 4) & 3)) * 8;
    const int rsw = (c.l31 >> 2) & 3;
    const bf16_t* wp = Wt + (size_t)lrow * ldw + lseg * 8;
    const bf16_t* ap = Act + (size_t)lrow * lda + lseg * 8;
    u32x4 rw[2], ra[4];
#pragma unroll
    for (int it = 0; it < 2; ++it) rw[it] = *(const u32x4*)(wp + (size_t)(64 * it) * ldw);
#pragma unroll
    for (int it = 0; it < 4; ++it) ra[it] = *(const u32x4*)(ap + (size_t)(64 * it) * lda);
    __syncthreads();
#pragma unroll
    for (int it = 0; it < 2; ++it) *(u32x4*)(S + (lrow + 64 * it) * RS + scol) = rw[it];
#pragma unroll
    for (int it = 0; it < 4; ++it) *(u32x4*)(S + (128 + lrow + 64 * it) * RS + scol) = ra[it];
    if (K > 32) {
#pragma unroll
        for (int it = 0; it < 2; ++it) rw[it] = *(const u32x4*)(wp + (size_t)(64 * it) * ldw + 32);
#pragma unroll
        for (int it = 0; it < 4; ++it) ra[it] = *(const u32x4*)(ap + (size_t)(64 * it) * lda + 32);
    }
    __syncthreads();
    for (int k0 = 0; k0 < K; k0 += 32) {
        const int s = (k0 >> 5) & 1;
        bf16_t* Sc = S + s * STG;
        bf16_t* Sn = S + (s ^ 1) * STG;
        if (k0 + 32 < K) {
#pragma unroll
            for (int it = 0; it < 2; ++it) *(u32x4*)(Sn + (lrow + 64 * it) * RS + scol) = rw[it];
#pragma unroll
            for (int it = 0; it < 4; ++it) *(u32x4*)(Sn + (128 + lrow + 64 * it) * RS + scol) = ra[it];
            if (k0 + 64 < K) {
#pragma unroll
                for (int it = 0; it < 2; ++it) rw[it] = *(const u32x4*)(wp + (size_t)(64 * it) * ldw + k0 + 64);
#pragma unroll
                for (int it = 0; it < 4; ++it) ra[it] = *(const u32x4*)(ap + (size_t)(64 * it) * lda + k0 + 64);
            }
        }
#pragma unroll
        for (int ks = 0; ks < 2; ++ks) {
            const int rcol = ((ks * 2 + c.hl) ^ rsw) * 8;
            bf16x8 a[2], b[4];
#pragma unroll
            for (int i = 0; i < 2; ++i) a[i] = *(const bf16x8*)(Sc + (wn * 64 + i * 32 + c.l31) * RS + rcol);
#pragma unroll
            for (int j = 0; j < 4; ++j) b[j] = *(const bf16x8*)(Sc + (128 + wm * 128 + j * 32 + c.l31) * RS + rcol);
#pragma unroll
            for (int i = 0; i < 2; ++i)
#pragma unroll
                for (int j = 0; j < 4; ++j) acc[i][j] = MFMA(a[i], b[j], acc[i][j]);
        }
        __syncthreads();
    }
}
DI void zero_acc2(f32x16 (&acc)[2][4]) {
#pragma unroll
    for (int i = 0; i < 2; ++i)
#pragma unroll
        for (int j = 0; j < 4; ++j)
#pragma unroll
            for (int r = 0; r < 16; ++r) acc[i][j][r] = 0.f;
}

DI void transpose_item(const Ctx& c, const float* __restrict__ src, int N, int k0, int n0, int mapk, bf16_t* __restrict__ dst, int ldk) {
    float* T = (float*)c.smem;
    __syncthreads();
#pragma unroll
    for (int it = 0; it < 8; ++it) {
        const int idx = c.tid + 256 * it, r = idx >> 5, c4 = idx & 31;
        const f32x4 v = *(const f32x4*)(src + (size_t)(k0 + r) * N + n0 + c4 * 4);
        float* t = T + r * 129 + c4 * 4;
        t[0] = v[0]; t[1] = v[1]; t[2] = v[2]; t[3] = v[3];
    }
    __syncthreads();
#pragma unroll
    for (int it = 0; it < 4; ++it) {
        const int idx = c.tid + 256 * it, np = idx >> 3, ch = idx & 7;
        int cs = np;
        if (mapk == 1) cs = (np >> 1) + 64 * (np & 1);
        else if (mapk == 2) { const int r = np & 63; cs = (np & 64) + (r >> 1) + 32 * (r & 1); }
        const float* t = T + (ch * 8) * 129 + cs;
        u32x4 o;
        o[0] = pk2(t[0], t[129]); o[1] = pk2(t[2 * 129], t[3 * 129]); o[2] = pk2(t[4 * 129], t[5 * 129]); o[3] = pk2(t[6 * 129], t[7 * 129]);
        *(u32x4*)(dst + (size_t)(n0 + np) * ldk + k0 + ch * 8) = o;
    }
}
DI void mod_item(const Ctx& c, int l, int jb) {
    float* sv = (float*)c.smem;
    float* red = sv + 9 * 1024;
    __syncthreads();
    for (int idx = c.tid; idx < 9216; idx += 256) {
        const int v = idx >> 10, k = idx & 1023;
        const float x = v < 8 ? c.c[v * 1024 + k] : c.c_ctx[k];
        sv[idx] = x / (1.f + expf(-x));
    }
    __syncthreads();
    const int kk = c.tid >> 5, jj = c.tid & 31, j = jb * 32 + jj;
    float a[9];
#pragma unroll
    for (int v = 0; v < 9; ++v) a[v] = 0.f;
    const float* wp = c.w_mod + (size_t)l * 1024 * 3072 + j;
#pragma unroll 4
    for (int i = 0; i < 128; ++i) {
        const int k = kk + 8 * i;
        const float wv = wp[(size_t)k * 3072];
#pragma unroll
        for (int v = 0; v < 9; ++v) a[v] += sv[v * 1024 + k] * wv;
    }
#pragma unroll
    for (int v = 0; v < 9; ++v) red[(kk * 9 + v) * 32 + jj] = a[v];
    __syncthreads();
    float* MOD = (float*)(c.ws + OFF_MOD);
    for (int idx = c.tid; idx < 288; idx += 256) {
        const int v = idx >> 5, j2 = idx & 31;
        float s = 0.f;
#pragma unroll
        for (int k2 = 0; k2 < 8; ++k2) s += red[(k2 * 9 + v) * 32 + j2];
        MOD[(size_t)(l * 9 + v) * 3072 + jb * 32 + j2] = s + c.b_mod[l * 3072 + jb * 32 + j2];
    }
}

DI void rope_item(const Ctx& c, int it) {
    constexpr float L2B = 13.287712379549449f;
    f32x2* T = (f32x2*)(c.ws + OFF_ROPE);
#pragma unroll 1
    for (int e = 0; e < 8; ++e) {
        const int idx = (it * 8 + e) * 256 + c.tid;
        const int lp = idx / 96, a = idx % 96;
        const float rowp = (float)(lp >> 6), colp = (float)(lp & 63);
        float ang;
        if (a < 64) { const int f = a & 31; ang = (a < 32 ? rowp : colp) * exp2f(-(float)f * (L2B / 32.f)); }
        else { const int a2 = a - 64, f = a2 & 15; ang = (a2 < 16 ? rowp : colp) * exp2f(-(float)f * (L2B / 16.f)); }
        f32x2 v; v[0] = cosf(ang); v[1] = sinf(ang);
        T[idx] = v;
    }
}
DI void p0_item(const Ctx& c, int it) {
    if (it < 2 * 1408) {
        const int l = it / 1408; int r = it % 1408;
        if (r < 1088) {
            const int ct = r % 68, kb = r / 68;
            const int kind = ct >> 2;
            const int mapk = (kind == 0 || kind == 4) ? 1 : ((kind == 2 || kind == 6) ? 2 : 0);
            transpose_item(c, c.w_in + (size_t)l * 1024 * INC, INC, kb * 64, ct * 128, mapk, (bf16_t*)(c.ws + OFF_WIN) + (size_t)l * INC * LDW, LDW);
            return;
        }
        r -= 1088;
        if (r < 192) {
            const int br = r / 64, q = r % 64, kb = q >> 3, nb = q & 7;
            transpose_item(c, c.w_bo + (size_t)(l * 3 + br) * 512 * 1024, 1024, kb * 64, nb * 128, 0,
                           (bf16_t*)(c.ws + OFF_WBO) + (size_t)(l * 3 + br) * 1024 * 512, 512);
            return;
        }
        r -= 192;
        { const int kb = r >> 3, nb = r & 7;
          transpose_item(c, c.w_out + (size_t)l * 1024 * 1024, 1024, kb * 64, nb * 128, 0, (bf16_t*)(c.ws + OFF_WO) + (size_t)l * 1024 * 1024, 1024); }
        return;
    }
    it -= 2 * 1408;
    mod_item(c, it / 96, it % 96);
}

DI void modulate_row(const f32x4 (&x)[4], const float* gpre, const float* mod  , bf16_t* hrow, int lane) {
    float ss = 0.f;
#pragma unroll
    for (int j = 0; j < 4; ++j) ss += x[j][0] * x[j][0] + x[j][1] * x[j][1] + x[j][2] * x[j][2] + x[j][3] * x[j][3];
    ss = wave_sum(ss);
    const float r = rsqrtf(ss * (1.f / 1024.f) + EPS);
#pragma unroll
    for (int j = 0; j < 4; ++j) {
        const int col = lane * 4 + 256 * j;
        const f32x4 g = *(const f32x4*)(gpre + col), sh = *(const f32x4*)(mod + col), sc = *(const f32x4*)(mod + 1024 + col);
        f32x4 h;
#pragma unroll
        for (int e = 0; e < 4; ++e) h[e] = x[j][e] * r * g[e] * (1.f + sc[e]) + sh[e];
        u32x2 o; o[0] = pk2(h[0], h[1]); o[1] = pk2(h[2], h[3]);
        *(u32x2*)(hrow + col) = o;
    }
}
DI void ph_item(const Ctx& c, int g, int item) {
    const int tok = item * 4 + c.w, bl = tok / PP, p = tok % PP, b = g * NBG + bl;
    const float* src = p < CTXL ? c.ctx + ((size_t)b * CTXL + p) * DM : c.x + ((size_t)b * SEQL + (p - CTXL)) * DM;
    f32x4 x[4];
#pragma unroll
    for (int j = 0; j < 4; ++j) x[j] = *(const f32x4*)(src + c.lane * 4 + 256 * j);
    const float* mod = (const float*)(c.ws + OFF_MOD) + (size_t)(0 * 9 + (p < CTXL ? 8 : b)) * 3072;
    modulate_row(x, c.g_pre, mod, (bf16_t*)(c.ws + OFF_H) + (size_t)tok * LDH, c.lane);
}
DI void pr_item(const Ctx& c, int l, int g, int item) {
    const int tok = item * 4 + c.w, bl = tok / PP, p = tok % PP, b = g * NBG + bl;
    if (l == 1 && p < CTXL) return;
    const float* orow = (const float*)(c.ws + OFF_OUT) + (size_t)tok * DM;
    const int v = p < CTXL ? 8 : b;
    const float* mod = (const float*)(c.ws + OFF_MOD) + (size_t)(l * 9 + v) * 3072;
    float* xo_lat = c.out + ((size_t)b * SEQL + (p - CTXL)) * DM;
    const float* xold = p < CTXL ? c.ctx + ((size_t)b * CTXL + p) * DM : (l == 0 ? c.x + ((size_t)b * SEQL + (p - CTXL)) * DM : xo_lat);
    f32x4 o[4]; float ss = 0.f;
#pragma unroll
    for (int j = 0; j < 4; ++j) { o[j] = *(const f32x4*)(orow + c.lane * 4 + 256 * j); ss += o[j][0] * o[j][0] + o[j][1] * o[j][1] + o[j][2] * o[j][2] + o[j][3] * o[j][3]; }
    ss = wave_sum(ss);
    const float r = rsqrtf(ss * (1.f / 1024.f) + EPS);
    f32x4 xn[4];
#pragma unroll
    for (int j = 0; j < 4; ++j) {
        const int col = c.lane * 4 + 256 * j;
        const f32x4 gp = *(const f32x4*)(c.g_post + l * 1024 + col), gt = *(const f32x4*)(mod + 2048 + col), xv = *(const f32x4*)(xold + col);
#pragma unroll
        for (int e = 0; e < 4; ++e) xn[j][e] = xv[e] + gt[e] * (o[j][e] * r * gp[e]);
        if (p >= CTXL) *(f32x4*)(xo_lat + col) = xn[j];
    }
    if (l == 0) {
        const float* mod1 = (const float*)(c.ws + OFF_MOD) + (size_t)(1 * 9 + v) * 3072;
        modulate_row(xn, c.g_pre + 1024, mod1, (bf16_t*)(c.ws + OFF_H) + (size_t)tok * LDH, c.lane);
    }
}

DI void pz_item(const Ctx& c, int l, int rt2, int ct) {
    f32x16 acc[2][4];
    zero_acc2(acc);
    gemm_core2(c, (const bf16_t*)(c.ws + OFF_WIN) + ((size_t)l * INC + (size_t)ct * 128) * LDW, LDW,
               (const bf16_t*)(c.ws + OFF_H) + (size_t)rt2 * 256 * LDH, LDH, 1024, acc);
    const int wn = c.w >> 1, wm = c.w & 1;
    const int bl = rt2 / 9, pt2 = rt2 % 9;
    const int kind = ct >> 2, h = ct & 3;
    const bool roped = (kind == 0 || kind == 4 || kind == 2 || kind == 6);
    const bool retk = (kind == 0 || kind == 4);
    bf16_t* E = (bf16_t*)c.smem;
    constexpr int ES = 136, ETS = 264;
    const float rsc = kind == 0 ? 0.08838834764831845f : (kind == 6 ? 0.125f * LOG2E : 1.f);
    const bool latent = pt2 > 0;
    const bool mulx = (kind == 5 || kind == 7 || kind == 10);
#define XF_PLAIN  { v0 *= rsc; v1 *= rsc; v2 *= rsc; v3 *= rsc; }
#define XF_SIG    { v0 = fsig(v0); v1 = fsig(v1); v2 = fsig(v2); v3 = fsig(v3); }
#define XF_SILU   { v0 *= fsig(v0); v1 *= fsig(v1); v2 *= fsig(v2); v3 *= fsig(v3); }
#define PZ_STAGE(PASS, XF) \
    _Pragma("unroll") for (int j = 0; j < 4; ++j) { \
        const int m = wm * 128 + j * 32 + c.l31; \
        _Pragma("unroll") for (int i = 0; i < 2; ++i) \
        _Pragma("unroll") for (int q = 0; q < 4; ++q) { \
            const int n0 = wn * 64 + i * 32 + 8 * q + 4 * c.hl; \
            float v0 = acc[i][j][4 * q + 0], v1 = acc[i][j][4 * q + 1], v2 = acc[i][j][4 * q + 2], v3 = acc[i][j][4 * q + 3]; \
            XF \
            if (PASS == 0) { \
                u32x2 o; o[0] = pk2(v0, v1); o[1] = pk2(v2, v3); \
                *(u32x2*)(E + m * ES + n0) = o; \
            } else { \
                E[(n0 + 0) * ETS + m] = f2bf(v0); E[(n0 + 1) * ETS + m] = f2bf(v1); E[(n0 + 2) * ETS + m] = f2bf(v2); E[(n0 + 3) * ETS + m] = f2bf(v3); \
            } \
        } \
    }
    const int cls = roped ? (latent ? 0 : 1) : (kind >= 11 ? 2 : (mulx ? 3 : 1));
    const int nfq = retk ? 32 : 16;
    const float fsc = retk ? (13.287712379549449f / 32.f) : (13.287712379549449f / 16.f);
    if (cls == 0) {
        const int lbase = pt2 * 256 + wm * 128 - CTXL;
        const float rowA = (float)(lbase >> 6), colA = (float)c.l31;
#pragma unroll
        for (int i = 0; i < 2; ++i) {
            const bool rowpart = retk ? (wn == 0) : (i == 0);
            const float posA = rowpart ? rowA : colA;
            const float posB = rowpart ? rowA + 1.f : colA + 32.f;
#pragma unroll
            for (int q = 0; q < 4; ++q) {
                const int n0 = wn * 64 + i * 32 + 8 * q + 4 * c.hl;
                const int c0 = retk ? (n0 >> 1) : ((n0 & 63) >> 1);
                const float iv0 = __builtin_amdgcn_exp2f(-(float)(c0 & (nfq - 1)) * fsc) * 0.15915494309189535f;
                const float iv1 = __builtin_amdgcn_exp2f(-(float)((c0 + 1) & (nfq - 1)) * fsc) * 0.15915494309189535f;
#define ROPE_APPLY(POS, JA, JB) { float s0, c0f, s1, c1f; sincos_rev((POS) * iv0, s0, c0f); sincos_rev((POS) * iv1, s1, c1f); \
                    { const float v0 = acc[i][JA][4 * q + 0], v1 = acc[i][JA][4 * q + 1], v2 = acc[i][JA][4 * q + 2], v3 = acc[i][JA][4 * q + 3]; \
                      acc[i][JA][4 * q + 0] = v0 * c0f - v1 * s0; acc[i][JA][4 * q + 1] = v0 * s0 + v1 * c0f; acc[i][JA][4 * q + 2] = v2 * c1f - v3 * s1; acc[i][JA][4 * q + 3] = v2 * s1 + v3 * c1f; } \
                    { const float v0 = acc[i][JB][4 * q + 0], v1 = acc[i][JB][4 * q + 1], v2 = acc[i][JB][4 * q + 2], v3 = acc[i][JB][4 * q + 3]; \
                      acc[i][JB][4 * q + 0] = v0 * c0f - v1 * s0; acc[i][JB][4 * q + 1] = v0 * s0 + v1 * c0f; acc[i][JB][4 * q + 2] = v2 * c1f - v3 * s1; acc[i][JB][4 * q + 3] = v2 * s1 + v3 * c1f; } }
                if (rowpart) { ROPE_APPLY(posA, 0, 1) ROPE_APPLY(posB, 2, 3) }
                else { ROPE_APPLY(posA, 0, 2) ROPE_APPLY(posB, 1, 3) }
#undef ROPE_APPLY
            }
        }
    }
    if (kind != 1 && kind != 3) {
        if (cls <= 1) { PZ_STAGE(0, XF_PLAIN) }
        else if (cls == 2) { PZ_STAGE(0, XF_SIG) }
        else { PZ_STAGE(0, XF_SILU) }
        __syncthreads();
        bf16_t* dst; size_t ld;
        if (kind >= 11) { dst = (bf16_t*)(c.ws + OFF_MLOG) + (size_t)(ct - 44) * 128; ld = 3072; }
        else {
            size_t off;
            switch (kind) { case 0: off = OFF_RK; break; case 2: off = OFF_DK; break; case 4: off = OFF_RQ; break; case 5: off = OFF_RG; break;
                            case 6: off = OFF_DQ; break; case 7: off = OFF_DG; break; case 8: off = OFF_MU; break; case 9: off = OFF_MV; break; default: off = OFF_MG; break; }
            dst = (bf16_t*)(c.ws + off) + h * 128; ld = 512;
        }
        dst += (size_t)rt2 * 256 * ld;
#pragma unroll 4
        for (int it = 0; it < 16; ++it) {
            const int id = c.tid + 256 * it, row = id >> 4, seg = id & 15;
            *(u32x4*)(dst + (size_t)row * ld + seg * 8) = *(const u32x4*)(E + row * ES + seg * 8);
        }
    }
    if (kind == 0 || kind == 1 || kind == 3) {
        if (kind == 0) __syncthreads();
        PZ_STAGE(1, XF_PLAIN)
        __syncthreads();
        const size_t off = kind == 0 ? OFF_RKT : (kind == 1 ? OFF_RVT : OFF_DVT);
        bf16_t* dst = (bf16_t*)(c.ws + off) + (size_t)(bl * 4 + h) * 128 * PP + pt2 * 256;
#pragma unroll 4
        for (int it = 0; it < 16; ++it) {
            const int id = c.tid + 256 * it, n = id >> 5, seg = id & 31;
            *(u32x4*)(dst + (size_t)n * PP + seg * 8) = *(const u32x4*)(E + n * ETS + seg * 8);
        }
    }
    __builtin_amdgcn_s_setprio(0);
#undef PZ_STAGE
#undef XF_PLAIN
#undef XF_SIG
#undef XF_SILU
}

DI void attn_item(const Ctx& c, int l, int bl, int h, int q0, int nk) {
    bf16_t* Ks = (bf16_t*)c.smem;
    bf16_t* Vs = Ks + 64 * 136;
    const int mp = c.w >> 1, qs = c.w & 1;
    const int qpos = q0 + qs * 32 + c.l31;
    const size_t qtok = (size_t)bl * PP + qpos;
    const bf16_t* DQ = (const bf16_t*)(c.ws + OFF_DQ);
    const bf16_t* DK = (const bf16_t*)(c.ws + OFF_DK) + (size_t)bl * PP * 512 + h * 128;
    const bf16_t* DVT = (const bf16_t*)(c.ws + OFF_DVT) + (size_t)(bl * 4 + h) * 128 * PP;
    bf16x8 qf[4];
#pragma unroll
    for (int ks = 0; ks < 4; ++ks) qf[ks] = *(const bf16x8*)(DQ + qtok * 512 + h * 128 + mp * 64 + ks * 16 + c.hl * 8);
    f32x16 o[4];
#pragma unroll
    for (int et = 0; et < 4; ++et)
#pragma unroll
        for (int r = 0; r < 16; ++r) o[et][r] = 0.f;
    float mrun = -1e30f, lrun = 0.f;
    u32x4 rk[4], rv[4];
    constexpr int BUF = 64 * 136 + 128 * 68;
#define AT_LOAD(KT0) { _Pragma("unroll") for (int it = 0; it < 4; ++it) { const int idx = c.tid + 256 * it; \
        rk[it] = *(const u32x4*)(DK + (size_t)((KT0) + (idx >> 4)) * 512 + (idx & 15) * 8); \
        rv[it] = *(const u32x4*)(DVT + (size_t)(idx >> 3) * PP + (KT0) + (idx & 7) * 8); } }
#define AT_STORE(BP) { _Pragma("unroll") for (int it = 0; it < 4; ++it) { const int idx = c.tid + 256 * it; \
        *(u32x4*)((BP) + (idx >> 4) * 136 + (idx & 15) * 8) = rk[it]; \
        u32x2 lo2, hi2; lo2[0] = rv[it][0]; lo2[1] = rv[it][1]; hi2[0] = rv[it][2]; hi2[1] = rv[it][3]; \
        *(u32x2*)((BP) + 64 * 136 + (idx >> 3) * 68 + (idx & 7) * 8) = lo2; *(u32x2*)((BP) + 64 * 136 + (idx >> 3) * 68 + (idx & 7) * 8 + 4) = hi2; } }
    AT_LOAD(0)
    __syncthreads();
    AT_STORE(Ks)
    if (64 < nk) AT_LOAD(64)
    __syncthreads();
    for (int kt0 = 0; kt0 < nk; kt0 += 64) {
        const int cb = (kt0 >> 6) & 1;
        const bf16_t* Kc = Ks + cb * BUF;
        const bf16_t* Vc = Kc + 64 * 136;
        if (kt0 + 64 < nk) {
            AT_STORE(Ks + (cb ^ 1) * BUF)
            if (kt0 + 128 < nk) AT_LOAD(kt0 + 128)
        }
        f32x16 s[2];
#pragma unroll
        for (int kt = 0; kt < 2; ++kt) {
#pragma unroll
            for (int r = 0; r < 16; ++r) s[kt][r] = 0.f;
#pragma unroll
            for (int ks = 0; ks < 4; ++ks) {
                const bf16x8 a = *(const bf16x8*)(Kc + (kt * 32 + c.l31) * 136 + mp * 64 + ks * 16 + c.hl * 8);
                s[kt] = MFMA(a, qf[ks], s[kt]);
            }
        }
        float mx = s[0][0];
#pragma unroll
        for (int r = 0; r < 16; ++r) { mx = fmaxf(mx, s[0][r]); mx = fmaxf(mx, s[1][r]); }
        mx = fmaxf(mx, __shfl_xor(mx, 32));
        const float mold = mrun;
        const float mnew = fmaxf(mrun, mx);
        const float alpha = __builtin_amdgcn_exp2f(mrun - mnew);
        mrun = mnew;
        float lsum = 0.f;
#pragma unroll
        for (int kt = 0; kt < 2; ++kt)
#pragma unroll
            for (int r = 0; r < 16; ++r) { const float pv = __builtin_amdgcn_exp2f(s[kt][r] - mnew); s[kt][r] = pv; lsum += pv; }
        lrun = lrun * alpha + lsum;
        if (__any(mx > mold)) {
#pragma unroll
            for (int et = 0; et < 4; ++et)
#pragma unroll
                for (int r = 0; r < 16; ++r) o[et][r] *= alpha;
        }
#pragma unroll
        for (int kt = 0; kt < 2; ++kt) {
#pragma unroll
            for (int st = 0; st < 2; ++st) {
                u32x4 pp;
                pp[0] = pk2(s[kt][8 * st + 0], s[kt][8 * st + 1]); pp[1] = pk2(s[kt][8 * st + 2], s[kt][8 * st + 3]);
                pp[2] = pk2(s[kt][8 * st + 4], s[kt][8 * st + 5]); pp[3] = pk2(s[kt][8 * st + 6], s[kt][8 * st + 7]);
                const bf16x8 pf = __builtin_bit_cast(bf16x8, pp);
#pragma unroll
                for (int et = 0; et < 4; ++et) {
                    const bf16_t* vp = Vc + (et * 32 + c.l31) * 68 + kt * 32 + 16 * st + 4 * c.hl;
                    const u32x2 lo = *(const u32x2*)vp, hi = *(const u32x2*)(vp + 8);
                    u32x4 av; av[0] = lo[0]; av[1] = lo[1]; av[2] = hi[0]; av[3] = hi[1];
                    o[et] = MFMA(__builtin_bit_cast(bf16x8, av), pf, o[et]);
                }
            }
        }
        __syncthreads();
    }
#undef AT_LOAD
#undef AT_STORE
    const float ltot = lrun + __shfl_xor(lrun, 32);
    const float linv = 1.f / ltot;
    float* Oc = (float*)c.smem;
    if (mp == 1) {
#pragma unroll
        for (int et = 0; et < 4; ++et)
#pragma unroll
            for (int r = 0; r < 16; ++r) Oc[(qs * 128 + et * 32 + crow(r, c.hl)) * 32 + c.l31] = o[et][r] * linv;
    }
    __syncthreads();
    if (mp == 0) {
        const float lam = c.cst[l], lam_init = c.cst[2 + l];
        float ss = 0.f;
#pragma unroll
        for (int et = 0; et < 4; ++et)
#pragma unroll
            for (int r = 0; r < 16; ++r) {
                const float d = o[et][r] * linv - lam * Oc[(qs * 128 + et * 32 + crow(r, c.hl)) * 32 + c.l31];
                o[et][r] = d; ss += d * d;
            }
        ss += __shfl_xor(ss, 32);
        const float rn = rsqrtf(ss * (1.f / 128.f) + EPS) * (1.f - lam_init);
        const bf16_t* DG = (const bf16_t*)(c.ws + OFF_DG) + qtok * 512 + h * 128;
        bf16_t* OD = (bf16_t*)(c.ws + OFF_ODIFF) + qtok * 512 + h * 128;
#pragma unroll
        for (int et = 0; et < 4; ++et)
#pragma unroll
            for (int q = 0; q < 4; ++q) {
                const int e0 = et * 32 + 8 * q + 4 * c.hl;
                const u32x2 g = *(const u32x2*)(DG + e0);
                u32x2 ov;
                ov[0] = pk2(o[et][4 * q + 0] * rn * bflo(g[0]), o[et][4 * q + 1] * rn * bfhi(g[0]));
                ov[1] = pk2(o[et][4 * q + 2] * rn * bflo(g[1]), o[et][4 * q + 3] * rn * bfhi(g[1]));
                *(u32x2*)(OD + e0) = ov;
            }
    }
}

DI void scan_item(const Ctx& c, int l, int bl, int h, int dir, int es) {
    const float lg2 = c.cst[4 + l * 8 + dir * 4 + h];
    const float decayC = __builtin_amdgcn_exp2f(lg2 * 128.f);
    f32x16 st;
#pragma unroll
    for (int r = 0; r < 16; ++r) st[r] = 0.f;
    const bf16_t* vt = (const bf16_t*)(c.ws + OFF_RVT) + ((size_t)(bl * 4 + h) * 128 + es * 32 + c.l31) * PP;
    const bf16_t* kt = (const bf16_t*)(c.ws + OFF_RKT) + ((size_t)(bl * 4 + h) * 128 + c.w * 32 + c.l31) * PP;
    bf16_t* stbase = (bf16_t*)(c.ws + OFF_ST) + (size_t)(((bl * 4 + h) * 2 + dir) * NCH) * 16384;
#pragma unroll 1
    for (int step = 0; step < NCH; ++step) {
        const int m = dir == 0 ? step : (step < 2 ? 1 - step : 19 - step);
        bf16_t* sp = stbase + (size_t)m * 16384;
#pragma unroll
        for (int r = 0; r < 16; ++r) sp[(es * 32 + crow(r, c.hl)) * 128 + c.w * 32 + c.l31] = f2bf(st[r]);
        if (step == NCH - 1) break;
#pragma unroll
        for (int r = 0; r < 16; ++r) st[r] *= decayC;
#pragma unroll
        for (int ks = 0; ks < 8; ++ks) {
            const int j0 = ks * 16 + c.hl * 8;
            const u32x4 av = *(const u32x4*)(vt + m * 128 + j0);
            const u32x4 bv = *(const u32x4*)(kt + m * 128 + j0);
            u32x4 as;
#pragma unroll
            for (int e = 0; e < 4; ++e) {
                const int ja = j0 + 2 * e;
                const float e0 = dir == 0 ? (float)(127 - ja) : (float)ja;
                const float e1 = dir == 0 ? (float)(126 - ja) : (float)(ja + 1);
                const float w0 = __builtin_amdgcn_exp2f(lg2 * e0), w1 = __builtin_amdgcn_exp2f(lg2 * e1);
                as[e] = pk2(bflo(av[e]) * w0, bfhi(av[e]) * w1);
            }
            st = MFMA(__builtin_bit_cast(bf16x8, as), __builtin_bit_cast(bf16x8, bv), st);
        }
    }
}

DI void mlp_item(const Ctx& c, int l, int bl, int m, int g) {
    bf16_t* Vn = (bf16_t*)c.smem;
    bf16_t* Wsm = Vn + 128 * 136;
    float* stat = (float*)(Wsm + 128 * 136);
    const size_t tok0 = (size_t)bl * PP + m * 128;
    const bf16_t* MV = (const bf16_t*)(c.ws + OFF_MV);
    __syncthreads();
#pragma unroll 1
    for (int rb = 0; rb < 4; ++rb) {
        u32x4 vv[8];
#pragma unroll
        for (int r8 = 0; r8 < 8; ++r8) vv[r8] = *(const u32x4*)(MV + (tok0 + c.w * 32 + rb * 8 + r8) * 512 + c.lane * 8);
#pragma unroll
        for (int r8 = 0; r8 < 8; ++r8) {
            const int row = c.w * 32 + rb * 8 + r8;
            float xv[8];
#pragma unroll
            for (int e = 0; e < 4; ++e) { xv[2 * e] = bflo(vv[r8][e]); xv[2 * e + 1] = bfhi(vv[r8][e]); }
            float sm = 0.f;
#pragma unroll
            for (int e = 0; e < 8; ++e) sm += xv[e];
            sm = wave_sum(sm);
            const float mu = sm * (1.f / 512.f);
            float ss = 0.f;
#pragma unroll
            for (int e = 0; e < 8; ++e) { const float d = xv[e] - mu; ss += d * d; }
            ss = wave_sum(ss);
            if (c.lane == 0) { stat[row] = mu; stat[128 + row] = rsqrtf(ss * (1.f / 512.f) + EPS); }
        }
    }
    __syncthreads();
    {
        u32x4 tv[8];
#pragma unroll
        for (int it = 0; it < 8; ++it) { const int idx = c.tid + 256 * it; tv[it] = *(const u32x4*)(MV + (tok0 + (idx >> 4)) * 512 + g * 128 + (idx & 15) * 8); }
#pragma unroll
        for (int it = 0; it < 8; ++it) {
            const int idx = c.tid + 256 * it, j = idx >> 4, seg = idx & 15;
            const float mu = stat[j], rs = stat[128 + j];
#pragma unroll
            for (int e = 0; e < 4; ++e) {
                Vn[(seg * 8 + 2 * e) * 136 + j] = f2bf((bflo(tv[it][e]) - mu) * rs);
                Vn[(seg * 8 + 2 * e + 1) * 136 + j] = f2bf((bfhi(tv[it][e]) - mu) * rs);
            }
        }
    }
    {
        const float* wsrc = c.w_s + (size_t)(l * 4 + g) * 128 * 128;
#pragma unroll 1
        for (int hb = 0; hb < 2; ++hb) {
            f32x4 wv[8];
#pragma unroll
            for (int it = 0; it < 8; ++it) { const int idx = c.tid + 256 * (hb * 8 + it); wv[it] = *(const f32x4*)(wsrc + (idx >> 5) * 128 + (idx & 31) * 4); }
#pragma unroll
            for (int it = 0; it < 8; ++it) {
                const int idx = c.tid + 256 * (hb * 8 + it);
                u32x2 o; o[0] = pk2(wv[it][0], wv[it][1]); o[1] = pk2(wv[it][2], wv[it][3]);
                *(u32x2*)(Wsm + (idx >> 5) * 136 + (idx & 31) * 4) = o;
            }
        }
    }
    __syncthreads();
    const int wc = c.w >> 1, wi = c.w & 1;
    f32x16 acc[2][2];
    zero_acc(acc);
#pragma unroll
    for (int ks = 0; ks < 8; ++ks) {
        const bf16x8 a0 = *(const bf16x8*)(Vn + (wc * 64 + c.l31) * 136 + ks * 16 + c.hl * 8);
        const bf16x8 a1 = *(const bf16x8*)(Vn + (wc * 64 + 32 + c.l31) * 136 + ks * 16 + c.hl * 8);
        const bf16x8 b0 = *(const bf16x8*)(Wsm + (wi * 64 + c.l31) * 136 + ks * 16 + c.hl * 8);
        const bf16x8 b1 = *(const bf16x8*)(Wsm + (wi * 64 + 32 + c.l31) * 136 + ks * 16 + c.hl * 8);
        acc[0][0] = MFMA(a0, b0, acc[0][0]); acc[0][1] = MFMA(a0, b1, acc[0][1]);
        acc[1][0] = MFMA(a1, b0, acc[1][0]); acc[1][1] = MFMA(a1, b1, acc[1][1]);
    }
    const bf16_t* MU = (const bf16_t*)(c.ws + OFF_MU);
    const bf16_t* MG = (const bf16_t*)(c.ws + OFF_MG);
    bf16_t* OM = (bf16_t*)(c.ws + OFF_OMLP);
#pragma unroll
    for (int ii = 0; ii < 2; ++ii) {
        const int i = wi * 64 + ii * 32 + c.l31;
        const size_t tok = tok0 + i;
        const float bs = c.b_s[(l * 4 + g) * 128 + i];
#pragma unroll
        for (int ci = 0; ci < 2; ++ci)
#pragma unroll
            for (int q = 0; q < 4; ++q) {
                const int c0 = g * 128 + wc * 64 + ci * 32 + 8 * q + 4 * c.hl;
                const u32x2 u = *(const u32x2*)(MU + tok * 512 + c0), gg = *(const u32x2*)(MG + tok * 512 + c0);
                u32x2 ov;
                ov[0] = pk2(bflo(u[0]) * (acc[ci][ii][4 * q + 0] + bs) * bflo(gg[0]), bfhi(u[0]) * (acc[ci][ii][4 * q + 1] + bs) * bfhi(gg[0]));
                ov[1] = pk2(bflo(u[1]) * (acc[ci][ii][4 * q + 2] + bs) * bflo(gg[1]), bfhi(u[1]) * (acc[ci][ii][4 * q + 3] + bs) * bfhi(gg[1]));
                *(u32x2*)(OM + tok * 512 + c0) = ov;
            }
    }
}

DI void retout_item(const Ctx& c, int l, int bl, int h, int m) {
    bf16_t* Ks = (bf16_t*)c.smem;
    bf16_t* Vs = Ks + 128 * 136;
    const size_t tok0 = (size_t)bl * PP + m * 128;
    const bf16_t* RK = (const bf16_t*)(c.ws + OFF_RK) + tok0 * 512 + h * 128;
    const bf16_t* RVT = (const bf16_t*)(c.ws + OFF_RVT) + (size_t)(bl * 4 + h) * 128 * PP + m * 128;
    __syncthreads();
    {
        u32x4 tk[8], tv[8];
#pragma unroll
        for (int it = 0; it < 8; ++it) {
            const int idx = c.tid + 256 * it, row = idx >> 4, seg = idx & 15;
            tk[it] = *(const u32x4*)(RK + (size_t)row * 512 + seg * 8);
            tv[it] = *(const u32x4*)(RVT + (size_t)row * PP + seg * 8);
        }
#pragma unroll
        for (int it = 0; it < 8; ++it) {
            const int idx = c.tid + 256 * it, row = idx >> 4, seg = idx & 15;
            *(u32x4*)(Ks + row * 136 + seg * 8) = tk[it];
            u32x2 lo2, hi2; lo2[0] = tv[it][0]; lo2[1] = tv[it][1]; hi2[0] = tv[it][2]; hi2[1] = tv[it][3];
            *(u32x2*)(Vs + row * 132 + seg * 8) = lo2; *(u32x2*)(Vs + row * 132 + seg * 8 + 4) = hi2;
        }
    }
    __syncthreads();
    const int i = c.w * 32 + c.l31;
    const size_t tok = tok0 + i;
    const float lgf = c.cst[4 + l * 8 + h], lgb = c.cst[4 + l * 8 + 4 + h];
    bf16x8 qf[8];
    const bf16_t* RQ = (const bf16_t*)(c.ws + OFF_RQ) + tok * 512 + h * 128;
#pragma unroll
    for (int ks = 0; ks < 8; ++ks) qf[ks] = *(const bf16x8*)(RQ + ks * 16 + c.hl * 8);
    f32x16 o[4];
    const bf16_t* stf = (const bf16_t*)(c.ws + OFF_ST) + (size_t)(((bl * 4 + h) * 2 + 0) * NCH + m) * 16384;
    const bf16_t* stb = (const bf16_t*)(c.ws + OFF_ST) + (size_t)(((bl * 4 + h) * 2 + 1) * NCH + m) * 16384;
    const float qdf = __builtin_amdgcn_exp2f(lgf * (float)(i + 1)), qdb = __builtin_amdgcn_exp2f(lgb * (float)(128 - i));
#pragma unroll
    for (int et = 0; et < 4; ++et) {
        f32x16 tf, tb;
#pragma unroll
        for (int r = 0; r < 16; ++r) { tf[r] = 0.f; tb[r] = 0.f; }
#pragma unroll
        for (int ks = 0; ks < 8; ++ks) {
            const bf16x8 a = *(const bf16x8*)(stf + (et * 32 + c.l31) * 128 + ks * 16 + c.hl * 8);
            const bf16x8 b = *(const bf16x8*)(stb + (et * 32 + c.l31) * 128 + ks * 16 + c.hl * 8);
            tf = MFMA(a, qf[ks], tf);
            tb = MFMA(b, qf[ks], tb);
        }
#pragma unroll
        for (int r = 0; r < 16; ++r) o[et][r] = tf[r] * qdf + tb[r] * qdb;
        __builtin_amdgcn_sched_barrier(0);
    }
#pragma unroll
    for (int jt = 0; jt < 4; ++jt) {
        f32x16 sc;
#pragma unroll
        for (int r = 0; r < 16; ++r) sc[r] = 0.f;
#pragma unroll
        for (int ks = 0; ks < 8; ++ks) {
            const bf16x8 a = *(const bf16x8*)(Ks + (jt * 32 + c.l31) * 136 + ks * 16 + c.hl * 8);
            sc = MFMA(a, qf[ks], sc);
        }
#pragma unroll
        for (int r = 0; r < 16; ++r) {
            const int j = jt * 32 + crow(r, c.hl);
            const int dl = i - j;
            const float arg = dl > 0 ? lgf * (float)dl : -lgb * (float)dl;
            float f = __builtin_amdgcn_exp2f(arg);
            f = dl == 0 ? 2.f : f;
            sc[r] *= f;
        }
#pragma unroll
        for (int s2 = 0; s2 < 2; ++s2) {
            u32x4 pp;
            pp[0] = pk2(sc[8 * s2 + 0], sc[8 * s2 + 1]); pp[1] = pk2(sc[8 * s2 + 2], sc[8 * s2 + 3]);
            pp[2] = pk2(sc[8 * s2 + 4], sc[8 * s2 + 5]); pp[3] = pk2(sc[8 * s2 + 6], sc[8 * s2 + 7]);
            const bf16x8 pf = __builtin_bit_cast(bf16x8, pp);
#pragma unroll
            for (int et = 0; et < 4; ++et) {
                const bf16_t* vp = Vs + (et * 32 + c.l31) * 132 + jt * 32 + 16 * s2 + 4 * c.hl;
                const u32x2 lo = *(const u32x2*)vp, hi = *(const u32x2*)(vp + 8);
                u32x4 av; av[0] = lo[0]; av[1] = lo[1]; av[2] = hi[0]; av[3] = hi[1];
                o[et] = MFMA(__builtin_bit_cast(bf16x8, av), pf, o[et]);
            }
        }
        __builtin_amdgcn_sched_barrier(0);
    }
    float ss = 0.f;
#pragma unroll
    for (int et = 0; et < 4; ++et)
#pragma unroll
        for (int r = 0; r < 16; ++r) ss += o[et][r] * o[et][r];
    ss += __shfl_xor(ss, 32);
    const float rn = rsqrtf(ss * (1.f / 128.f) + EPS);
    const bf16_t* RG = (const bf16_t*)(c.ws + OFF_RG) + tok * 512 + h * 128;
    bf16_t* OR = (bf16_t*)(c.ws + OFF_ORET) + tok * 512 + h * 128;
#pragma unroll
    for (int et = 0; et < 4; ++et)
#pragma unroll
        for (int q = 0; q < 4; ++q) {
            const int e0 = et * 32 + 8 * q + 4 * c.hl;
            const u32x2 g = *(const u32x2*)(RG + e0);
            u32x2 ov;
            ov[0] = pk2(o[et][4 * q + 0] * rn * bflo(g[0]), o[et][4 * q + 1] * rn * bfhi(g[0]));
            ov[1] = pk2(o[et][4 * q + 2] * rn * bflo(g[1]), o[et][4 * q + 3] * rn * bfhi(g[1]));
            *(u32x2*)(OR + e0) = ov;
        }
}

DI void pm_item(const Ctx& c, int l, int rt, int nt) {
    f32x16 y[2][2], acc[2][2];
    zero_acc(y);
    const int wn = c.w >> 1, wm = c.w & 1;
    const bf16_t* MLOG = (const bf16_t*)(c.ws + OFF_MLOG);
#pragma unroll 1
    for (int br = 0; br < 3; ++br) {
        const size_t ooff = br == 0 ? OFF_ORET : (br == 1 ? OFF_OMLP : OFF_ODIFF);
        zero_acc(acc);
        gemm_core(c, (const bf16_t*)(c.ws + OFF_WBO) + ((size_t)(l * 3 + br) * 1024 + (size_t)nt * 128) * 512, 512,
                  (const bf16_t*)(c.ws + ooff) + (size_t)rt * 128 * 512, 512, 512, acc);
#pragma unroll
        for (int j = 0; j < 2; ++j) {
            const size_t tok = (size_t)rt * 128 + wm * 64 + j * 32 + c.l31;
#pragma unroll
            for (int i = 0; i < 2; ++i)
#pragma unroll
                for (int q = 0; q < 4; ++q) {
                    const int n0 = nt * 128 + wn * 64 + i * 32 + 8 * q + 4 * c.hl;
                    const u32x2 g = *(const u32x2*)(MLOG + tok * 3072 + br * 1024 + n0);
                    y[i][j][4 * q + 0] += bflo(g[0]) * acc[i][j][4 * q + 0];
                    y[i][j][4 * q + 1] += bfhi(g[0]) * acc[i][j][4 * q + 1];
                    y[i][j][4 * q + 2] += bflo(g[1]) * acc[i][j][4 * q + 2];
                    y[i][j][4 * q + 3] += bfhi(g[1]) * acc[i][j][4 * q + 3];
                }
        }
    }
    bf16_t* Y = (bf16_t*)(c.ws + OFF_Y);
#pragma unroll
    for (int j = 0; j < 2; ++j) {
        const size_t tok = (size_t)rt * 128 + wm * 64 + j * 32 + c.l31;
#pragma unroll
        for (int i = 0; i < 2; ++i)
#pragma unroll
            for (int q = 0; q < 4; ++q) {
                const int n0 = nt * 128 + wn * 64 + i * 32 + 8 * q + 4 * c.hl;
                u32x2 ov; ov[0] = pk2(y[i][j][4 * q + 0], y[i][j][4 * q + 1]); ov[1] = pk2(y[i][j][4 * q + 2], y[i][j][4 * q + 3]);
                *(u32x2*)(Y + tok * 1024 + n0) = ov;
            }
    }
}
DI void po_item(const Ctx& c, int l, int rt2, int nt) {
    f32x16 acc[2][4];
    zero_acc2(acc);
    gemm_core2(c, (const bf16_t*)(c.ws + OFF_WO) + ((size_t)l * 1024 + (size_t)nt * 128) * 1024, 1024,
               (const bf16_t*)(c.ws + OFF_Y) + (size_t)rt2 * 256 * 1024, 1024, 1024, acc);
    const int wn = c.w >> 1, wm = c.w & 1;
    float* OUT = (float*)(c.ws + OFF_OUT);
#pragma unroll
    for (int j = 0; j < 4; ++j) {
        const size_t tok = (size_t)rt2 * 256 + wm * 128 + j * 32 + c.l31;
#pragma unroll
        for (int i = 0; i < 2; ++i)
#pragma unroll
            for (int q = 0; q < 4; ++q) {
                const int n0 = nt * 128 + wn * 64 + i * 32 + 8 * q + 4 * c.hl;
                f32x4 ov; ov[0] = acc[i][j][4 * q + 0]; ov[1] = acc[i][j][4 * q + 1]; ov[2] = acc[i][j][4 * q + 2]; ov[3] = acc[i][j][4 * q + 3];
                *(f32x4*)(OUT + tok * 1024 + n0) = ov;
            }
    }
}

extern __shared__ __attribute__((aligned(16))) unsigned char dynsmem[];
constexpr int LDS_BYTES = 72 * 1024;

DI Ctx mk_ctx(const Params& p, const float* cst, int wv) {
    Ctx c;
    c.x = p.in[0]; c.c = p.in[1]; c.ctx = p.in[2]; c.c_ctx = p.in[3]; c.w_mod = p.in[4]; c.b_mod = p.in[5]; c.g_pre = p.in[6]; c.g_post = p.in[7];
    c.w_in = p.in[8]; c.decay = p.in[9]; c.w_s = p.in[10]; c.b_s = p.in[11]; c.lq = p.in[12]; c.lk = p.in[13]; c.w_bo = p.in[14]; c.w_out = p.in[15];
    c.out = p.out; c.ws = p.ws; c.smem = dynsmem; c.cst = cst;
    unsigned zl = 0u;
    asm volatile("" : "+v"(zl));
    int tid = wv * 64 + (int)__builtin_amdgcn_mbcnt_hi(~0u, __builtin_amdgcn_mbcnt_lo(~0u, zl));
    asm volatile("" : "+v"(tid));
    size_t zoff = 0;
    asm volatile("" : "+s"(zoff));
    c.ws = p.ws + zoff;
    c.tid = tid; c.lane = tid & 63; c.w = tid >> 6; c.l31 = c.lane & 31; c.hl = c.lane >> 5;
    return c;
}
DI void relaunder(Ctx& c) {
    int t = c.tid;
    asm volatile("" : "+v"(t));
    c.tid = t; c.lane = t & 63; c.w = t >> 6; c.l31 = c.lane & 31; c.hl = c.lane >> 5;
}

__global__ void __launch_bounds__(256, 2) mega(Params p) {
    __shared__ uint4 xbw;
    __shared__ float cst[32];
    const int wv = __builtin_amdgcn_readfirstlane((int)threadIdx.x >> 6);
    Ctx c = mk_ctx(p, cst, wv);
    if (c.tid == 0) xbw = make_uint4(0u, 0u, 0u, 0u);
    if (c.tid < 64) {
        for (int l = 0; l < 2; ++l) {
            float a = c.lq[(l * 2 + 0) * 64 + c.tid] * c.lk[(l * 2 + 0) * 64 + c.tid];
            float b = c.lq[(l * 2 + 1) * 64 + c.tid] * c.lk[(l * 2 + 1) * 64 + c.tid];
            a = wave_sum(a); b = wave_sum(b);
            const float lam_init = 0.8f - 0.6f * expf(-0.3f * (float)l);
            if (c.tid == 0) { cst[l] = expf(a) - expf(b) + lam_init; cst[2 + l] = lam_init; }
        }
        if (c.tid < 16) {
            const float z = c.decay[c.tid];
            cst[4 + c.tid] = -log1pf(expf(-z)) * LOG2E;
        }
    }
    __syncthreads();
    XcdBarrier bar = xcd_barrier_post((unsigned*)(p.ws + OFF_BAR), (volatile LAS unsigned*)&xbw, c.tid == 0);
    const int G = gridDim.x, bid = blockIdx.x;
    constexpr int NPH = 2 + NGRP * 12;
#pragma unroll 1
    for (int ph = 0; ph < NPH; ++ph) {
        c = mk_ctx(p, cst, wv);
        int kind, g = 0, l = 0;
        if (ph == 0) kind = 0;
        else if (ph == 1) kind = 1;
        else { const int q = ph - 2; g = q / 12; const int r = q % 12; l = r / 6; kind = 2 + r % 6; }
#ifndef ECHO_KIND
#define ECHO_KIND -1
#endif
        const unsigned long long tph0 = (ECHO_KIND >= 0) ? __builtin_amdgcn_s_memrealtime() : 0ull;
        switch (kind) {
        case 0:
#pragma unroll 1
            for (int it = bid; it < 2 * 1408 + 192; it += G) { relaunder(c); p0_item(c, it); }
            break;
        case 1:
#pragma unroll 1
            for (int it = bid; it < NT / 4; it += G) { relaunder(c); ph_item(c, g, it); }
            break;
        case 2:
            if ((G & 7) == 0) {
                const int x = bid & 7, jl = bid >> 3, GL = G >> 3;
#pragma unroll 1
                for (int k = jl; k < 306; k += GL) {
                    int ct, rt2;
                    if (k < 288) { ct = 8 * (k & 7) + x; rt2 = k >> 3; }
                    else { ct = 64 + (x >> 1); rt2 = (x & 1) * 18 + (k - 288); }
                    if (l == 1 && (rt2 % 9) == 0 && ct >= 16) continue;
                    relaunder(c);
                    pz_item(c, l, rt2, ct);
                }
            } else {
#pragma unroll 1
                for (int it = bid; it < 36 * 68; it += G) {
                    const int ct = it % 68, rt2 = it / 68;
                    if (l == 1 && (rt2 % 9) == 0 && ct >= 16) continue;
                    relaunder(c);
                    pz_item(c, l, rt2, ct);
                }
            }
            break;
        case 3: {
            const int n_att = 512, n_catt = (l == 0) ? 64 : 0, n_scan = 128, n_mlp = (l == 0) ? 288 : 256;
            const int total = n_att + n_catt + n_scan + n_mlp;
#pragma unroll 1
            for (int it = bid; it < total; it += G) {
                int r = it;
                relaunder(c);
                if (r < n_att + n_catt) {
                    int bl, h, q0, nk;
                    if (r < n_att) { bl = r >> 7; h = (r >> 5) & 3; q0 = CTXL + (r & 31) * 64; nk = PP; }
                    else { r -= n_att; bl = r >> 4; h = (r >> 2) & 3; q0 = (r & 3) * 64; nk = CTXL; }
                    attn_item(c, l, bl, h, q0, nk);
                    continue;
                }
                r -= n_att + n_catt;
                if (r < n_scan) { const int bl = r >> 5, h = (r >> 3) & 3, dir = (r >> 2) & 1, es = r & 3; scan_item(c, l, bl, h, dir, es); continue; }
                r -= n_scan;
                int bl, m, gg;
                if (l == 0) { bl = r / 72; const int q = r % 72; m = q >> 2; gg = q & 3; }
                else { bl = r >> 6; const int q = r & 63; m = 2 + (q >> 2); gg = q & 3; }
                mlp_item(c, l, bl, m, gg);
            }
            break; }
        case 4: {
            const int total = (l == 0) ? 288 : 256;
#pragma unroll 1
            for (int it = bid; it < total; it += G) {
                int bl, m, h;
                if (l == 0) { bl = it / 72; const int q = it % 72; h = q & 3; m = q >> 2; }
                else { bl = it >> 6; const int q = it & 63; h = q & 3; m = 2 + (q >> 2); }
                relaunder(c);
                retout_item(c, l, bl, h, m);
            }
            break; }
        case 5: {
            const int nrt = (l == 0) ? 72 : 64;
#pragma unroll 1
            for (int it = bid; it < nrt * 8; it += G) {
                const int nt = it & 7, rr = it >> 3;
                const int rt = (l == 0) ? rr : (rr >> 4) * NCH + 2 + (rr & 15);
                relaunder(c);
                pm_item(c, l, rt, nt);
            }
            break; }
        case 6: {
            const int nrt = (l == 0) ? 72 : 64;
#pragma unroll 1
            for (int it = bid; it < (nrt / 2) * 8; it += G) {
                const int nt = it & 7, rr = it >> 3;
                const int rt2 = (l == 0) ? rr : (rr >> 3) * 9 + 1 + (rr & 7);
                relaunder(c);
                po_item(c, l, rt2, nt);
            }
            break; }
        default:
#pragma unroll 1
            for (int it = bid; it < NT / 4; it += G) { relaunder(c); pr_item(c, l, g, it); }
            if (g + 1 < NGRP && l == 1) {
#pragma unroll 1
                for (int it = bid; it < NT / 4; it += G) { relaunder(c); ph_item(c, g + 1, it); }
            }
            break;
        }
        if (ECHO_KIND >= 0 && kind == ECHO_KIND) { __syncthreads(); const unsigned long long tb = __builtin_amdgcn_s_memrealtime(), dt = tb - tph0; while (__builtin_amdgcn_s_memrealtime() - tb < dt) __builtin_amdgcn_s_sleep(8); }
        if (ph + 1 < NPH) xcd_barrier(bar, c.tid == 0);
    }
}

extern "C" void kernel_launch(void* const* d_in, const int* in_sizes, int n_in, void* d_out, int out_size, void* d_ws, size_t ws_size, hipStream_t stream) {
    static int grid = 0;
    if (grid == 0) {
        int dev = 0, cus = 0, per_cu = 0;
        hipGetDevice(&dev);
        hipDeviceGetAttribute(&cus, hipDeviceAttributeMultiprocessorCount, dev);
        hipFuncSetAttribute((const void*)mega, hipFuncAttributeMaxDynamicSharedMemorySize, LDS_BYTES);
        hipOccupancyMaxActiveBlocksPerMultiprocessor(&per_cu, (const void*)mega, 256, LDS_BYTES);
        if (per_cu > 2) per_cu = 2;
        if (per_cu < 1) per_cu = 1;
        grid = cus * per_cu;
        if (ws_size < WS_END) { fprintf(stderr, "workspace too small: %zu < %zu\n", ws_size, (size_t)WS_END); grid = -1; }
    }
    if (grid < 0) return;
    hipMemsetAsync((unsigned char*)d_ws + OFF_BAR, 0, XCD_BAR_WORDS * 4, stream);
    Params p{};
    for (int i = 0; i < 16; ++i) p.in[i] = (const float*)d_in[i];
    p.out = (float*)d_out; p.ws = (unsigned char*)d_ws;
    void* args[] = {&p};
    hipError_t e = hipLaunchCooperativeKernel((const void*)mega, dim3(grid), dim3(256), args, LDS_BYTES, stream);
    if (e != hipSuccess) fprintf(stderr, "cooperative launch failed: %s (grid %d)\n", hipGetErrorString(e), grid);
}
```

```cpp
#include <hip/hip_runtime.h>
#include <cstdio>
#include <cstdint>

#define DI __device__ __forceinline__
#define LAS __attribute__((address_space(3)))
typedef unsigned short bf16_t;
typedef short bf16x8 __attribute__((ext_vector_type(8)));
typedef float f32x16 __attribute__((ext_vector_type(16)));
typedef float f32x4 __attribute__((ext_vector_type(4)));
typedef float f32x2 __attribute__((ext_vector_type(2)));
typedef unsigned u32x4 __attribute__((ext_vector_type(4)));
typedef unsigned u32x2 __attribute__((ext_vector_type(2)));
#define MFMA(a, b, c) __builtin_amdgcn_mfma_f32_32x32x16_bf16((a), (b), (c), 0, 0, 0)

#define XB_TMO      128
#define XB_XCNT(j)  (256  + 64 * (j))
#define XB_XSUB(j)  (1280 + 64 * (j))
#define XB_XGEN(j)  (2304 + 64 * (j))
#define XB_TOP      3328
#define XB_TOPGEN   3392
#define XCD_BAR_WORDS 3456
#define XB_SPIN_CAP (1u << 22)
DI unsigned xb_ld(unsigned* p)              { return __hip_atomic_load(p, __ATOMIC_RELAXED, __HIP_MEMORY_SCOPE_AGENT); }
DI unsigned xb_add(unsigned* p, unsigned v) { return __hip_atomic_fetch_add(p, v, __ATOMIC_RELAXED, __HIP_MEMORY_SCOPE_AGENT); }
DI unsigned xb_xcc_id() { return (unsigned)__builtin_amdgcn_s_getreg((3 << 11) | 20) & 0xFu; }
#define XB_SPIN(cond, bar) do { unsigned _sp = 0; while (cond) { __builtin_amdgcn_s_sleep(1); \
    if ((++_sp & 255u) == 0u) { if (xb_ld(&(bar)[XB_TMO])) break; if (_sp > XB_SPIN_CAP) { atomicAdd(&(bar)[XB_TMO], 1u); break; } } } } while (0)
struct XcdBarrier { unsigned* bar; unsigned x; volatile LAS unsigned* st; };
DI XcdBarrier xcd_barrier_post(unsigned* bar, volatile LAS unsigned* st, bool t0) {
    XcdBarrier b; b.bar = bar; b.x = xb_xcc_id(); b.st = st;
    if (t0) (void)xb_add(&bar[XB_XCNT(b.x)], 1u);
    return b;
}
DI void xcd_barrier_complete(unsigned* bar, unsigned x, unsigned& nloc, unsigned& nx) {
    const unsigned G = gridDim.x * gridDim.y * gridDim.z;
    unsigned sum, cnt, mine, sp = 0u;
    for (;;) {
        sum = 0u; cnt = 0u; mine = 0u;
#pragma unroll
        for (unsigned j = 0; j < 16; ++j) { const unsigned c = xb_ld(&bar[XB_XCNT(j)]); sum += c; cnt += (c > 0u) ? 1u : 0u; mine = (j == x) ? c : mine; }
        if (sum == G) break;
        __builtin_amdgcn_s_sleep(1);
        if ((++sp & 255u) == 0u) { if (xb_ld(&bar[XB_TMO])) break; if (sp > XB_SPIN_CAP) { atomicAdd(&bar[XB_TMO], 1u); break; } }
    }
    nloc = mine > 0u ? mine : 1u; nx = cnt > 0u ? cnt : 1u;
}
DI void xcd_barrier(const XcdBarrier& b, bool t0) {
    asm volatile("s_waitcnt vmcnt(0)" ::: "memory");
    __syncthreads();
    if (t0) {
        unsigned* bar = b.bar;
        __builtin_amdgcn_s_waitcnt(0);
        unsigned nloc = b.st[0], nx = b.st[1];
        if (nloc == 0u) { xcd_barrier_complete(bar, b.x, nloc, nx); b.st[0] = nloc; b.st[1] = nx; }
        const unsigned old = xb_add(&bar[XB_XSUB(b.x)], 1u);
        const unsigned gen = old / nloc;
        if (old + 1u == (gen + 1u) * nloc) {
            __builtin_amdgcn_fence(__ATOMIC_RELEASE, "agent");
            asm volatile("s_waitcnt vmcnt(0)" ::: "memory");
            const unsigned og = xb_add(&bar[XB_TOP], 1u);
            const unsigned tg = og / nx;
            if (og + 1u == (tg + 1u) * nx) xb_add(&bar[XB_TOPGEN], 1u);
            else XB_SPIN(xb_ld(&bar[XB_TOPGEN]) == tg, bar);
            __builtin_amdgcn_fence(__ATOMIC_ACQUIRE, "agent");
            xb_add(&bar[XB_XGEN(b.x)], 1u);
            asm volatile("s_waitcnt vmcnt(0)" ::: "memory");
        } else {
            XB_SPIN(xb_ld(&bar[XB_XGEN(b.x)]) == gen, bar);
            __builtin_amdgcn_fence(__ATOMIC_ACQUIRE, "agent");
            asm volatile("s_waitcnt vmcnt(0)" ::: "memory");
        }
    }
    __syncthreads();
}

constexpr int DM = 1024, SEQL = 2048, CTXL = 256, PP = 2304  ;
constexpr int NBG = 4  , NGRP = 2, NT = NBG * PP  ;
constexpr int INC = 8704, NCH = 18  ;
constexpr int LDH = 1088, LDW = 1088;
constexpr float EPS = 1e-6f;
constexpr float LOG2E = 1.4426950408889634f;

constexpr size_t TB = (size_t)NT * 512 * 2;
constexpr size_t OFF_BAR = 0;
constexpr size_t OFF_MOD = 16384;
constexpr size_t OFF_WIN = OFF_MOD + 262144;
constexpr size_t OFF_WBO = OFF_WIN + (size_t)2 * INC * LDW * 2;
constexpr size_t OFF_WO  = OFF_WBO + (size_t)2 * 3 * 1024 * 512 * 2;
constexpr size_t OFF_H   = OFF_WO + (size_t)2 * 1024 * 1024 * 2;
constexpr size_t OFF_RK  = OFF_H + (size_t)NT * LDH * 2;
constexpr size_t OFF_RKT = OFF_RK + TB;
constexpr size_t OFF_RVT = OFF_RKT + TB;
constexpr size_t OFF_DK  = OFF_RVT + TB;
constexpr size_t OFF_DVT = OFF_DK + TB;
constexpr size_t OFF_RQ  = OFF_DVT + TB;
constexpr size_t OFF_RG  = OFF_RQ + TB;
constexpr size_t OFF_DQ  = OFF_RG + TB;
constexpr size_t OFF_DG  = OFF_DQ + TB;
constexpr size_t OFF_MU  = OFF_DG + TB;
constexpr size_t OFF_MV  = OFF_MU + TB;
constexpr size_t OFF_MG  = OFF_MV + TB;
constexpr size_t OFF_MLOG = OFF_MG + TB;
constexpr size_t OFF_OMLP = OFF_MLOG + 6 * TB;
constexpr size_t OFF_ODIFF = OFF_OMLP + TB;
constexpr size_t OFF_ROPE = OFF_ODIFF + TB;
constexpr size_t WS_END = OFF_ROPE + (size_t)2048 * 96 * 8;
constexpr size_t OFF_ST = OFF_H;
constexpr size_t OFF_ORET = OFF_DK;
constexpr size_t OFF_Y = OFF_RK;
constexpr size_t OFF_OUT = OFF_MLOG;

struct Params {
    const float* in[16];
    float* out;
    unsigned char* ws;
};

struct Ctx {
    const float *x, *c, *ctx, *c_ctx, *w_mod, *b_mod, *g_pre, *g_post, *w_in, *decay, *w_s, *b_s, *lq, *lk, *w_bo, *w_out;
    float* out;
    unsigned char* ws;
    unsigned char* smem;
    const float* cst;
    int tid, lane, w, l31, hl;
};

DI unsigned pk2(float lo, float hi) {
    typedef __bf16 b2 __attribute__((ext_vector_type(2)));
    f32x2 v = {lo, hi};
    b2 r = __builtin_convertvector(v, b2);
    return __builtin_bit_cast(unsigned, r);
}
DI bf16_t f2bf(float x) { return (bf16_t)(pk2(x, 0.f) & 0xffffu); }
DI float bflo(unsigned u) { return __uint_as_float(u << 16); }
DI float bfhi(unsigned u) { return __uint_as_float(u & 0xffff0000u); }
DI int crow(int r, int hl) { return (r & 3) + 8 * (r >> 2) + 4 * hl; }
DI float wave_sum(float v) {
#pragma unroll
    for (int o = 1; o < 64; o <<= 1) v += __shfl_xor(v, o);
    return v;
}
DI float fsig(float x) { return __builtin_amdgcn_rcpf(1.f + __builtin_amdgcn_exp2f(-LOG2E * x)); }
DI void sincos_rev(float rev, float& sn, float& cs) {
    const float g = __builtin_amdgcn_fractf(rev) - 0.5f;
    const bool fold = fabsf(g) > 0.25f;
    const float h = fold ? (copysignf(0.5f, g) - g) : g;
    const float x = h * 6.283185307179586f;
    const float x2 = x * x;
    const float sp = x * (1.f + x2 * (-1.6666667e-1f + x2 * (8.3333333e-3f + x2 * (-1.9841270e-4f + x2 * (2.7557319e-6f - x2 * 2.5052108e-8f)))));
    const float cp = 1.f + x2 * (-0.5f + x2 * (4.1666667e-2f + x2 * (-1.3888889e-3f + x2 * (2.4801587e-5f + x2 * (-2.7557319e-7f + x2 * 2.0876757e-9f)))));
    sn = -sp;
    cs = fold ? cp : -cp;
}
DI float silu_f(float x) { return x / (1.f + __expf(-x)); }
DI float sigmoid_f(float x) { return 1.f / (1.f + __expf(-x)); }

DI void gemm_core(const Ctx& c, const bf16_t* __restrict__ Wt, int ldw, const bf16_t* __restrict__ Act, int lda, int K, f32x16 (&acc)[2][2]) {
    bf16_t* Ws = (bf16_t*)c.smem;
    bf16_t* As = Ws + 128 * 72;
    const int wn = c.w >> 1, wm = c.w & 1;
    const int lrow = c.tid >> 3, lseg = c.tid & 7;
    u32x4 rw[4], ra[4];
#pragma unroll
    for (int it = 0; it < 4; ++it) {
        rw[it] = *(const u32x4*)(Wt + (size_t)(lrow + 32 * it) * ldw + lseg * 8);
        ra[it] = *(const u32x4*)(Act + (size_t)(lrow + 32 * it) * lda + lseg * 8);
    }
    for (int k0 = 0; k0 < K; k0 += 64) {
        __syncthreads();
#pragma unroll
        for (int it = 0; it < 4; ++it) {
            *(u32x4*)(Ws + (lrow + 32 * it) * 72 + lseg * 8) = rw[it];
            *(u32x4*)(As + (lrow + 32 * it) * 72 + lseg * 8) = ra[it];
        }
        __syncthreads();
        if (k0 + 64 < K) {
#pragma unroll
            for (int it = 0; it < 4; ++it) {
                rw[it] = *(const u32x4*)(Wt + (size_t)(lrow + 32 * it) * ldw + k0 + 64 + lseg * 8);
                ra[it] = *(const u32x4*)(Act + (size_t)(lrow + 32 * it) * lda + k0 + 64 + lseg * 8);
            }
        }
#pragma unroll
        for (int ks = 0; ks < 4; ++ks) {
            const bf16x8 a0 = *(const bf16x8*)(Ws + (wn * 64 + c.l31) * 72 + ks * 16 + c.hl * 8);
            const bf16x8 a1 = *(const bf16x8*)(Ws + (wn * 64 + 32 + c.l31) * 72 + ks * 16 + c.hl * 8);
            const bf16x8 b0 = *(const bf16x8*)(As + (wm * 64 + c.l31) * 72 + ks * 16 + c.hl * 8);
            const bf16x8 b1 = *(const bf16x8*)(As + (wm * 64 + 32 + c.l31) * 72 + ks * 16 + c.hl * 8);
            acc[0][0] = MFMA(a0, b0, acc[0][0]);
            acc[0][1] = MFMA(a0, b1, acc[0][1]);
            acc[1][0] = MFMA(a1, b0, acc[1][0]);
            acc[1][1] = MFMA(a1, b1, acc[1][1]);
        }
    }
}
DI void zero_acc(f32x16 (&acc)[2][2]) {
#pragma unroll
    for (int i = 0; i < 2; ++i)
#pragma unroll
        for (int j = 0; j < 2; ++j)
#pragma unroll
            for (int r = 0; r < 16; ++r) acc[i][j][r] = 0.f;
}


DI void gemm_core2(const Ctx& c, const bf16_t* __restrict__ Wt, int ldw, const bf16_t* __restrict__ Act, int lda, int K, f32x16 (&acc)[2][4]) {
    constexpr int RS = 32;
    constexpr int STG = 384 * RS;
    bf16_t* S = (bf16_t*)c.smem;
    const int wn = c.w >> 1, wm = c.w & 1;
    const int lrow = c.tid >> 2, lseg = c.tid & 3;
    const int scol = (lseg ^ ((c.tid >> 4) & 3)) * 8;
    const int rsw = (c.l31 >> 2) & 3;
    const bf16_t* wp = Wt + (size_t)lrow * ldw + lseg * 8;
    const bf16_t* ap = Act + (size_t)lrow * lda + lseg * 8;
    u32x4 rw[2], ra[4];
#pragma unroll
    for (int it = 0; it < 2; ++it) rw[it] = *(const u32x4*)(wp + (size_t)(64 * it) * ldw);
#pragma unroll
    for (int it = 0; it < 4; ++it) ra[it] = *(const u32x4*)(ap + (size_t)(64 * it) * lda);
    __syncthreads();
#pragma unroll
    for (int it = 0; it < 2; ++it) *(u32x4*)(S + (lrow + 64 * it) * RS + scol) = rw[it];
#pragma unroll
    for (int it = 0; it < 4; ++it) *(u32x4*)(S + (128 + lrow + 64 * it) * RS + scol) = ra[it];
    if (K > 32) {
#pragma unroll
        for (int it = 0; it < 2; ++it) rw[it] = *(const u32x4*)(wp + (size_t)(64 * it) * ldw + 32);
#pragma unroll
        for (int it = 0; it < 4; ++it) ra[it] = *(const u32x4*)(ap + (size_t)(64 * it) * lda + 32);
    }
    __syncthreads();
    for (int k0 = 0; k0 < K; k0 += 32) {
        const int s = (k0 >> 5) & 1;
        bf16_t* Sc = S + s * STG;
        bf16_t* Sn = S + (s ^ 1) * STG;
        if (k0 + 32 < K) {
#pragma unroll
            for (int it = 0; it < 2; ++it) *(u32x4*)(Sn + (lrow + 64 * it) * RS + scol) = rw[it];
#pragma unroll
            for (int it = 0; it < 4; ++it) *(u32x4*)(Sn + (128 + lrow + 64 * it) * RS + scol) = ra[it];
            if (k0 + 64 < K) {
#pragma unroll
                for (int it = 0; it < 2; ++it) rw[it] = *(const u32x4*)(wp + (size_t)(64 * it) * ldw + k0 + 64);
#pragma unroll
                for (int it = 0; it < 4; ++it) ra[it] = *(const u32x4*)(ap + (size_t)(64 * it) * lda + k0 + 64);
            }
        }
#pragma unroll
        for (int ks = 0; ks < 2; ++ks) {
            const int rcol = ((ks * 2 + c.hl) ^ rsw) * 8;
            bf16x8 a[2], b[4];
#pragma unroll
            for (int i = 0; i < 2; ++i) a[i] = *(const bf16x8*)(Sc + (wn * 64 + i * 32 + c.l31) * RS + rcol);
#pragma unroll
            for (int j = 0; j < 4; ++j) b[j] = *(const bf16x8*)(Sc + (128 + wm * 128 + j * 32 + c.l31) * RS + rcol);
#pragma unroll
            for (int i = 0; i < 2; ++i)
#pragma unroll
                for (int j = 0; j < 4; ++j) acc[i][j] = MFMA(a[i], b[j], acc[i][j]);
        }
        __syncthreads();
    }
}
DI void zero_acc2(f32x16 (&acc)[2][4]) {
#pragma unroll
    for (int i = 0; i < 2; ++i)
#pragma unroll
        for (int j = 0; j < 4; ++j)
#pragma unroll
            for (int r = 0; r < 16; ++r) acc[i][j][r] = 0.f;
}

DI void transpose_item(const Ctx& c, const float* __restrict__ src, int N, int k0, int n0, int mapk, bf16_t* __restrict__ dst, int ldk) {
    float* T = (float*)c.smem;
    __syncthreads();
    {
        f32x4 tv[8];
#pragma unroll
        for (int it = 0; it < 8; ++it) { const int idx = c.tid + 256 * it; tv[it] = *(const f32x4*)(src + (size_t)(k0 + (idx >> 5)) * N + n0 + (idx & 31) * 4); }
#pragma unroll
        for (int it = 0; it < 8; ++it) {
            const int idx = c.tid + 256 * it, r = idx >> 5, c4 = idx & 31;
            float* t = T + r * 129 + c4 * 4;
            t[0] = tv[it][0]; t[1] = tv[it][1]; t[2] = tv[it][2]; t[3] = tv[it][3];
        }
    }
    __syncthreads();
#pragma unroll
    for (int it = 0; it < 4; ++it) {
        const int idx = c.tid + 256 * it, np = idx >> 3, ch = idx & 7;
        int cs = np;
        if (mapk == 1) cs = (np >> 1) + 64 * (np & 1);
        else if (mapk == 2) { const int r = np & 63; cs = (np & 64) + (r >> 1) + 32 * (r & 1); }
        const float* t = T + (ch * 8) * 129 + cs;
        u32x4 o;
        o[0] = pk2(t[0], t[129]); o[1] = pk2(t[2 * 129], t[3 * 129]); o[2] = pk2(t[4 * 129], t[5 * 129]); o[3] = pk2(t[6 * 129], t[7 * 129]);
        *(u32x4*)(dst + (size_t)(n0 + np) * ldk + k0 + ch * 8) = o;
    }
}
DI void mod_item(const Ctx& c, int l, int jb) {
    float* sv = (float*)c.smem;
    float* red = sv + 9 * 1024;
    __syncthreads();
    for (int idx = c.tid; idx < 9216; idx += 256) {
        const int v = idx >> 10, k = idx & 1023;
        const float x = v < 8 ? c.c[v * 1024 + k] : c.c_ctx[k];
        sv[idx] = x / (1.f + expf(-x));
    }
    __syncthreads();
    const int kk = c.tid >> 5, jj = c.tid & 31, j = jb * 32 + jj;
    float a[9];
#pragma unroll
    for (int v = 0; v < 9; ++v) a[v] = 0.f;
    const float* wp = c.w_mod + (size_t)l * 1024 * 3072 + j;
#pragma unroll 4
    for (int i = 0; i < 128; ++i) {
        const int k = kk + 8 * i;
        const float wv = wp[(size_t)k * 3072];
#pragma unroll
        for (int v = 0; v < 9; ++v) a[v] += sv[v * 1024 + k] * wv;
    }
#pragma unroll
    for (int v = 0; v < 9; ++v) red[(kk * 9 + v) * 32 + jj] = a[v];
    __syncthreads();
    float* MOD = (float*)(c.ws + OFF_MOD);
    for (int idx = c.tid; idx < 288; idx += 256) {
        const int v = idx >> 5, j2 = idx & 31;
        float s = 0.f;
#pragma unroll
        for (int k2 = 0; k2 < 8; ++k2) s += red[(k2 * 9 + v) * 32 + j2];
        MOD[(size_t)(l * 9 + v) * 3072 + jb * 32 + j2] = s + c.b_mod[l * 3072 + jb * 32 + j2];
    }
}

DI void rope_item(const Ctx& c, int it) {
    constexpr float L2B = 13.287712379549449f;
    f32x2* T = (f32x2*)(c.ws + OFF_ROPE);
#pragma unroll 1
    for (int e = 0; e < 8; ++e) {
        const int idx = (it * 8 + e) * 256 + c.tid;
        const int lp = idx / 96, a = idx % 96;
        const float rowp = (float)(lp >> 6), colp = (float)(lp & 63);
        float ang;
        if (a < 64) { const int f = a & 31; ang = (a < 32 ? rowp : colp) * exp2f(-(float)f * (L2B / 32.f)); }
        else { const int a2 = a - 64, f = a2 & 15; ang = (a2 < 16 ? rowp : colp) * exp2f(-(float)f * (L2B / 16.f)); }
        f32x2 v; v[0] = cosf(ang); v[1] = sinf(ang);
        T[idx] = v;
    }
}
DI void p0_item(const Ctx& c, int it) {
    if (it < 2 * 1408) {
        const int l = it / 1408; int r = it % 1408;
        if (r < 1088) {
            const int ct = r % 68, kb = r / 68;
            const int kind = ct >> 2;
            const int mapk = (kind == 0 || kind == 4) ? 1 : ((kind == 2 || kind == 6) ? 2 : 0);
            transpose_item(c, c.w_in + (size_t)l * 1024 * INC, INC, kb * 64, ct * 128, mapk, (bf16_t*)(c.ws + OFF_WIN) + (size_t)l * INC * LDW, LDW);
            return;
        }
        r -= 1088;
        if (r < 192) {
            const int br = r / 64, q = r % 64, kb = q >> 3, nb = q & 7;
            transpose_item(c, c.w_bo + (size_t)(l * 3 + br) * 512 * 1024, 1024, kb * 64, nb * 128, 0,
                           (bf16_t*)(c.ws + OFF_WBO) + (size_t)(l * 3 + br) * 1024 * 512, 512);
            return;
        }
        r -= 192;
        { const int kb = r >> 3, nb = r & 7;
          transpose_item(c, c.w_out + (size_t)l * 1024 * 1024, 1024, kb * 64, nb * 128, 0, (bf16_t*)(c.ws + OFF_WO) + (size_t)l * 1024 * 1024, 1024); }
        return;
    }
    it -= 2 * 1408;
    mod_item(c, it / 96, it % 96);
}

DI void modulate_row(const f32x4 (&x)[4], const float* gpre, const float* mod  , bf16_t* hrow, int lane) {
    float ss = 0.f;
#pragma unroll
    for (int j = 0; j < 4; ++j) ss += x[j][0] * x[j][0] + x[j][1] * x[j][1] + x[j][2] * x[j][2] + x[j][3] * x[j][3];
    ss = wave_sum(ss);
    const float r = rsqrtf(ss * (1.f / 1024.f) + EPS);
#pragma unroll
    for (int j = 0; j < 4; ++j) {
        const int col = lane * 4 + 256 * j;
        const f32x4 g = *(const f32x4*)(gpre + col), sh = *(const f32x4*)(mod + col), sc = *(const f32x4*)(mod + 1024 + col);
        f32x4 h;
#pragma unroll
        for (int e = 0; e < 4; ++e) h[e] = x[j][e] * r * g[e] * (1.f + sc[e]) + sh[e];
        u32x2 o; o[0] = pk2(h[0], h[1]); o[1] = pk2(h[2], h[3]);
        *(u32x2*)(hrow + col) = o;
    }
}
DI void ph_item(const Ctx& c, int g, int item) {
    const int tok = item * 4 + c.w, bl = tok / PP, p = tok % PP, b = g * NBG + bl;
    const float* src = p < CTXL ? c.ctx + ((size_t)b * CTXL + p) * DM : c.x + ((size_t)b * SEQL + (p - CTXL)) * DM;
    f32x4 x[4];
#pragma unroll
    for (int j = 0; j < 4; ++j) x[j] = *(const f32x4*)(src + c.lane * 4 + 256 * j);
    const float* mod = (const float*)(c.ws + OFF_MOD) + (size_t)(0 * 9 + (p < CTXL ? 8 : b)) * 3072;
    modulate_row(x, c.g_pre, mod, (bf16_t*)(c.ws + OFF_H) + (size_t)tok * LDH, c.lane);
}
DI void pr_item(const Ctx& c, int l, int g, int item) {
    const int tok = item * 4 + c.w, bl = tok / PP, p = tok % PP, b = g * NBG + bl;
    if (l == 1 && p < CTXL) return;
    const float* orow = (const float*)(c.ws + OFF_OUT) + (size_t)tok * DM;
    const int v = p < CTXL ? 8 : b;
    const float* mod = (const float*)(c.ws + OFF_MOD) + (size_t)(l * 9 + v) * 3072;
    float* xo_lat = c.out + ((size_t)b * SEQL + (p - CTXL)) * DM;
    const float* xold = p < CTXL ? c.ctx + ((size_t)b * CTXL + p) * DM : (l == 0 ? c.x + ((size_t)b * SEQL + (p - CTXL)) * DM : xo_lat);
    f32x4 o[4]; float ss = 0.f;
#pragma unroll
    for (int j = 0; j < 4; ++j) { o[j] = *(const f32x4*)(orow + c.lane * 4 + 256 * j); ss += o[j][0] * o[j][0] + o[j][1] * o[j][1] + o[j][2] * o[j][2] + o[j][3] * o[j][3]; }
    ss = wave_sum(ss);
    const float r = rsqrtf(ss * (1.f / 1024.f) + EPS);
    f32x4 xn[4];
#pragma unroll
    for (int j = 0; j < 4; ++j) {
        const int col = c.lane * 4 + 256 * j;
        const f32x4 gp = *(const f32x4*)(c.g_post + l * 1024 + col), gt = *(const f32x4*)(mod + 2048 + col), xv = *(const f32x4*)(xold + col);
#pragma unroll
        for (int e = 0; e < 4; ++e) xn[j][e] = xv[e] + gt[e] * (o[j][e] * r * gp[e]);
        if (p >= CTXL) *(f32x4*)(xo_lat + col) = xn[j];
    }
    if (l == 0) {
        const float* mod1 = (const float*)(c.ws + OFF_MOD) + (size_t)(1 * 9 + v) * 3072;
        modulate_row(xn, c.g_pre + 1024, mod1, (bf16_t*)(c.ws + OFF_H) + (size_t)tok * LDH, c.lane);
    }
}

DI void pz_item(const Ctx& c, int l, int rt2, int ct) {
    f32x16 acc[2][4];
    zero_acc2(acc);
    gemm_core2(c, (const bf16_t*)(c.ws + OFF_WIN) + ((size_t)l * INC + (size_t)ct * 128) * LDW, LDW,
               (const bf16_t*)(c.ws + OFF_H) + (size_t)rt2 * 256 * LDH, LDH, 1024, acc);
    const int wn = c.w >> 1, wm = c.w & 1;
    const int bl = rt2 / 9, pt2 = rt2 % 9;
    const int kind = ct >> 2, h = ct & 3;
    const bool roped = (kind == 0 || kind == 4 || kind == 2 || kind == 6);
    const bool retk = (kind == 0 || kind == 4);
    bf16_t* E = (bf16_t*)c.smem;
    constexpr int ES = 136, ETS = 264;
    const float rsc = kind == 0 ? 0.08838834764831845f : (kind == 6 ? 0.125f * LOG2E : 1.f);
    const bool latent = pt2 > 0;
    const bool mulx = (kind == 5 || kind == 7 || kind == 10);
#define XF_PLAIN  { v0 *= rsc; v1 *= rsc; v2 *= rsc; v3 *= rsc; }
#define XF_SIG    { v0 = fsig(v0); v1 = fsig(v1); v2 = fsig(v2); v3 = fsig(v3); }
#define XF_SILU   { v0 *= fsig(v0); v1 *= fsig(v1); v2 *= fsig(v2); v3 *= fsig(v3); }
#define PZ_STAGE(PASS, XF) \
    _Pragma("unroll") for (int j = 0; j < 4; ++j) { \
        const int m = wm * 128 + j * 32 + c.l31; \
        _Pragma("unroll") for (int i = 0; i < 2; ++i) \
        _Pragma("unroll") for (int q = 0; q < 4; ++q) { \
            const int n0 = wn * 64 + i * 32 + 8 * q + 4 * c.hl; \
            float v0 = acc[i][j][4 * q + 0], v1 = acc[i][j][4 * q + 1], v2 = acc[i][j][4 * q + 2], v3 = acc[i][j][4 * q + 3]; \
            XF \
            if (PASS == 0) { \
                u32x2 o; o[0] = pk2(v0, v1); o[1] = pk2(v2, v3); \
                *(u32x2*)(E + m * ES + n0) = o; \
            } else { \
                E[(n0 + 0) * ETS + m] = f2bf(v0); E[(n0 + 1) * ETS + m] = f2bf(v1); E[(n0 + 2) * ETS + m] = f2bf(v2); E[(n0 + 3) * ETS + m] = f2bf(v3); \
            } \
        } \
    }
    const int cls = roped ? (latent ? 0 : 1) : (kind >= 11 ? 2 : (mulx ? 3 : 1));
    const int nfq = retk ? 32 : 16;
    const float fsc = retk ? (13.287712379549449f / 32.f) : (13.287712379549449f / 16.f);
    if (cls == 0) {
        const int lbase = pt2 * 256 + wm * 128 - CTXL;
        const float rowA = (float)(lbase >> 6), colA = (float)c.l31;
#pragma unroll
        for (int i = 0; i < 2; ++i) {
            const bool rowpart = retk ? (wn == 0) : (i == 0);
            const float posA = rowpart ? rowA : colA;
            const float posB = rowpart ? rowA + 1.f : colA + 32.f;
#pragma unroll
            for (int q = 0; q < 4; ++q) {
                const int n0 = wn * 64 + i * 32 + 8 * q + 4 * c.hl;
                const int c0 = retk ? (n0 >> 1) : ((n0 & 63) >> 1);
                const float iv0 = __builtin_amdgcn_exp2f(-(float)(c0 & (nfq - 1)) * fsc) * 0.15915494309189535f;
                const float iv1 = __builtin_amdgcn_exp2f(-(float)((c0 + 1) & (nfq - 1)) * fsc) * 0.15915494309189535f;
#define ROPE_APPLY(POS, JA, JB) { float s0, c0f, s1, c1f; sincos_rev((POS) * iv0, s0, c0f); sincos_rev((POS) * iv1, s1, c1f); \
                    { const float v0 = acc[i][JA][4 * q + 0], v1 = acc[i][JA][4 * q + 1], v2 = acc[i][JA][4 * q + 2], v3 = acc[i][JA][4 * q + 3]; \
                      acc[i][JA][4 * q + 0] = v0 * c0f - v1 * s0; acc[i][JA][4 * q + 1] = v0 * s0 + v1 * c0f; acc[i][JA][4 * q + 2] = v2 * c1f - v3 * s1; acc[i][JA][4 * q + 3] = v2 * s1 + v3 * c1f; } \
                    { const float v0 = acc[i][JB][4 * q + 0], v1 = acc[i][JB][4 * q + 1], v2 = acc[i][JB][4 * q + 2], v3 = acc[i][JB][4 * q + 3]; \
                      acc[i][JB][4 * q + 0] = v0 * c0f - v1 * s0; acc[i][JB][4 * q + 1] = v0 * s0 + v1 * c0f; acc[i][JB][4 * q + 2] = v2 * c1f - v3 * s1; acc[i][JB][4 * q + 3] = v2 * s1 + v3 * c1f; } }
                if (rowpart) { ROPE_APPLY(posA, 0, 1) ROPE_APPLY(posB, 2, 3) }
                else { ROPE_APPLY(posA, 0, 2) ROPE_APPLY(posB, 1, 3) }
#undef ROPE_APPLY
            }
        }
    }
    if (kind != 1 && kind != 3) {
        if (cls <= 1) { PZ_STAGE(0, XF_PLAIN) }
        else if (cls == 2) { PZ_STAGE(0, XF_SIG) }
        else { PZ_STAGE(0, XF_SILU) }
        __syncthreads();
        bf16_t* dst; size_t ld;
        if (kind >= 11) { dst = (bf16_t*)(c.ws + OFF_MLOG) + (size_t)(ct - 44) * 128; ld = 3072; }
        else {
            size_t off;
            switch (kind) { case 0: off = OFF_RK; break; case 2: off = OFF_DK; break; case 4: off = OFF_RQ; break; case 5: off = OFF_RG; break;
                            case 6: off = OFF_DQ; break; case 7: off = OFF_DG; break; case 8: off = OFF_MU; break; case 9: off = OFF_MV; break; default: off = OFF_MG; break; }
            dst = (bf16_t*)(c.ws + off) + h * 128; ld = 512;
        }
        dst += (size_t)rt2 * 256 * ld;
#pragma unroll 4
        for (int it = 0; it < 16; ++it) {
            const int id = c.tid + 256 * it, row = id >> 4, seg = id & 15;
            *(u32x4*)(dst + (size_t)row * ld + seg * 8) = *(const u32x4*)(E + row * ES + seg * 8);
        }
    }
    if (kind == 0 || kind == 1 || kind == 3) {
        if (kind == 0) __syncthreads();
        PZ_STAGE(1, XF_PLAIN)
        __syncthreads();
        const size_t off = kind == 0 ? OFF_RKT : (kind == 1 ? OFF_RVT : OFF_DVT);
        bf16_t* dst = (bf16_t*)(c.ws + off) + (size_t)(bl * 4 + h) * 128 * PP + pt2 * 256;
#pragma unroll 4
        for (int it = 0; it < 16; ++it) {
            const int id = c.tid + 256 * it, n = id >> 5, seg = id & 31;
            *(u32x4*)(dst + (size_t)n * PP + seg * 8) = *(const u32x4*)(E + n * ETS + seg * 8);
        }
    }
    __builtin_amdgcn_s_setprio(0);
#undef PZ_STAGE
#undef XF_PLAIN
#undef XF_SIG
#undef XF_SILU
}

DI void attn_item(const Ctx& c, int l, int bl, int h, int q0, int nk) {
    bf16_t* Ks = (bf16_t*)c.smem;
    bf16_t* Vs = Ks + 64 * 136;
    const int mp = c.w >> 1, qs = c.w & 1;
    const int qpos = q0 + qs * 32 + c.l31;
    const size_t qtok = (size_t)bl * PP + qpos;
    const bf16_t* DQ = (const bf16_t*)(c.ws + OFF_DQ);
    const bf16_t* DK = (const bf16_t*)(c.ws + OFF_DK) + (size_t)bl * PP * 512 + h * 128;
    const bf16_t* DVT = (const bf16_t*)(c.ws + OFF_DVT) + (size_t)(bl * 4 + h) * 128 * PP;
    bf16x8 qf[4];
#pragma unroll
    for (int ks = 0; ks < 4; ++ks) qf[ks] = *(const bf16x8*)(DQ + qtok * 512 + h * 128 + mp * 64 + ks * 16 + c.hl * 8);
    f32x16 o[4];
#pragma unroll
    for (int et = 0; et < 4; ++et)
#pragma unroll
        for (int r = 0; r < 16; ++r) o[et][r] = 0.f;
    float mrun = -1e30f, lrun = 0.f;
    u32x4 rk[4], rv[4];
    constexpr int BUF = 64 * 136 + 128 * 68;
#define AT_LOAD(KT0) { _Pragma("unroll") for (int it = 0; it < 4; ++it) { const int idx = c.tid + 256 * it; \
        rk[it] = *(const u32x4*)(DK + (size_t)((KT0) + (idx >> 4)) * 512 + (idx & 15) * 8); \
        rv[it] = *(const u32x4*)(DVT + (size_t)(idx >> 3) * PP + (KT0) + (idx & 7) * 8); } }
#define AT_STORE(BP) { _Pragma("unroll") for (int it = 0; it < 4; ++it) { const int idx = c.tid + 256 * it; \
        *(u32x4*)((BP) + (idx >> 4) * 136 + (idx & 15) * 8) = rk[it]; \
        u32x2 lo2, hi2; lo2[0] = rv[it][0]; lo2[1] = rv[it][1]; hi2[0] = rv[it][2]; hi2[1] = rv[it][3]; \
        *(u32x2*)((BP) + 64 * 136 + (idx >> 3) * 68 + (idx & 7) * 8) = lo2; *(u32x2*)((BP) + 64 * 136 + (idx >> 3) * 68 + (idx & 7) * 8 + 4) = hi2; } }
    AT_LOAD(0)
    __syncthreads();
    AT_STORE(Ks)
    if (64 < nk) AT_LOAD(64)
    __syncthreads();
    for (int kt0 = 0; kt0 < nk; kt0 += 64) {
        const int cb = (kt0 >> 6) & 1;
        const bf16_t* Kc = Ks + cb * BUF;
        const bf16_t* Vc = Kc + 64 * 136;
        if (kt0 + 64 < nk) {
            AT_STORE(Ks + (cb ^ 1) * BUF)
            if (kt0 + 128 < nk) AT_LOAD(kt0 + 128)
        }
        f32x16 s[2];
#pragma unroll
        for (int kt = 0; kt < 2; ++kt) {
#pragma unroll
            for (int r = 0; r < 16; ++r) s[kt][r] = 0.f;
#pragma unroll
            for (int ks = 0; ks < 4; ++ks) {
                const bf16x8 a = *(const bf16x8*)(Kc + (kt * 32 + c.l31) * 136 + mp * 64 + ks * 16 + c.hl * 8);
                s[kt] = MFMA(a, qf[ks], s[kt]);
            }
        }
        float mx = s[0][0];
#pragma unroll
        for (int r = 0; r < 16; ++r) { mx = fmaxf(mx, s[0][r]); mx = fmaxf(mx, s[1][r]); }
        mx = fmaxf(mx, __shfl_xor(mx, 32));
        const float mold = mrun;
        const float mnew = fmaxf(mrun, mx);
        const float alpha = __builtin_amdgcn_exp2f(mrun - mnew);
        mrun = mnew;
        float lsum = 0.f;
#pragma unroll
        for (int kt = 0; kt < 2; ++kt)
#pragma unroll
            for (int r = 0; r < 16; ++r) { const float pv = __builtin_amdgcn_exp2f(s[kt][r] - mnew); s[kt][r] = pv; lsum += pv; }
        lrun = lrun * alpha + lsum;
        if (__any(mx > mold)) {
#pragma unroll
            for (int et = 0; et < 4; ++et)
#pragma unroll
                for (int r = 0; r < 16; ++r) o[et][r] *= alpha;
        }
#pragma unroll
        for (int kt = 0; kt < 2; ++kt) {
#pragma unroll
            for (int st = 0; st < 2; ++st) {
                u32x4 pp;
                pp[0] = pk2(s[kt][8 * st + 0], s[kt][8 * st + 1]); pp[1] = pk2(s[kt][8 * st + 2], s[kt][8 * st + 3]);
                pp[2] = pk2(s[kt][8 * st + 4], s[kt][8 * st + 5]); pp[3] = pk2(s[kt][8 * st + 6], s[kt][8 * st + 7]);
                const bf16x8 pf = __builtin_bit_cast(bf16x8, pp);
#pragma unroll
                for (int et = 0; et < 4; ++et) {
                    const bf16_t* vp = Vc + (et * 32 + c.l31) * 68 + kt * 32 + 16 * st + 4 * c.hl;
                    const u32x2 lo = *(const u32x2*)vp, hi = *(const u32x2*)(vp + 8);
                    u32x4 av; av[0] = lo[0]; av[1] = lo[1]; av[2] = hi[0]; av[3] = hi[1];
                    o[et] = MFMA(__builtin_bit_cast(bf16x8, av), pf, o[et]);
                }
            }
        }
        __syncthreads();
    }
#undef AT_LOAD
#undef AT_STORE
    const float ltot = lrun + __shfl_xor(lrun, 32);
    const float linv = 1.f / ltot;
    float* Oc = (float*)c.smem;
    if (mp == 1) {
#pragma unroll
        for (int et = 0; et < 4; ++et)
#pragma unroll
            for (int r = 0; r < 16; ++r) Oc[(qs * 128 + et * 32 + crow(r, c.hl)) * 32 + c.l31] = o[et][r] * linv;
    }
    __syncthreads();
    if (mp == 0) {
        const float lam = c.cst[l], lam_init = c.cst[2 + l];
        float ss = 0.f;
#pragma unroll
        for (int et = 0; et < 4; ++et)
#pragma unroll
            for (int r = 0; r < 16; ++r) {
                const float d = o[et][r] * linv - lam * Oc[(qs * 128 + et * 32 + crow(r, c.hl)) * 32 + c.l31];
                o[et][r] = d; ss += d * d;
            }
        ss += __shfl_xor(ss, 32);
        const float rn = rsqrtf(ss * (1.f / 128.f) + EPS) * (1.f - lam_init);
        const bf16_t* DG = (const bf16_t*)(c.ws + OFF_DG) + qtok * 512 + h * 128;
        bf16_t* OD = (bf16_t*)(c.ws + OFF_ODIFF) + qtok * 512 + h * 128;
#pragma unroll
        for (int et = 0; et < 4; ++et)
#pragma unroll
            for (int q = 0; q < 4; ++q) {
                const int e0 = et * 32 + 8 * q + 4 * c.hl;
                const u32x2 g = *(const u32x2*)(DG + e0);
                u32x2 ov;
                ov[0] = pk2(o[et][4 * q + 0] * rn * bflo(g[0]), o[et][4 * q + 1] * rn * bfhi(g[0]));
                ov[1] = pk2(o[et][4 * q + 2] * rn * bflo(g[1]), o[et][4 * q + 3] * rn * bfhi(g[1]));
                *(u32x2*)(OD + e0) = ov;
            }
    }
}

DI void scan_item(const Ctx& c, int l, int bl, int h, int dir, int es) {
    const float lg2 = c.cst[4 + l * 8 + dir * 4 + h];
    const float decayC = __builtin_amdgcn_exp2f(lg2 * 128.f);
    f32x16 st;
#pragma unroll
    for (int r = 0; r < 16; ++r) st[r] = 0.f;
    const bf16_t* vt = (const bf16_t*)(c.ws + OFF_RVT) + ((size_t)(bl * 4 + h) * 128 + es * 32 + c.l31) * PP;
    const bf16_t* kt = (const bf16_t*)(c.ws + OFF_RKT) + ((size_t)(bl * 4 + h) * 128 + c.w * 32 + c.l31) * PP;
    bf16_t* stbase = (bf16_t*)(c.ws + OFF_ST) + (size_t)(((bl * 4 + h) * 2 + dir) * NCH) * 16384;
#pragma unroll 1
    for (int step = 0; step < NCH; ++step) {
        const int m = dir == 0 ? step : (step < 2 ? 1 - step : 19 - step);
        bf16_t* sp = stbase + (size_t)m * 16384;
#pragma unroll
        for (int r = 0; r < 16; ++r) sp[(es * 32 + crow(r, c.hl)) * 128 + c.w * 32 + c.l31] = f2bf(st[r]);
        if (step == NCH - 1) break;
#pragma unroll
        for (int r = 0; r < 16; ++r) st[r] *= decayC;
#pragma unroll
        for (int ks = 0; ks < 8; ++ks) {
            const int j0 = ks * 16 + c.hl * 8;
            const u32x4 av = *(const u32x4*)(vt + m * 128 + j0);
            const u32x4 bv = *(const u32x4*)(kt + m * 128 + j0);
            u32x4 as;
#pragma unroll
            for (int e = 0; e < 4; ++e) {
                const int ja = j0 + 2 * e;
                const float e0 = dir == 0 ? (float)(127 - ja) : (float)ja;
                const float e1 = dir == 0 ? (float)(126 - ja) : (float)(ja + 1);
                const float w0 = __builtin_amdgcn_exp2f(lg2 * e0), w1 = __builtin_amdgcn_exp2f(lg2 * e1);
                as[e] = pk2(bflo(av[e]) * w0, bfhi(av[e]) * w1);
            }
            st = MFMA(__builtin_bit_cast(bf16x8, as), __builtin_bit_cast(bf16x8, bv), st);
        }
    }
}

DI void mlp_item(const Ctx& c, int l, int bl, int m, int g) {
    bf16_t* Vn = (bf16_t*)c.smem;
    bf16_t* Wsm = Vn + 128 * 136;
    float* stat = (float*)(Wsm + 128 * 136);
    const size_t tok0 = (size_t)bl * PP + m * 128;
    const bf16_t* MV = (const bf16_t*)(c.ws + OFF_MV);
    __syncthreads();
#pragma unroll 1
    for (int rb = 0; rb < 4; ++rb) {
        u32x4 vv[8];
#pragma unroll
        for (int r8 = 0; r8 < 8; ++r8) vv[r8] = *(const u32x4*)(MV + (tok0 + c.w * 32 + rb * 8 + r8) * 512 + c.lane * 8);
#pragma unroll
        for (int r8 = 0; r8 < 8; ++r8) {
            const int row = c.w * 32 + rb * 8 + r8;
            float xv[8];
#pragma unroll
            for (int e = 0; e < 4; ++e) { xv[2 * e] = bflo(vv[r8][e]); xv[2 * e + 1] = bfhi(vv[r8][e]); }
            float sm = 0.f;
#pragma unroll
            for (int e = 0; e < 8; ++e) sm += xv[e];
            sm = wave_sum(sm);
            const float mu = sm * (1.f / 512.f);
            float ss = 0.f;
#pragma unroll
            for (int e = 0; e < 8; ++e) { const float d = xv[e] - mu; ss += d * d; }
            ss = wave_sum(ss);
            if (c.lane == 0) { stat[row] = mu; stat[128 + row] = rsqrtf(ss * (1.f / 512.f) + EPS); }
        }
    }
    __syncthreads();
    {
        u32x4 tv[8];
#pragma unroll
        for (int it = 0; it < 8; ++it) { const int idx = c.tid + 256 * it; tv[it] = *(const u32x4*)(MV + (tok0 + (idx >> 4)) * 512 + g * 128 + (idx & 15) * 8); }
#pragma unroll
        for (int it = 0; it < 8; ++it) {
            const int idx = c.tid + 256 * it, j = idx >> 4, seg = idx & 15;
            const float mu = stat[j], rs = stat[128 + j];
#pragma unroll
            for (int e = 0; e < 4; ++e) {
                Vn[(seg * 8 + 2 * e) * 136 + j] = f2bf((bflo(tv[it][e]) - mu) * rs);
                Vn[(seg * 8 + 2 * e + 1) * 136 + j] = f2bf((bfhi(tv[it][e]) - mu) * rs);
            }
        }
    }
    {
        const float* wsrc = c.w_s + (size_t)(l * 4 + g) * 128 * 128;
#pragma unroll 1
        for (int hb = 0; hb < 2; ++hb) {
            f32x4 wv[8];
#pragma unroll
            for (int it = 0; it < 8; ++it) { const int idx = c.tid + 256 * (hb * 8 + it); wv[it] = *(const f32x4*)(wsrc + (idx >> 5) * 128 + (idx & 31) * 4); }
#pragma unroll
            for (int it = 0; it < 8; ++it) {
                const int idx = c.tid + 256 * (hb * 8 + it);
                u32x2 o; o[0] = pk2(wv[it][0], wv[it][1]); o[1] = pk2(wv[it][2], wv[it][3]);
                *(u32x2*)(Wsm + (idx >> 5) * 136 + (idx & 31) * 4) = o;
            }
        }
    }
    __syncthreads();
    const int wc = c.w >> 1, wi = c.w & 1;
    f32x16 acc[2][2];
    zero_acc(acc);
#pragma unroll
    for (int ks = 0; ks < 8; ++ks) {
        const bf16x8 a0 = *(const bf16x8*)(Vn + (wc * 64 + c.l31) * 136 + ks * 16 + c.hl * 8);
        const bf16x8 a1 = *(const bf16x8*)(Vn + (wc * 64 + 32 + c.l31) * 136 + ks * 16 + c.hl * 8);
        const bf16x8 b0 = *(const bf16x8*)(Wsm + (wi * 64 + c.l31) * 136 + ks * 16 + c.hl * 8);
        const bf16x8 b1 = *(const bf16x8*)(Wsm + (wi * 64 + 32 + c.l31) * 136 + ks * 16 + c.hl * 8);
        acc[0][0] = MFMA(a0, b0, acc[0][0]); acc[0][1] = MFMA(a0, b1, acc[0][1]);
        acc[1][0] = MFMA(a1, b0, acc[1][0]); acc[1][1] = MFMA(a1, b1, acc[1][1]);
    }
    const bf16_t* MU = (const bf16_t*)(c.ws + OFF_MU);
    const bf16_t* MG = (const bf16_t*)(c.ws + OFF_MG);
    bf16_t* OM = (bf16_t*)(c.ws + OFF_OMLP);
#pragma unroll
    for (int ii = 0; ii < 2; ++ii) {
        const int i = wi * 64 + ii * 32 + c.l31;
        const size_t tok = tok0 + i;
        const float bs = c.b_s[(l * 4 + g) * 128 + i];
#pragma unroll
        for (int ci = 0; ci < 2; ++ci)
#pragma unroll
            for (int q = 0; q < 4; ++q) {
                const int c0 = g * 128 + wc * 64 + ci * 32 + 8 * q + 4 * c.hl;
                const u32x2 u = *(const u32x2*)(MU + tok * 512 + c0), gg = *(const u32x2*)(MG + tok * 512 + c0);
                u32x2 ov;
                ov[0] = pk2(bflo(u[0]) * (acc[ci][ii][4 * q + 0] + bs) * bflo(gg[0]), bfhi(u[0]) * (acc[ci][ii][4 * q + 1] + bs) * bfhi(gg[0]));
                ov[1] = pk2(bflo(u[1]) * (acc[ci][ii][4 * q + 2] + bs) * bflo(gg[1]), bfhi(u[1]) * (acc[ci][ii][4 * q + 3] + bs) * bfhi(gg[1]));
                *(u32x2*)(OM + tok * 512 + c0) = ov;
            }
    }
}

DI void retout_item(const Ctx& c, int l, int bl, int h, int m) {
    bf16_t* Ks = (bf16_t*)c.smem;
    bf16_t* Vs = Ks + 128 * 136;
    const size_t tok0 = (size_t)bl * PP + m * 128;
    const bf16_t* RK = (const bf16_t*)(c.ws + OFF_RK) + tok0 * 512 + h * 128;
    const bf16_t* RVT = (const bf16_t*)(c.ws + OFF_RVT) + (size_t)(bl * 4 + h) * 128 * PP + m * 128;
    __syncthreads();
    {
        u32x4 tk[8], tv[8];
#pragma unroll
        for (int it = 0; it < 8; ++it) {
            const int idx = c.tid + 256 * it, row = idx >> 4, seg = idx & 15;
            tk[it] = *(const u32x4*)(RK + (size_t)row * 512 + seg * 8);
            tv[it] = *(const u32x4*)(RVT + (size_t)row * PP + seg * 8);
        }
#pragma unroll
        for (int it = 0; it < 8; ++it) {
            const int idx = c.tid + 256 * it, row = idx >> 4, seg = idx & 15;
            *(u32x4*)(Ks + row * 136 + seg * 8) = tk[it];
            u32x2 lo2, hi2; lo2[0] = tv[it][0]; lo2[1] = tv[it][1]; hi2[0] = tv[it][2]; hi2[1] = tv[it][3];
            *(u32x2*)(Vs + row * 132 + seg * 8) = lo2; *(u32x2*)(Vs + row * 132 + seg * 8 + 4) = hi2;
        }
    }
    __syncthreads();
    const int i = c.w * 32 + c.l31;
    const size_t tok = tok0 + i;
    const float lgf = c.cst[4 + l * 8 + h], lgb = c.cst[4 + l * 8 + 4 + h];
    bf16x8 qf[8];
    const bf16_t* RQ = (const bf16_t*)(c.ws + OFF_RQ) + tok * 512 + h * 128;
#pragma unroll
    for (int ks = 0; ks < 8; ++ks) qf[ks] = *(const bf16x8*)(RQ + ks * 16 + c.hl * 8);
    f32x16 o[4];
    const bf16_t* stf = (const bf16_t*)(c.ws + OFF_ST) + (size_t)(((bl * 4 + h) * 2 + 0) * NCH + m) * 16384;
    const bf16_t* stb = (const bf16_t*)(c.ws + OFF_ST) + (size_t)(((bl * 4 + h) * 2 + 1) * NCH + m) * 16384;
    const float qdf = __builtin_amdgcn_exp2f(lgf * (float)(i + 1)), qdb = __builtin_amdgcn_exp2f(lgb * (float)(128 - i));
#pragma unroll
    for (int et = 0; et < 4; ++et) {
        f32x16 tf, tb;
#pragma unroll
        for (int r = 0; r < 16; ++r) { tf[r] = 0.f; tb[r] = 0.f; }
#pragma unroll
        for (int ks = 0; ks < 8; ++ks) {
            const bf16x8 a = *(const bf16x8*)(stf + (et * 32 + c.l31) * 128 + ks * 16 + c.hl * 8);
            const bf16x8 b = *(const bf16x8*)(stb + (et * 32 + c.l31) * 128 + ks * 16 + c.hl * 8);
            tf = MFMA(a, qf[ks], tf);
            tb = MFMA(b, qf[ks], tb);
        }
#pragma unroll
        for (int r = 0; r < 16; ++r) o[et][r] = tf[r] * qdf + tb[r] * qdb;
        __builtin_amdgcn_sched_barrier(0);
    }
#pragma unroll
    for (int jt = 0; jt < 4; ++jt) {
        f32x16 sc;
#pragma unroll
        for (int r = 0; r < 16; ++r) sc[r] = 0.f;
#pragma unroll
        for (int ks = 0; ks < 8; ++ks) {
            const bf16x8 a = *(const bf16x8*)(Ks + (jt * 32 + c.l31) * 136 + ks * 16 + c.hl * 8);
            sc = MFMA(a, qf[ks], sc);
        }
#pragma unroll
        for (int r = 0; r < 16; ++r) {
            const int j = jt * 32 + crow(r, c.hl);
            const int dl = i - j;
            const float arg = dl > 0 ? lgf * (float)dl : -lgb * (float)dl;
            float f = __builtin_amdgcn_exp2f(arg);
            f = dl == 0 ? 2.f : f;
            sc[r] *= f;
        }
#pragma unroll
        for (int s2 = 0; s2 < 2; ++s2) {
            u32x4 pp;
            pp[0] = pk2(sc[8 * s2 + 0], sc[8 * s2 + 1]); pp[1] = pk2(sc[8 * s2 + 2], sc[8 * s2 + 3]);
            pp[2] = pk2(sc[8 * s2 + 4], sc[8 * s2 + 5]); pp[3] = pk2(sc[8 * s2 + 6], sc[8 * s2 + 7]);
            const bf16x8 pf = __builtin_bit_cast(bf16x8, pp);
#pragma unroll
            for (int et = 0; et < 4; ++et) {
                const bf16_t* vp = Vs + (et * 32 + c.l31) * 132 + jt * 32 + 16 * s2 + 4 * c.hl;
                const u32x2 lo = *(const u32x2*)vp, hi = *(const u32x2*)(vp + 8);
                u32x4 av; av[0] = lo[0]; av[1] = lo[1]; av[2] = hi[0]; av[3] = hi[1];
                o[et] = MFMA(__builtin_bit_cast(bf16x8, av), pf, o[et]);
            }
        }
        __builtin_amdgcn_sched_barrier(0);
    }
    float ss = 0.f;
#pragma unroll
    for (int et = 0; et < 4; ++et)
#pragma unroll
        for (int r = 0; r < 16; ++r) ss += o[et][r] * o[et][r];
    ss += __shfl_xor(ss, 32);
    const float rn = rsqrtf(ss * (1.f / 128.f) + EPS);
    const bf16_t* RG = (const bf16_t*)(c.ws + OFF_RG) + tok * 512 + h * 128;
    bf16_t* OR = (bf16_t*)(c.ws + OFF_ORET) + tok * 512 + h * 128;
#pragma unroll
    for (int et = 0; et < 4; ++et)
#pragma unroll
        for (int q = 0; q < 4; ++q) {
            const int e0 = et * 32 + 8 * q + 4 * c.hl;
            const u32x2 g = *(const u32x2*)(RG + e0);
            u32x2 ov;
            ov[0] = pk2(o[et][4 * q + 0] * rn * bflo(g[0]), o[et][4 * q + 1] * rn * bfhi(g[0]));
            ov[1] = pk2(o[et][4 * q + 2] * rn * bflo(g[1]), o[et][4 * q + 3] * rn * bfhi(g[1]));
            *(u32x2*)(OR + e0) = ov;
        }
}

DI void pm_item(const Ctx& c, int l, int rt, int nt) {
    f32x16 y[2][2], acc[2][2];
    zero_acc(y);
    const int wn = c.w >> 1, wm = c.w & 1;
    const bf16_t* MLOG = (const bf16_t*)(c.ws + OFF_MLOG);
#pragma unroll 1
    for (int br = 0; br < 3; ++br) {
        const size_t ooff = br == 0 ? OFF_ORET : (br == 1 ? OFF_OMLP : OFF_ODIFF);
        zero_acc(acc);
        gemm_core(c, (const bf16_t*)(c.ws + OFF_WBO) + ((size_t)(l * 3 + br) * 1024 + (size_t)nt * 128) * 512, 512,
                  (const bf16_t*)(c.ws + ooff) + (size_t)rt * 128 * 512, 512, 512, acc);
#pragma unroll
        for (int j = 0; j < 2; ++j) {
            const size_t tok = (size_t)rt * 128 + wm * 64 + j * 32 + c.l31;
#pragma unroll
            for (int i = 0; i < 2; ++i)
#pragma unroll
                for (int q = 0; q < 4; ++q) {
                    const int n0 = nt * 128 + wn * 64 + i * 32 + 8 * q + 4 * c.hl;
                    const u32x2 g = *(const u32x2*)(MLOG + tok * 3072 + br * 1024 + n0);
                    y[i][j][4 * q + 0] += bflo(g[0]) * acc[i][j][4 * q + 0];
                    y[i][j][4 * q + 1] += bfhi(g[0]) * acc[i][j][4 * q + 1];
                    y[i][j][4 * q + 2] += bflo(g[1]) * acc[i][j][4 * q + 2];
                    y[i][j][4 * q + 3] += bfhi(g[1]) * acc[i][j][4 * q + 3];
                }
        }
    }
    bf16_t* Y = (bf16_t*)(c.ws + OFF_Y);
#pragma unroll
    for (int j = 0; j < 2; ++j) {
        const size_t tok = (size_t)rt * 128 + wm * 64 + j * 32 + c.l31;
#pragma unroll
        for (int i = 0; i < 2; ++i)
#pragma unroll
            for (int q = 0; q < 4; ++q) {
                const int n0 = nt * 128 + wn * 64 + i * 32 + 8 * q + 4 * c.hl;
                u32x2 ov; ov[0] = pk2(y[i][j][4 * q + 0], y[i][j][4 * q + 1]); ov[1] = pk2(y[i][j][4 * q + 2], y[i][j][4 * q + 3]);
                *(u32x2*)(Y + tok * 1024 + n0) = ov;
            }
    }
}
DI void po_item(const Ctx& c, int l, int rt2, int nt) {
    f32x16 acc[2][4];
    zero_acc2(acc);
    gemm_core2(c, (const bf16_t*)(c.ws + OFF_WO) + ((size_t)l * 1024 + (size_t)nt * 128) * 1024, 1024,
               (const bf16_t*)(c.ws + OFF_Y) + (size_t)rt2 * 256 * 1024, 1024, 1024, acc);
    const int wn = c.w >> 1, wm = c.w & 1;
    float* OUT = (float*)(c.ws + OFF_OUT);
#pragma unroll
    for (int j = 0; j < 4; ++j) {
        const size_t tok = (size_t)rt2 * 256 + wm * 128 + j * 32 + c.l31;
#pragma unroll
        for (int i = 0; i < 2; ++i)
#pragma unroll
            for (int q = 0; q < 4; ++q) {
                const int n0 = nt * 128 + wn * 64 + i * 32 + 8 * q + 4 * c.hl;
                f32x4 ov; ov[0] = acc[i][j][4 * q + 0]; ov[1] = acc[i][j][4 * q + 1]; ov[2] = acc[i][j][4 * q + 2]; ov[3] = acc[i][j][4 * q + 3];
                *(f32x4*)(OUT + tok * 1024 + n0) = ov;
            }
    }
}

extern __shared__ __attribute__((aligned(16))) unsigned char dynsmem[];
constexpr int LDS_BYTES = 72 * 1024;

DI Ctx mk_ctx(const Params& p, const float* cst, int wv) {
    Ctx c;
    c.x = p.in[0]; c.c = p.in[1]; c.ctx = p.in[2]; c.c_ctx = p.in[3]; c.w_mod = p.in[4]; c.b_mod = p.in[5]; c.g_pre = p.in[6]; c.g_post = p.in[7];
    c.w_in = p.in[8]; c.decay = p.in[9]; c.w_s = p.in[10]; c.b_s = p.in[11]; c.lq = p.in[12]; c.lk = p.in[13]; c.w_bo = p.in[14]; c.w_out = p.in[15];
    c.out = p.out; c.ws = p.ws; c.smem = dynsmem; c.cst = cst;
    unsigned zl = 0u;
    asm volatile("" : "+v"(zl));
    int tid = wv * 64 + (int)__builtin_amdgcn_mbcnt_hi(~0u, __builtin_amdgcn_mbcnt_lo(~0u, zl));
    asm volatile("" : "+v"(tid));
    size_t zoff = 0;
    asm volatile("" : "+s"(zoff));
    c.ws = p.ws + zoff;
    c.tid = tid; c.lane = tid & 63; c.w = tid >> 6; c.l31 = c.lane & 31; c.hl = c.lane >> 5;
    return c;
}
DI void relaunder(Ctx& c) {
    int t = c.tid;
    asm volatile("" : "+v"(t));
    c.tid = t; c.lane = t & 63; c.w = t >> 6; c.l31 = c.lane & 31; c.hl = c.lane >> 5;
}

__global__ void __launch_bounds__(256, 2) mega(Params p) {
    __shared__ uint4 xbw;
    __shared__ float cst[32];
    const int wv = __builtin_amdgcn_readfirstlane((int)threadIdx.x >> 6);
    Ctx c = mk_ctx(p, cst, wv);
    if (c.tid == 0) xbw = make_uint4(0u, 0u, 0u, 0u);
    if (c.tid < 64) {
        for (int l = 0; l < 2; ++l) {
            float a = c.lq[(l * 2 + 0) * 64 + c.tid] * c.lk[(l * 2 + 0) * 64 + c.tid];
            float b = c.lq[(l * 2 + 1) * 64 + c.tid] * c.lk[(l * 2 + 1) * 64 + c.tid];
            a = wave_sum(a); b = wave_sum(b);
            const float lam_init = 0.8f - 0.6f * expf(-0.3f * (float)l);
            if (c.tid == 0) { cst[l] = expf(a) - expf(b) + lam_init; cst[2 + l] = lam_init; }
        }
        if (c.tid < 16) {
            const float z = c.decay[c.tid];
            cst[4 + c.tid] = -log1pf(expf(-z)) * LOG2E;
        }
    }
    __syncthreads();
    XcdBarrier bar = xcd_barrier_post((unsigned*)(p.ws + OFF_BAR), (volatile LAS unsigned*)&xbw, c.tid == 0);
    const int G = gridDim.x, bid = blockIdx.x;
    constexpr int NPH = 2 + NGRP * 12;
#pragma unroll 1
    for (int ph = 0; ph < NPH; ++ph) {
        c = mk_ctx(p, cst, wv);
        int kind, g = 0, l = 0;
        if (ph == 0) kind = 0;
        else if (ph == 1) kind = 1;
        else { const int q = ph - 2; g = q / 12; const int r = q % 12; l = r / 6; kind = 2 + r % 6; }
#ifndef ECHO_KIND
#define ECHO_KIND -1
#endif
        const unsigned long long tph0 = (ECHO_KIND >= 0) ? __builtin_amdgcn_s_memrealtime() : 0ull;
        switch (kind) {
        case 0:
#pragma unroll 1
            for (int it = bid; it < 2 * 1408 + 192; it += G) { relaunder(c); p0_item(c, it); }
            break;
        case 1:
#pragma unroll 1
            for (int it = bid; it < NT / 4; it += G) { relaunder(c); ph_item(c, g, it); }
            break;
        case 2:
            if ((G & 7) == 0) {
                const int x = bid & 7, jl = bid >> 3, GL = G >> 3;
#pragma unroll 1
                for (int k = jl; k < 306; k += GL) {
                    int ct, rt2;
                    if (k < 288) { ct = 8 * (k & 7) + x; rt2 = k >> 3; }
                    else { ct = 64 + (x >> 1); rt2 = (x & 1) * 18 + (k - 288); }
                    if (l == 1 && (rt2 % 9) == 0 && ct >= 16) continue;
                    relaunder(c);
                    pz_item(c, l, rt2, ct);
                }
            } else {
#pragma unroll 1
                for (int it = bid; it < 36 * 68; it += G) {
                    const int ct = it % 68, rt2 = it / 68;
                    if (l == 1 && (rt2 % 9) == 0 && ct >= 16) continue;
                    relaunder(c);
                    pz_item(c, l, rt2, ct);
                }
            }
            break;
        case 3: {
            const int n_att = 512, n_catt = (l == 0) ? 64 : 0, n_scan = 128, n_mlp = (l == 0) ? 288 : 256;
            const int total = n_att + n_catt + n_scan + n_mlp;
#pragma unroll 1
            for (int it = bid; it < total; it += G) {
                int r = it;
                relaunder(c);
                if (r < n_att + n_catt) {
                    int bl, h, q0, nk;
                    if (r < n_att) { bl = r >> 7; h = (r >> 5) & 3; q0 = CTXL + (r & 31) * 64; nk = PP; }
                    else { r -= n_att; bl = r >> 4; h = (r >> 2) & 3; q0 = (r & 3) * 64; nk = CTXL; }
                    attn_item(c, l, bl, h, q0, nk);
                    continue;
                }
                r -= n_att + n_catt;
                if (r < n_scan) { const int bl = r >> 5, h = (r >> 3) & 3, dir = (r >> 2) & 1, es = r & 3; scan_item(c, l, bl, h, dir, es); continue; }
                r -= n_scan;
                int bl, m, gg;
                if (l == 0) { bl = r / 72; const int q = r % 72; m = q >> 2; gg = q & 3; }
                else { bl = r >> 6; const int q = r & 63; m = 2 + (q >> 2); gg = q & 3; }
                mlp_item(c, l, bl, m, gg);
            }
            break; }
        case 4: {
            const int total = (l == 0) ? 288 : 256;
#pragma unroll 1
            for (int it = bid; it < total; it += G) {
                int bl, m, h;
                if (l == 0) { bl = it / 72; const int q = it % 72; h = q & 3; m = q >> 2; }
                else { bl = it >> 6; const int q = it & 63; h = q & 3; m = 2 + (q >> 2); }
                relaunder(c);
                retout_item(c, l, bl, h, m);
            }
            break; }
        case 5: {
            const int nrt = (l == 0) ? 72 : 64;
#pragma unroll 1
            for (int it = bid; it < nrt * 8; it += G) {
                const int nt = it & 7, rr = it >> 3;
                const int rt = (l == 0) ? rr : (rr >> 4) * NCH + 2 + (rr & 15);
                relaunder(c);
                pm_item(c, l, rt, nt);
            }
            break; }
        case 6: {
            const int nrt = (l == 0) ? 72 : 64;
#pragma unroll 1
            for (int it = bid; it < (nrt / 2) * 8; it += G) {
                const int nt = it & 7, rr = it >> 3;
                const int rt2 = (l == 0) ? rr : (rr >> 3) * 9 + 1 + (rr & 7);
                relaunder(c);
                po_item(c, l, rt2, nt);
            }
            break; }
        default:
#pragma unroll 1
            for (int it = bid; it < NT / 4; it += G) { relaunder(c); pr_item(c, l, g, it); }
            if (g + 1 < NGRP && l == 1) {
#pragma unroll 1
                for (int it = bid; it < NT / 4; it += G) { relaunder(c); ph_item(c, g + 1, it); }
            }
            break;
        }
        if (ECHO_KIND >= 0 && kind == ECHO_KIND) { __syncthreads(); const unsigned long long tb = __builtin_amdgcn_s_memrealtime(), dt = tb - tph0; while (__builtin_amdgcn_s_memrealtime() - tb < dt) __builtin_amdgcn_s_sleep(8); }
        if (ph + 1 < NPH) xcd_barrier(bar, c.tid == 0);
    }
}

extern "C" void kernel_launch(void* const* d_in, const int* in_sizes, int n_in, void* d_out, int out_size, void* d_ws, size_t ws_size, hipStream_t stream) {
    static int grid = 0;
    if (grid == 0) {
        int dev = 0, cus = 0, per_cu = 0;
        hipGetDevice(&dev);
        hipDeviceGetAttribute(&cus, hipDeviceAttributeMultiprocessorCount, dev);
        hipFuncSetAttribute((const void*)mega, hipFuncAttributeMaxDynamicSharedMemorySize, LDS_BYTES);
        hipOccupancyMaxActiveBlocksPerMultiprocessor(&per_cu, (const void*)mega, 256, LDS_BYTES);
        if (per_cu > 2) per_cu = 2;
        if (per_cu < 1) per_cu = 1;
        grid = cus * per_cu;
        if (ws_size < WS_END) { fprintf(stderr, "workspace too small: %zu < %zu\n", ws_size, (size_t)WS_END); grid = -1; }
    }
    if (grid < 0) return;
    hipMemsetAsync((unsigned char*)d_ws + OFF_BAR, 0, XCD_BAR_WORDS * 4, stream);
    Params p{};
    for (int i = 0; i < 16; ++i) p.in[i] = (const float*)d_in[i];
    p.out = (float*)d_out; p.ws = (unsigned char*)d_ws;
    void* args[] = {&p};
    hipError_t e = hipLaunchCooperativeKernel((const void*)mega, dim3(grid), dim3(256), args, LDS_BYTES, stream);
    if (e != hipSuccess) fprintf(stderr, "cooperative launch failed: %s (grid %d)\n", hipGetErrorString(e), grid);
}
```

```cpp
#include <hip/hip_runtime.h>
#include <cstdio>
#include <cstdint>

#define DI __device__ __forceinline__
#define LAS __attribute__((address_space(3)))
typedef unsigned short bf16_t;
typedef short bf16x8 __attribute__((ext_vector_type(8)));
typedef float f32x16 __attribute__((ext_vector_type(16)));
typedef float f32x4 __attribute__((ext_vector_type(4)));
typedef float f32x2 __attribute__((ext_vector_type(2)));
typedef unsigned u32x4 __attribute__((ext_vector_type(4)));
typedef unsigned u32x2 __attribute__((ext_vector_type(2)));
#define MFMA(a, b, c) __builtin_amdgcn_mfma_f32_32x32x16_bf16((a), (b), (c), 0, 0, 0)

#define XB_TMO      128
#define XB_XCNT(j)  (256  + 64 * (j))
#define XB_XSUB(j)  (1280 + 64 * (j))
#define XB_XGEN(j)  (2304 + 64 * (j))
#define XB_TOP      3328
#define XB_TOPGEN   3392
#define XCD_BAR_WORDS 3456
#define XB_SPIN_CAP (1u << 22)
DI unsigned xb_ld(unsigned* p)              { return __hip_atomic_load(p, __ATOMIC_RELAXED, __HIP_MEMORY_SCOPE_AGENT); }
DI unsigned xb_add(unsigned* p, unsigned v) { return __hip_atomic_fetch_add(p, v, __ATOMIC_RELAXED, __HIP_MEMORY_SCOPE_AGENT); }
DI unsigned xb_xcc_id() { return (unsigned)__builtin_amdgcn_s_getreg((3 << 11) | 20) & 0xFu; }
#define XB_SPIN(cond, bar) do { unsigned _sp = 0; while (cond) { __builtin_amdgcn_s_sleep(1); \
    if ((++_sp & 255u) == 0u) { if (xb_ld(&(bar)[XB_TMO])) break; if (_sp > XB_SPIN_CAP) { atomicAdd(&(bar)[XB_TMO], 1u); break; } } } } while (0)
struct XcdBarrier { unsigned* bar; unsigned x; volatile LAS unsigned* st; };
DI XcdBarrier xcd_barrier_post(unsigned* bar, volatile LAS unsigned* st, bool t0) {
    XcdBarrier b; b.bar = bar; b.x = xb_xcc_id(); b.st = st;
    if (t0) (void)xb_add(&bar[XB_XCNT(b.x)], 1u);
    return b;
}
DI void xcd_barrier_complete(unsigned* bar, unsigned x, unsigned& nloc, unsigned& nx) {
    const unsigned G = gridDim.x * gridDim.y * gridDim.z;
    unsigned sum, cnt, mine, sp = 0u;
    for (;;) {
        sum = 0u; cnt = 0u; mine = 0u;
#pragma unroll
        for (unsigned j = 0; j < 16; ++j) { const unsigned c = xb_ld(&bar[XB_XCNT(j)]); sum += c; cnt += (c > 0u) ? 1u : 0u; mine = (j == x) ? c : mine; }
        if (sum == G) break;
        __builtin_amdgcn_s_sleep(1);
        if ((++sp & 255u) == 0u) { if (xb_ld(&bar[XB_TMO])) break; if (sp > XB_SPIN_CAP) { atomicAdd(&bar[XB_TMO], 1u); break; } }
    }
    nloc = mine > 0u ? mine : 1u; nx = cnt > 0u ? cnt : 1u;
}
DI void xcd_barrier(const XcdBarrier& b, bool t0) {
    asm volatile("s_waitcnt vmcnt(0)" ::: "memory");
    __syncthreads();
    if (t0) {
        unsigned* bar = b.bar;
        __builtin_amdgcn_s_waitcnt(0);
        unsigned nloc = b.st[0], nx = b.st[1];
        if (nloc == 0u) { xcd_barrier_complete(bar, b.x, nloc, nx); b.st[0] = nloc; b.st[1] = nx; }
        const unsigned old = xb_add(&bar[XB_XSUB(b.x)], 1u);
        const unsigned gen = old / nloc;
        if (old + 1u == (gen + 1u) * nloc) {
            __builtin_amdgcn_fence(__ATOMIC_RELEASE, "agent");
            asm volatile("s_waitcnt vmcnt(0)" ::: "memory");
            const unsigned og = xb_add(&bar[XB_TOP], 1u);
            const unsigned tg = og / nx;
            if (og + 1u == (tg + 1u) * nx) xb_add(&bar[XB_TOPGEN], 1u);
            else XB_SPIN(xb_ld(&bar[XB_TOPGEN]) == tg, bar);
            __builtin_amdgcn_fence(__ATOMIC_ACQUIRE, "agent");
            xb_add(&bar[XB_XGEN(b.x)], 1u);
            asm volatile("s_waitcnt vmcnt(0)" ::: "memory");
        } else {
            XB_SPIN(xb_ld(&bar[XB_XGEN(b.x)]) == gen, bar);
            __builtin_amdgcn_fence(__ATOMIC_ACQUIRE, "agent");
            asm volatile("s_waitcnt vmcnt(0)" ::: "memory");
        }
    }
    __syncthreads();
}

constexpr int DM = 1024, SEQL = 2048, CTXL = 256, PP = 2304  ;
constexpr int NBG = 4  , NGRP = 2, NT = NBG * PP  ;
constexpr int INC = 8704, NCH = 18  ;
constexpr int LDH = 1088, LDW = 1088;
constexpr float EPS = 1e-6f;
constexpr float LOG2E = 1.4426950408889634f;

constexpr size_t TB = (size_t)NT * 512 * 2;
constexpr size_t OFF_BAR = 0;
constexpr size_t OFF_MOD = 16384;
constexpr size_t OFF_WIN = OFF_MOD + 262144;
constexpr size_t OFF_WBO = OFF_WIN + (size_t)2 * INC * LDW * 2;
constexpr size_t OFF_WO  = OFF_WBO + (size_t)2 * 3 * 1024 * 512 * 2;
constexpr size_t OFF_H   = OFF_WO + (size_t)2 * 1024 * 1024 * 2;
constexpr size_t OFF_RK  = OFF_H + (size_t)NT * LDH * 2;
constexpr size_t OFF_RKT = OFF_RK + TB;
constexpr size_t OFF_RVT = OFF_RKT + TB;
constexpr size_t OFF_DK  = OFF_RVT + TB;
constexpr size_t OFF_DVT = OFF_DK + TB;
constexpr size_t OFF_RQ  = OFF_DVT + TB;
constexpr size_t OFF_RG  = OFF_RQ + TB;
constexpr size_t OFF_DQ  = OFF_RG + TB;
constexpr size_t OFF_DG  = OFF_DQ + TB;
constexpr size_t OFF_MU  = OFF_DG + TB;
constexpr size_t OFF_MV  = OFF_MU + TB;
constexpr size_t OFF_MG  = OFF_MV + TB;
constexpr size_t OFF_MLOG = OFF_MG + TB;
constexpr size_t OFF_OMLP = OFF_MLOG + 6 * TB;
constexpr size_t OFF_ODIFF = OFF_OMLP + TB;
constexpr size_t OFF_ROPE = OFF_ODIFF + TB;
constexpr size_t WS_END = OFF_ROPE + (size_t)2048 * 96 * 8;
constexpr size_t OFF_ST = OFF_H;
constexpr size_t OFF_ORET = OFF_DK;
constexpr size_t OFF_Y = OFF_RK;
constexpr size_t OFF_OUT = OFF_MLOG;

struct Params {
    const float* in[16];
    float* out;
    unsigned char* ws;
};

struct Ctx {
    const float *x, *c, *ctx, *c_ctx, *w_mod, *b_mod, *g_pre, *g_post, *w_in, *decay, *w_s, *b_s, *lq, *lk, *w_bo, *w_out;
    float* out;
    unsigned char* ws;
    unsigned char* smem;
    const float* cst;
    int tid, lane, w, l31, hl;
};

DI unsigned pk2(float lo, float hi) {
    typedef __bf16 b2 __attribute__((ext_vector_type(2)));
    f32x2 v = {lo, hi};
    b2 r = __builtin_convertvector(v, b2);
    return __builtin_bit_cast(unsigned, r);
}
DI bf16_t f2bf(float x) { return (bf16_t)(pk2(x, 0.f) & 0xffffu); }
DI float bflo(unsigned u) { return __uint_as_float(u << 16); }
DI float bfhi(unsigned u) { return __uint_as_float(u & 0xffff0000u); }
DI int crow(int r, int hl) { return (r & 3) + 8 * (r >> 2) + 4 * hl; }
DI float wave_sum(float v) {
#pragma unroll
    for (int o = 1; o < 64; o <<= 1) v += __shfl_xor(v, o);
    return v;
}
DI float fsig(float x) { return __builtin_amdgcn_rcpf(1.f + __builtin_amdgcn_exp2f(-LOG2E * x)); }
DI void sincos_rev(float rev, float& sn, float& cs) {
    const float g = __builtin_amdgcn_fractf(rev) - 0.5f;
    const bool fold = fabsf(g) > 0.25f;
    const float h = fold ? (copysignf(0.5f, g) - g) : g;
    const float x = h * 6.283185307179586f;
    const float x2 = x * x;
    const float sp = x * (1.f + x2 * (-1.6666667e-1f + x2 * (8.3333333e-3f + x2 * (-1.9841270e-4f + x2 * (2.7557319e-6f - x2 * 2.5052108e-8f)))));
    const float cp = 1.f + x2 * (-0.5f + x2 * (4.1666667e-2f + x2 * (-1.3888889e-3f + x2 * (2.4801587e-5f + x2 * (-2.7557319e-7f + x2 * 2.0876757e-9f)))));
    sn = -sp;
    cs = fold ? cp : -cp;
}
DI float silu_f(float x) { return x / (1.f + __expf(-x)); }
DI float sigmoid_f(float x) { return 1.f / (1.f + __expf(-x)); }

DI void gemm_core(const Ctx& c, const bf16_t* __restrict__ Wt, int ldw, const bf16_t* __restrict__ Act, int lda, int K, f32x16 (&acc)[2][2]) {
    bf16_t* Ws = (bf16_t*)c.smem;
    bf16_t* As = Ws + 128 * 72;
    const int wn = c.w >> 1, wm = c.w & 1;
    const int lrow = c.tid >> 3, lseg = c.tid & 7;
    u32x4 rw[4], ra[4];
#pragma unroll
    for (int it = 0; it < 4; ++it) {
        rw[it] = *(const u32x4*)(Wt + (size_t)(lrow + 32 * it) * ldw + lseg * 8);
        ra[it] = *(const u32x4*)(Act + (size_t)(lrow + 32 * it) * lda + lseg * 8);
    }
    for (int k0 = 0; k0 < K; k0 += 64) {
        __syncthreads();
#pragma unroll
        for (int it = 0; it < 4; ++it) {
            *(u32x4*)(Ws + (lrow + 32 * it) * 72 + lseg * 8) = rw[it];
            *(u32x4*)(As + (lrow + 32 * it) * 72 + lseg * 8) = ra[it];
        }
        __syncthreads();
        if (k0 + 64 < K) {
#pragma unroll
            for (int it = 0; it < 4; ++it) {
                rw[it] = *(const u32x4*)(Wt + (size_t)(lrow + 32 * it) * ldw + k0 + 64 + lseg * 8);
                ra[it] = *(const u32x4*)(Act + (size_t)(lrow + 32 * it) * lda + k0 + 64 + lseg * 8);
            }
        }
#pragma unroll
        for (int ks = 0; ks < 4; ++ks) {
            const bf16x8 a0 = *(const bf16x8*)(Ws + (wn * 64 + c.l31) * 72 + ks * 16 + c.hl * 8);
            const bf16x8 a1 = *(const bf16x8*)(Ws + (wn * 64 + 32 + c.l31) * 72 + ks * 16 + c.hl * 8);
            const bf16x8 b0 = *(const bf16x8*)(As + (wm * 64 + c.l31) * 72 + ks * 16 + c.hl * 8);
            const bf16x8 b1 = *(const bf16x8*)(As + (wm * 64 + 32 + c.l31) * 72 + ks * 16 + c.hl * 8);
            acc[0][0] = MFMA(a0, b0, acc[0][0]);
            acc[0][1] = MFMA(a0, b1, acc[0][1]);
            acc[1][0] = MFMA(a1, b0, acc[1][0]);
            acc[1][1] = MFMA(a1, b1, acc[1][1]);
        }
    }
}
DI void zero_acc(f32x16 (&acc)[2][2]) {
#pragma unroll
    for (int i = 0; i < 2; ++i)
#pragma unroll
        for (int j = 0; j < 2; ++j)
#pragma unroll
            for (int r = 0; r < 16; ++r) acc[i][j][r] = 0.f;
}


DI void gemm_core2(const Ctx& c, const bf16_t* __restrict__ Wt, int ldw, const bf16_t* __restrict__ Act, int lda, int K, f32x16 (&acc)[2][4]) {
    constexpr int RS = 32;
    constexpr int STG = 384 * RS;
    bf16_t* S = (bf16_t*)c.smem;
    const int wn = c.w >> 1, wm = c.w & 1;
    const int lrow = c.tid >> 2, lseg = c.tid & 3;
    const int scol = (lseg ^ ((c.tid >> 4) & 3)) * 8;
    const int rsw = (c.l31 >> 2) & 3;
    const bf16_t* wp = Wt + (size_t)lrow * ldw + lseg * 8;
    const bf16_t* ap = Act + (size_t)lrow * lda + lseg * 8;
    u32x4 rw[2], ra[4];
#pragma unroll
    for (int it = 0; it < 2; ++it) rw[it] = *(const u32x4*)(wp + (size_t)(64 * it) * ldw);
#pragma unroll
    for (int it = 0; it < 4; ++it) ra[it] = *(const u32x4*)(ap + (size_t)(64 * it) * lda);
    __syncthreads();
#pragma unroll
    for (int it = 0; it < 2; ++it) *(u32x4*)(S + (lrow + 64 * it) * RS + scol) = rw[it];
#pragma unroll
    for (int it = 0; it < 4; ++it) *(u32x4*)(S + (128 + lrow + 64 * it) * RS + scol) = ra[it];
    if (K > 32) {
#pragma unroll
        for (int it = 0; it < 2; ++it) rw[it] = *(const u32x4*)(wp + (size_t)(64 * it) * ldw + 32);
#pragma unroll
        for (int it = 0; it < 4; ++it) ra[it] = *(const u32x4*)(ap + (size_t)(64 * it) * lda + 32);
    }
    __syncthreads();
    for (int k0 = 0; k0 < K; k0 += 32) {
        const int s = (k0 >> 5) & 1;
        bf16_t* Sc = S + s * STG;
        bf16_t* Sn = S + (s ^ 1) * STG;
        if (k0 + 32 < K) {
#pragma unroll
            for (int it = 0; it < 2; ++it) *(u32x4*)(Sn + (lrow + 64 * it) * RS + scol) = rw[it];
#pragma unroll
            for (int it = 0; it < 4; ++it) *(u32x4*)(Sn + (128 + lrow + 64 * it) * RS + scol) = ra[it];
            if (k0 + 64 < K) {
#pragma unroll
                for (int it = 0; it < 2; ++it) rw[it] = *(const u32x4*)(wp + (size_t)(64 * it) * ldw + k0 + 64);
#pragma unroll
                for (int it = 0; it < 4; ++it) ra[it] = *(const u32x4*)(ap + (size_t)(64 * it) * lda + k0 + 64);
            }
        }
#pragma unroll
        for (int ks = 0; ks < 2; ++ks) {
            const int rcol = ((ks * 2 + c.hl) ^ rsw) * 8;
            bf16x8 a[2], b[4];
#pragma unroll
            for (int i = 0; i < 2; ++i) a[i] = *(const bf16x8*)(Sc + (wn * 64 + i * 32 + c.l31) * RS + rcol);
#pragma unroll
            for (int j = 0; j < 4; ++j) b[j] = *(const bf16x8*)(Sc + (128 + wm * 128 + j * 32 + c.l31) * RS + rcol);
#pragma unroll
            for (int i = 0; i < 2; ++i)
#pragma unroll
                for (int j = 0; j < 4; ++j) acc[i][j] = MFMA(a[i], b[j], acc[i][j]);
        }
        __syncthreads();
    }
}
DI void zero_acc2(f32x16 (&acc)[2][4]) {
#pragma unroll
    for (int i = 0; i < 2; ++i)
#pragma unroll
        for (int j = 0; j < 4; ++j)
#pragma unroll
            for (int r = 0; r < 16; ++r) acc[i][j][r] = 0.f;
}

DI void transpose_item(const Ctx& c, const float* __restrict__ src, int N, int k0, int n0, int mapk, bf16_t* __restrict__ dst, int ldk) {
    float* T = (float*)c.smem;
    __syncthreads();
    {
        f32x4 tv[8];
#pragma unroll
        for (int it = 0; it < 8; ++it) { const int idx = c.tid + 256 * it; tv[it] = *(const f32x4*)(src + (size_t)(k0 + (idx >> 5)) * N + n0 + (idx & 31) * 4); }
#pragma unroll
        for (int it = 0; it < 8; ++it) {
            const int idx = c.tid + 256 * it, r = idx >> 5, c4 = idx & 31;
            float* t = T + r * 129 + c4 * 4;
            t[0] = tv[it][0]; t[1] = tv[it][1]; t[2] = tv[it][2]; t[3] = tv[it][3];
        }
    }
    __syncthreads();
#pragma unroll
    for (int it = 0; it < 4; ++it) {
        const int idx = c.tid + 256 * it, np = idx >> 3, ch = idx & 7;
        int cs = np;
        if (mapk == 1) cs = (np >> 1) + 64 * (np & 1);
        else if (mapk == 2) { const int r = np & 63; cs = (np & 64) + (r >> 1) + 32 * (r & 1); }
        const float* t = T + (ch * 8) * 129 + cs;
        u32x4 o;
        o[0] = pk2(t[0], t[129]); o[1] = pk2(t[2 * 129], t[3 * 129]); o[2] = pk2(t[4 * 129], t[5 * 129]); o[3] = pk2(t[6 * 129], t[7 * 129]);
        *(u32x4*)(dst + (size_t)(n0 + np) * ldk + k0 + ch * 8) = o;
    }
}
DI void mod_item(const Ctx& c, int l, int jb) {
    float* sv = (float*)c.smem;
    float* red = sv + 9 * 1024;
    __syncthreads();
    for (int idx = c.tid; idx < 9216; idx += 256) {
        const int v = idx >> 10, k = idx & 1023;
        const float x = v < 8 ? c.c[v * 1024 + k] : c.c_ctx[k];
        sv[idx] = x / (1.f + expf(-x));
    }
    __syncthreads();
    const int kk = c.tid >> 5, jj = c.tid & 31, j = jb * 32 + jj;
    float a[9];
#pragma unroll
    for (int v = 0; v < 9; ++v) a[v] = 0.f;
    const float* wp = c.w_mod + (size_t)l * 1024 * 3072 + j;
#pragma unroll 4
    for (int i = 0; i < 128; ++i) {
        const int k = kk + 8 * i;
        const float wv = wp[(size_t)k * 3072];
#pragma unroll
        for (int v = 0; v < 9; ++v) a[v] += sv[v * 1024 + k] * wv;
    }
#pragma unroll
    for (int v = 0; v < 9; ++v) red[(kk * 9 + v) * 32 + jj] = a[v];
    __syncthreads();
    float* MOD = (float*)(c.ws + OFF_MOD);
    for (int idx = c.tid; idx < 288; idx += 256) {
        const int v = idx >> 5, j2 = idx & 31;
        float s = 0.f;
#pragma unroll
        for (int k2 = 0; k2 < 8; ++k2) s += red[(k2 * 9 + v) * 32 + j2];
        MOD[(size_t)(l * 9 + v) * 3072 + jb * 32 + j2] = s + c.b_mod[l * 3072 + jb * 32 + j2];
    }
}

DI void rope_item(const Ctx& c, int it) {
    constexpr float L2B = 13.287712379549449f;
    f32x2* T = (f32x2*)(c.ws + OFF_ROPE);
#pragma unroll 1
    for (int e = 0; e < 8; ++e) {
        const int idx = (it * 8 + e) * 256 + c.tid;
        const int lp = idx / 96, a = idx % 96;
        const float rowp = (float)(lp >> 6), colp = (float)(lp & 63);
        float ang;
        if (a < 64) { const int f = a & 31; ang = (a < 32 ? rowp : colp) * exp2f(-(float)f * (L2B / 32.f)); }
        else { const int a2 = a - 64, f = a2 & 15; ang = (a2 < 16 ? rowp : colp) * exp2f(-(float)f * (L2B / 16.f)); }
        f32x2 v; v[0] = cosf(ang); v[1] = sinf(ang);
        T[idx] = v;
    }
}
DI void p0_item(const Ctx& c, int it) {
    if (it < 2 * 1408) {
        const int l = it / 1408; int r = it % 1408;
        if (r < 1088) {
            const int ct = r % 68, kb = r / 68;
            const int kind = ct >> 2;
            const int mapk = (kind == 0 || kind == 4) ? 1 : ((kind == 2 || kind == 6) ? 2 : 0);
            transpose_item(c, c.w_in + (size_t)l * 1024 * INC, INC, kb * 64, ct * 128, mapk, (bf16_t*)(c.ws + OFF_WIN) + (size_t)l * INC * LDW, LDW);
            return;
        }
        r -= 1088;
        if (r < 192) {
            const int br = r / 64, q = r % 64, kb = q >> 3, nb = q & 7;
            transpose_item(c, c.w_bo + (size_t)(l * 3 + br) * 512 * 1024, 1024, kb * 64, nb * 128, 0,
                           (bf16_t*)(c.ws + OFF_WBO) + (size_t)(l * 3 + br) * 1024 * 512, 512);
            return;
        }
        r -= 192;
        { const int kb = r >> 3, nb = r & 7;
          transpose_item(c, c.w_out + (size_t)l * 1024 * 1024, 1024, kb * 64, nb * 128, 0, (bf16_t*)(c.ws + OFF_WO) + (size_t)l * 1024 * 1024, 1024); }
        return;
    }
    it -= 2 * 1408;
    mod_item(c, it / 96, it % 96);
}

DI void modulate_row(const f32x4 (&x)[4], const float* gpre, const float* mod  , bf16_t* hrow, int lane) {
    float ss = 0.f;
#pragma unroll
    for (int j = 0; j < 4; ++j) ss += x[j][0] * x[j][0] + x[j][1] * x[j][1] + x[j][2] * x[j][2] + x[j][3] * x[j][3];
    ss = wave_sum(ss);
    const float r = rsqrtf(ss * (1.f / 1024.f) + EPS);
    f32x4 gq[4], shq[4], scq[4];
#pragma unroll
    for (int j = 0; j < 4; ++j) { const int col = lane * 4 + 256 * j; gq[j] = *(const f32x4*)(gpre + col); shq[j] = *(const f32x4*)(mod + col); scq[j] = *(const f32x4*)(mod + 1024 + col); }
#pragma unroll
    for (int j = 0; j < 4; ++j) {
        const int col = lane * 4 + 256 * j;
        const f32x4 g = gq[j], sh = shq[j], sc = scq[j];
        f32x4 h;
#pragma unroll
        for (int e = 0; e < 4; ++e) h[e] = x[j][e] * r * g[e] * (1.f + sc[e]) + sh[e];
        u32x2 o; o[0] = pk2(h[0], h[1]); o[1] = pk2(h[2], h[3]);
        *(u32x2*)(hrow + col) = o;
    }
}
DI void ph_item(const Ctx& c, int g, int item) {
    const int tok = item * 4 + c.w, bl = tok / PP, p = tok % PP, b = g * NBG + bl;
    const float* src = p < CTXL ? c.ctx + ((size_t)b * CTXL + p) * DM : c.x + ((size_t)b * SEQL + (p - CTXL)) * DM;
    f32x4 x[4];
#pragma unroll
    for (int j = 0; j < 4; ++j) x[j] = *(const f32x4*)(src + c.lane * 4 + 256 * j);
    const float* mod = (const float*)(c.ws + OFF_MOD) + (size_t)(0 * 9 + (p < CTXL ? 8 : b)) * 3072;
    modulate_row(x, c.g_pre, mod, (bf16_t*)(c.ws + OFF_H) + (size_t)tok * LDH, c.lane);
}
DI void pr_item(const Ctx& c, int l, int g, int item) {
    const int tok = item * 4 + c.w, bl = tok / PP, p = tok % PP, b = g * NBG + bl;
    if (l == 1 && p < CTXL) return;
    const float* orow = (const float*)(c.ws + OFF_OUT) + (size_t)tok * DM;
    const int v = p < CTXL ? 8 : b;
    const float* mod = (const float*)(c.ws + OFF_MOD) + (size_t)(l * 9 + v) * 3072;
    float* xo_lat = c.out + ((size_t)b * SEQL + (p - CTXL)) * DM;
    const float* xold = p < CTXL ? c.ctx + ((size_t)b * CTXL + p) * DM : (l == 0 ? c.x + ((size_t)b * SEQL + (p - CTXL)) * DM : xo_lat);
    f32x4 o[4], gpq[4], gtq[4], xvq[4]; float ss = 0.f;
#pragma unroll
    for (int j = 0; j < 4; ++j) {
        const int col = c.lane * 4 + 256 * j;
        o[j] = *(const f32x4*)(orow + col); gpq[j] = *(const f32x4*)(c.g_post + l * 1024 + col); gtq[j] = *(const f32x4*)(mod + 2048 + col); xvq[j] = *(const f32x4*)(xold + col);
    }
#pragma unroll
    for (int j = 0; j < 4; ++j) ss += o[j][0] * o[j][0] + o[j][1] * o[j][1] + o[j][2] * o[j][2] + o[j][3] * o[j][3];
    ss = wave_sum(ss);
    const float r = rsqrtf(ss * (1.f / 1024.f) + EPS);
    f32x4 xn[4];
#pragma unroll
    for (int j = 0; j < 4; ++j) {
        const int col = c.lane * 4 + 256 * j;
        const f32x4 gp = gpq[j], gt = gtq[j], xv = xvq[j];
#pragma unroll
        for (int e = 0; e < 4; ++e) xn[j][e] = xv[e] + gt[e] * (o[j][e] * r * gp[e]);
        if (p >= CTXL) *(f32x4*)(xo_lat + col) = xn[j];
    }
    if (l == 0) {
        const float* mod1 = (const float*)(c.ws + OFF_MOD) + (size_t)(1 * 9 + v) * 3072;
        modulate_row(xn, c.g_pre + 1024, mod1, (bf16_t*)(c.ws + OFF_H) + (size_t)tok * LDH, c.lane);
    }
}

DI void pz_item(const Ctx& c, int l, int rt2, int ct) {
    f32x16 acc[2][4];
    zero_acc2(acc);
    gemm_core2(c, (const bf16_t*)(c.ws + OFF_WIN) + ((size_t)l * INC + (size_t)ct * 128) * LDW, LDW,
               (const bf16_t*)(c.ws + OFF_H) + (size_t)rt2 * 256 * LDH, LDH, 1024, acc);
    const int wn = c.w >> 1, wm = c.w & 1;
    const int bl = rt2 / 9, pt2 = rt2 % 9;
    const int kind = ct >> 2, h = ct & 3;
    const bool roped = (kind == 0 || kind == 4 || kind == 2 || kind == 6);
    const bool retk = (kind == 0 || kind == 4);
    bf16_t* E = (bf16_t*)c.smem;
    constexpr int ES = 136, ETS = 264;
    const float rsc = kind == 0 ? 0.08838834764831845f : (kind == 6 ? 0.125f * LOG2E : 1.f);
    const bool latent = pt2 > 0;
    const bool mulx = (kind == 5 || kind == 7 || kind == 10);
#define XF_PLAIN  { v0 *= rsc; v1 *= rsc; v2 *= rsc; v3 *= rsc; }
#define XF_SIG    { v0 = fsig(v0); v1 = fsig(v1); v2 = fsig(v2); v3 = fsig(v3); }
#define XF_SILU   { v0 *= fsig(v0); v1 *= fsig(v1); v2 *= fsig(v2); v3 *= fsig(v3); }
#define PZ_STAGE(PASS, XF) \
    _Pragma("unroll") for (int j = 0; j < 4; ++j) { \
        const int m = wm * 128 + j * 32 + c.l31; \
        _Pragma("unroll") for (int i = 0; i < 2; ++i) \
        _Pragma("unroll") for (int q = 0; q < 4; ++q) { \
            const int n0 = wn * 64 + i * 32 + 8 * q + 4 * c.hl; \
            float v0 = acc[i][j][4 * q + 0], v1 = acc[i][j][4 * q + 1], v2 = acc[i][j][4 * q + 2], v3 = acc[i][j][4 * q + 3]; \
            XF \
            if (PASS == 0) { \
                u32x2 o; o[0] = pk2(v0, v1); o[1] = pk2(v2, v3); \
                *(u32x2*)(E + m * ES + n0) = o; \
            } else { \
                E[(n0 + 0) * ETS + m] = f2bf(v0); E[(n0 + 1) * ETS + m] = f2bf(v1); E[(n0 + 2) * ETS + m] = f2bf(v2); E[(n0 + 3) * ETS + m] = f2bf(v3); \
            } \
        } \
    }
    const int cls = roped ? (latent ? 0 : 1) : (kind >= 11 ? 2 : (mulx ? 3 : 1));
    const int nfq = retk ? 32 : 16;
    const float fsc = retk ? (13.287712379549449f / 32.f) : (13.287712379549449f / 16.f);
    if (cls == 0) {
        const int lbase = pt2 * 256 + wm * 128 - CTXL;
        const float rowA = (float)(lbase >> 6), colA = (float)c.l31;
#pragma unroll
        for (int i = 0; i < 2; ++i) {
            const bool rowpart = retk ? (wn == 0) : (i == 0);
            const float posA = rowpart ? rowA : colA;
            const float posB = rowpart ? rowA + 1.f : colA + 32.f;
#pragma unroll
            for (int q = 0; q < 4; ++q) {
                const int n0 = wn * 64 + i * 32 + 8 * q + 4 * c.hl;
                const int c0 = retk ? (n0 >> 1) : ((n0 & 63) >> 1);
                const float iv0 = __builtin_amdgcn_exp2f(-(float)(c0 & (nfq - 1)) * fsc) * 0.15915494309189535f;
                const float iv1 = __builtin_amdgcn_exp2f(-(float)((c0 + 1) & (nfq - 1)) * fsc) * 0.15915494309189535f;
#define ROPE_APPLY(POS, JA, JB) { float s0, c0f, s1, c1f; sincos_rev((POS) * iv0, s0, c0f); sincos_rev((POS) * iv1, s1, c1f); \
                    { const float v0 = acc[i][JA][4 * q + 0], v1 = acc[i][JA][4 * q + 1], v2 = acc[i][JA][4 * q + 2], v3 = acc[i][JA][4 * q + 3]; \
                      acc[i][JA][4 * q + 0] = v0 * c0f - v1 * s0; acc[i][JA][4 * q + 1] = v0 * s0 + v1 * c0f; acc[i][JA][4 * q + 2] = v2 * c1f - v3 * s1; acc[i][JA][4 * q + 3] = v2 * s1 + v3 * c1f; } \
                    { const float v0 = acc[i][JB][4 * q + 0], v1 = acc[i][JB][4 * q + 1], v2 = acc[i][JB][4 * q + 2], v3 = acc[i][JB][4 * q + 3]; \
                      acc[i][JB][4 * q + 0] = v0 * c0f - v1 * s0; acc[i][JB][4 * q + 1] = v0 * s0 + v1 * c0f; acc[i][JB][4 * q + 2] = v2 * c1f - v3 * s1; acc[i][JB][4 * q + 3] = v2 * s1 + v3 * c1f; } }
                if (rowpart) { ROPE_APPLY(posA, 0, 1) ROPE_APPLY(posB, 2, 3) }
                else { ROPE_APPLY(posA, 0, 2) ROPE_APPLY(posB, 1, 3) }
#undef ROPE_APPLY
            }
        }
    }
    if (kind != 1 && kind != 3) {
        if (cls <= 1) { PZ_STAGE(0, XF_PLAIN) }
        else if (cls == 2) { PZ_STAGE(0, XF_SIG) }
        else { PZ_STAGE(0, XF_SILU) }
        __syncthreads();
        bf16_t* dst; size_t ld;
        if (kind >= 11) { dst = (bf16_t*)(c.ws + OFF_MLOG) + (size_t)(ct - 44) * 128; ld = 3072; }
        else {
            size_t off;
            switch (kind) { case 0: off = OFF_RK; break; case 2: off = OFF_DK; break; case 4: off = OFF_RQ; break; case 5: off = OFF_RG; break;
                            case 6: off = OFF_DQ; break; case 7: off = OFF_DG; break; case 8: off = OFF_MU; break; case 9: off = OFF_MV; break; default: off = OFF_MG; break; }
            dst = (bf16_t*)(c.ws + off) + h * 128; ld = 512;
        }
        dst += (size_t)rt2 * 256 * ld;
#pragma unroll 4
        for (int it = 0; it < 16; ++it) {
            const int id = c.tid + 256 * it, row = id >> 4, seg = id & 15;
            *(u32x4*)(dst + (size_t)row * ld + seg * 8) = *(const u32x4*)(E + row * ES + seg * 8);
        }
    }
    if (kind == 0 || kind == 1 || kind == 3) {
        if (kind == 0) __syncthreads();
        PZ_STAGE(1, XF_PLAIN)
        __syncthreads();
        const size_t off = kind == 0 ? OFF_RKT : (kind == 1 ? OFF_RVT : OFF_DVT);
        bf16_t* dst = (bf16_t*)(c.ws + off) + (size_t)(bl * 4 + h) * 128 * PP + pt2 * 256;
#pragma unroll 4
        for (int it = 0; it < 16; ++it) {
            const int id = c.tid + 256 * it, n = id >> 5, seg = id & 31;
            *(u32x4*)(dst + (size_t)n * PP + seg * 8) = *(const u32x4*)(E + n * ETS + seg * 8);
        }
    }
    __builtin_amdgcn_s_setprio(0);
#undef PZ_STAGE
#undef XF_PLAIN
#undef XF_SIG
#undef XF_SILU
}

DI void attn_item(const Ctx& c, int l, int bl, int h, int q0, int nk) {
    bf16_t* Ks = (bf16_t*)c.smem;
    bf16_t* Vs = Ks + 64 * 136;
    const int mp = c.w >> 1, qs = c.w & 1;
    const int qpos = q0 + qs * 32 + c.l31;
    const size_t qtok = (size_t)bl * PP + qpos;
    const bf16_t* DQ = (const bf16_t*)(c.ws + OFF_DQ);
    const bf16_t* DK = (const bf16_t*)(c.ws + OFF_DK) + (size_t)bl * PP * 512 + h * 128;
    const bf16_t* DVT = (const bf16_t*)(c.ws + OFF_DVT) + (size_t)(bl * 4 + h) * 128 * PP;
    bf16x8 qf[4];
#pragma unroll
    for (int ks = 0; ks < 4; ++ks) qf[ks] = *(const bf16x8*)(DQ + qtok * 512 + h * 128 + mp * 64 + ks * 16 + c.hl * 8);
    f32x16 o[4];
#pragma unroll
    for (int et = 0; et < 4; ++et)
#pragma unroll
        for (int r = 0; r < 16; ++r) o[et][r] = 0.f;
    float mrun = -1e30f, lrun = 0.f;
    u32x4 rk[4], rv[4];
    constexpr int BUF = 64 * 136 + 128 * 68;
#define AT_LOAD(KT0) { _Pragma("unroll") for (int it = 0; it < 4; ++it) { const int idx = c.tid + 256 * it; \
        rk[it] = *(const u32x4*)(DK + (size_t)((KT0) + (idx >> 4)) * 512 + (idx & 15) * 8); \
        rv[it] = *(const u32x4*)(DVT + (size_t)(idx >> 3) * PP + (KT0) + (idx & 7) * 8); } }
#define AT_STORE(BP) { _Pragma("unroll") for (int it = 0; it < 4; ++it) { const int idx = c.tid + 256 * it; \
        *(u32x4*)((BP) + (idx >> 4) * 136 + (idx & 15) * 8) = rk[it]; \
        u32x2 lo2, hi2; lo2[0] = rv[it][0]; lo2[1] = rv[it][1]; hi2[0] = rv[it][2]; hi2[1] = rv[it][3]; \
        *(u32x2*)((BP) + 64 * 136 + (idx >> 3) * 68 + (idx & 7) * 8) = lo2; *(u32x2*)((BP) + 64 * 136 + (idx >> 3) * 68 + (idx & 7) * 8 + 4) = hi2; } }
    AT_LOAD(0)
    __syncthreads();
    AT_STORE(Ks)
    if (64 < nk) AT_LOAD(64)
    __syncthreads();
    for (int kt0 = 0; kt0 < nk; kt0 += 64) {
        const int cb = (kt0 >> 6) & 1;
        const bf16_t* Kc = Ks + cb * BUF;
        const bf16_t* Vc = Kc + 64 * 136;
        if (kt0 + 64 < nk) {
            AT_STORE(Ks + (cb ^ 1) * BUF)
            if (kt0 + 128 < nk) AT_LOAD(kt0 + 128)
        }
        f32x16 s[2];
#pragma unroll
        for (int kt = 0; kt < 2; ++kt) {
#pragma unroll
            for (int r = 0; r < 16; ++r) s[kt][r] = 0.f;
#pragma unroll
            for (int ks = 0; ks < 4; ++ks) {
                const bf16x8 a = *(const bf16x8*)(Kc + (kt * 32 + c.l31) * 136 + mp * 64 + ks * 16 + c.hl * 8);
                s[kt] = MFMA(a, qf[ks], s[kt]);
            }
        }
        float mx = s[0][0];
#pragma unroll
        for (int r = 0; r < 16; ++r) { mx = fmaxf(mx, s[0][r]); mx = fmaxf(mx, s[1][r]); }
        mx = fmaxf(mx, __shfl_xor(mx, 32));
        const float mold = mrun;
        const float mnew = fmaxf(mrun, mx);
        const float alpha = __builtin_amdgcn_exp2f(mrun - mnew);
        mrun = mnew;
        float lsum = 0.f;
#pragma unroll
        for (int kt = 0; kt < 2; ++kt)
#pragma unroll
            for (int r = 0; r < 16; ++r) { const float pv = __builtin_amdgcn_exp2f(s[kt][r] - mnew); s[kt][r] = pv; lsum += pv; }
        lrun = lrun * alpha + lsum;
        if (__any(mx > mold)) {
#pragma unroll
            for (int et = 0; et < 4; ++et)
#pragma unroll
                for (int r = 0; r < 16; ++r) o[et][r] *= alpha;
        }
#pragma unroll
        for (int kt = 0; kt < 2; ++kt) {
#pragma unroll
            for (int st = 0; st < 2; ++st) {
                u32x4 pp;
                pp[0] = pk2(s[kt][8 * st + 0], s[kt][8 * st + 1]); pp[1] = pk2(s[kt][8 * st + 2], s[kt][8 * st + 3]);
                pp[2] = pk2(s[kt][8 * st + 4], s[kt][8 * st + 5]); pp[3] = pk2(s[kt][8 * st + 6], s[kt][8 * st + 7]);
                const bf16x8 pf = __builtin_bit_cast(bf16x8, pp);
#pragma unroll
                for (int et = 0; et < 4; ++et) {
                    const bf16_t* vp = Vc + (et * 32 + c.l31) * 68 + kt * 32 + 16 * st + 4 * c.hl;
                    const u32x2 lo = *(const u32x2*)vp, hi = *(const u32x2*)(vp + 8);
                    u32x4 av; av[0] = lo[0]; av[1] = lo[1]; av[2] = hi[0]; av[3] = hi[1];
                    o[et] = MFMA(__builtin_bit_cast(bf16x8, av), pf, o[et]);
                }
            }
        }
        __syncthreads();
    }
#undef AT_LOAD
#undef AT_STORE
    const float ltot = lrun + __shfl_xor(lrun, 32);
    const float linv = 1.f / ltot;
    float* Oc = (float*)c.smem;
    if (mp == 1) {
#pragma unroll
        for (int et = 0; et < 4; ++et)
#pragma unroll
            for (int r = 0; r < 16; ++r) Oc[(qs * 128 + et * 32 + crow(r, c.hl)) * 32 + c.l31] = o[et][r] * linv;
    }
    __syncthreads();
    if (mp == 0) {
        const float lam = c.cst[l], lam_init = c.cst[2 + l];
        float ss = 0.f;
#pragma unroll
        for (int et = 0; et < 4; ++et)
#pragma unroll
            for (int r = 0; r < 16; ++r) {
                const float d = o[et][r] * linv - lam * Oc[(qs * 128 + et * 32 + crow(r, c.hl)) * 32 + c.l31];
                o[et][r] = d; ss += d * d;
            }
        ss += __shfl_xor(ss, 32);
        const float rn = rsqrtf(ss * (1.f / 128.f) + EPS) * (1.f - lam_init);
        const bf16_t* DG = (const bf16_t*)(c.ws + OFF_DG) + qtok * 512 + h * 128;
        bf16_t* OD = (bf16_t*)(c.ws + OFF_ODIFF) + qtok * 512 + h * 128;
#pragma unroll
        for (int et = 0; et < 4; ++et)
#pragma unroll
            for (int q = 0; q < 4; ++q) {
                const int e0 = et * 32 + 8 * q + 4 * c.hl;
                const u32x2 g = *(const u32x2*)(DG + e0);
                u32x2 ov;
                ov[0] = pk2(o[et][4 * q + 0] * rn * bflo(g[0]), o[et][4 * q + 1] * rn * bfhi(g[0]));
                ov[1] = pk2(o[et][4 * q + 2] * rn * bflo(g[1]), o[et][4 * q + 3] * rn * bfhi(g[1]));
                *(u32x2*)(OD + e0) = ov;
            }
    }
}

DI void scan_item(const Ctx& c, int l, int bl, int h, int dir, int es) {
    const float lg2 = c.cst[4 + l * 8 + dir * 4 + h];
    const float decayC = __builtin_amdgcn_exp2f(lg2 * 128.f);
    f32x16 st;
#pragma unroll
    for (int r = 0; r < 16; ++r) st[r] = 0.f;
    const bf16_t* vt = (const bf16_t*)(c.ws + OFF_RVT) + ((size_t)(bl * 4 + h) * 128 + es * 32 + c.l31) * PP;
    const bf16_t* kt = (const bf16_t*)(c.ws + OFF_RKT) + ((size_t)(bl * 4 + h) * 128 + c.w * 32 + c.l31) * PP;
    bf16_t* stbase = (bf16_t*)(c.ws + OFF_ST) + (size_t)(((bl * 4 + h) * 2 + dir) * NCH) * 16384;
#pragma unroll 1
    for (int step = 0; step < NCH; ++step) {
        const int m = dir == 0 ? step : (step < 2 ? 1 - step : 19 - step);
        bf16_t* sp = stbase + (size_t)m * 16384;
#pragma unroll
        for (int r = 0; r < 16; ++r) sp[(es * 32 + crow(r, c.hl)) * 128 + c.w * 32 + c.l31] = f2bf(st[r]);
        if (step == NCH - 1) break;
#pragma unroll
        for (int r = 0; r < 16; ++r) st[r] *= decayC;
#pragma unroll
        for (int ks = 0; ks < 8; ++ks) {
            const int j0 = ks * 16 + c.hl * 8;
            const u32x4 av = *(const u32x4*)(vt + m * 128 + j0);
            const u32x4 bv = *(const u32x4*)(kt + m * 128 + j0);
            u32x4 as;
#pragma unroll
            for (int e = 0; e < 4; ++e) {
                const int ja = j0 + 2 * e;
                const float e0 = dir == 0 ? (float)(127 - ja) : (float)ja;
                const float e1 = dir == 0 ? (float)(126 - ja) : (float)(ja + 1);
                const float w0 = __builtin_amdgcn_exp2f(lg2 * e0), w1 = __builtin_amdgcn_exp2f(lg2 * e1);
                as[e] = pk2(bflo(av[e]) * w0, bfhi(av[e]) * w1);
            }
            st = MFMA(__builtin_bit_cast(bf16x8, as), __builtin_bit_cast(bf16x8, bv), st);
        }
    }
}

DI void mlp_item(const Ctx& c, int l, int bl, int m, int g) {
    bf16_t* Vn = (bf16_t*)c.smem;
    bf16_t* Wsm = Vn + 128 * 136;
    float* stat = (float*)(Wsm + 128 * 136);
    const size_t tok0 = (size_t)bl * PP + m * 128;
    const bf16_t* MV = (const bf16_t*)(c.ws + OFF_MV);
    __syncthreads();
#pragma unroll 1
    for (int rb = 0; rb < 4; ++rb) {
        u32x4 vv[8];
#pragma unroll
        for (int r8 = 0; r8 < 8; ++r8) vv[r8] = *(const u32x4*)(MV + (tok0 + c.w * 32 + rb * 8 + r8) * 512 + c.lane * 8);
#pragma unroll
        for (int r8 = 0; r8 < 8; ++r8) {
            const int row = c.w * 32 + rb * 8 + r8;
            float xv[8];
#pragma unroll
            for (int e = 0; e < 4; ++e) { xv[2 * e] = bflo(vv[r8][e]); xv[2 * e + 1] = bfhi(vv[r8][e]); }
            float sm = 0.f;
#pragma unroll
            for (int e = 0; e < 8; ++e) sm += xv[e];
            sm = wave_sum(sm);
            const float mu = sm * (1.f / 512.f);
            float ss = 0.f;
#pragma unroll
            for (int e = 0; e < 8; ++e) { const float d = xv[e] - mu; ss += d * d; }
            ss = wave_sum(ss);
            if (c.lane == 0) { stat[row] = mu; stat[128 + row] = rsqrtf(ss * (1.f / 512.f) + EPS); }
        }
    }
    __syncthreads();
    {
        u32x4 tv[8];
#pragma unroll
        for (int it = 0; it < 8; ++it) { const int idx = c.tid + 256 * it; tv[it] = *(const u32x4*)(MV + (tok0 + (idx >> 4)) * 512 + g * 128 + (idx & 15) * 8); }
#pragma unroll
        for (int it = 0; it < 8; ++it) {
            const int idx = c.tid + 256 * it, j = idx >> 4, seg = idx & 15;
            const float mu = stat[j], rs = stat[128 + j];
#pragma unroll
            for (int e = 0; e < 4; ++e) {
                Vn[(seg * 8 + 2 * e) * 136 + j] = f2bf((bflo(tv[it][e]) - mu) * rs);
                Vn[(seg * 8 + 2 * e + 1) * 136 + j] = f2bf((bfhi(tv[it][e]) - mu) * rs);
            }
        }
    }
    {
        const float* wsrc = c.w_s + (size_t)(l * 4 + g) * 128 * 128;
#pragma unroll 1
        for (int hb = 0; hb < 2; ++hb) {
            f32x4 wv[8];
#pragma unroll
            for (int it = 0; it < 8; ++it) { const int idx = c.tid + 256 * (hb * 8 + it); wv[it] = *(const f32x4*)(wsrc + (idx >> 5) * 128 + (idx & 31) * 4); }
#pragma unroll
            for (int it = 0; it < 8; ++it) {
                const int idx = c.tid + 256 * (hb * 8 + it);
                u32x2 o; o[0] = pk2(wv[it][0], wv[it][1]); o[1] = pk2(wv[it][2], wv[it][3]);
                *(u32x2*)(Wsm + (idx >> 5) * 136 + (idx & 31) * 4) = o;
            }
        }
    }
    __syncthreads();
    const int wc = c.w >> 1, wi = c.w & 1;
    f32x16 acc[2][2];
    zero_acc(acc);
#pragma unroll
    for (int ks = 0; ks < 8; ++ks) {
        const bf16x8 a0 = *(const bf16x8*)(Vn + (wc * 64 + c.l31) * 136 + ks * 16 + c.hl * 8);
        const bf16x8 a1 = *(const bf16x8*)(Vn + (wc * 64 + 32 + c.l31) * 136 + ks * 16 + c.hl * 8);
        const bf16x8 b0 = *(const bf16x8*)(Wsm + (wi * 64 + c.l31) * 136 + ks * 16 + c.hl * 8);
        const bf16x8 b1 = *(const bf16x8*)(Wsm + (wi * 64 + 32 + c.l31) * 136 + ks * 16 + c.hl * 8);
        acc[0][0] = MFMA(a0, b0, acc[0][0]); acc[0][1] = MFMA(a0, b1, acc[0][1]);
        acc[1][0] = MFMA(a1, b0, acc[1][0]); acc[1][1] = MFMA(a1, b1, acc[1][1]);
    }
    const bf16_t* MU = (const bf16_t*)(c.ws + OFF_MU);
    const bf16_t* MG = (const bf16_t*)(c.ws + OFF_MG);
    bf16_t* OM = (bf16_t*)(c.ws + OFF_OMLP);
    u32x2 uq[2][2][4], gq[2][2][4];
    float bsq[2];
#pragma unroll
    for (int ii = 0; ii < 2; ++ii) {
        const int i = wi * 64 + ii * 32 + c.l31;
        const size_t tok = tok0 + i;
        bsq[ii] = c.b_s[(l * 4 + g) * 128 + i];
#pragma unroll
        for (int ci = 0; ci < 2; ++ci)
#pragma unroll
            for (int q = 0; q < 4; ++q) {
                const int c0 = g * 128 + wc * 64 + ci * 32 + 8 * q + 4 * c.hl;
                uq[ii][ci][q] = *(const u32x2*)(MU + tok * 512 + c0); gq[ii][ci][q] = *(const u32x2*)(MG + tok * 512 + c0);
            }
    }
#pragma unroll
    for (int ii = 0; ii < 2; ++ii) {
        const int i = wi * 64 + ii * 32 + c.l31;
        const size_t tok = tok0 + i;
        const float bs = bsq[ii];
#pragma unroll
        for (int ci = 0; ci < 2; ++ci)
#pragma unroll
            for (int q = 0; q < 4; ++q) {
                const int c0 = g * 128 + wc * 64 + ci * 32 + 8 * q + 4 * c.hl;
                const u32x2 u = uq[ii][ci][q], gg = gq[ii][ci][q];
                u32x2 ov;
                ov[0] = pk2(bflo(u[0]) * (acc[ci][ii][4 * q + 0] + bs) * bflo(gg[0]), bfhi(u[0]) * (acc[ci][ii][4 * q + 1] + bs) * bfhi(gg[0]));
                ov[1] = pk2(bflo(u[1]) * (acc[ci][ii][4 * q + 2] + bs) * bflo(gg[1]), bfhi(u[1]) * (acc[ci][ii][4 * q + 3] + bs) * bfhi(gg[1]));
                *(u32x2*)(OM + tok * 512 + c0) = ov;
            }
    }
}

DI void retout_item(const Ctx& c, int l, int bl, int h, int m) {
    bf16_t* Ks = (bf16_t*)c.smem;
    bf16_t* Vs = Ks + 128 * 136;
    const size_t tok0 = (size_t)bl * PP + m * 128;
    const bf16_t* RK = (const bf16_t*)(c.ws + OFF_RK) + tok0 * 512 + h * 128;
    const bf16_t* RVT = (const bf16_t*)(c.ws + OFF_RVT) + (size_t)(bl * 4 + h) * 128 * PP + m * 128;
    __syncthreads();
    {
        u32x4 tk[8], tv[8];
#pragma unroll
        for (int it = 0; it < 8; ++it) {
            const int idx = c.tid + 256 * it, row = idx >> 4, seg = idx & 15;
            tk[it] = *(const u32x4*)(RK + (size_t)row * 512 + seg * 8);
            tv[it] = *(const u32x4*)(RVT + (size_t)row * PP + seg * 8);
        }
#pragma unroll
        for (int it = 0; it < 8; ++it) {
            const int idx = c.tid + 256 * it, row = idx >> 4, seg = idx & 15;
            *(u32x4*)(Ks + row * 136 + seg * 8) = tk[it];
            u32x2 lo2, hi2; lo2[0] = tv[it][0]; lo2[1] = tv[it][1]; hi2[0] = tv[it][2]; hi2[1] = tv[it][3];
            *(u32x2*)(Vs + row * 132 + seg * 8) = lo2; *(u32x2*)(Vs + row * 132 + seg * 8 + 4) = hi2;
        }
    }
    __syncthreads();
    const int i = c.w * 32 + c.l31;
    const size_t tok = tok0 + i;
    const float lgf = c.cst[4 + l * 8 + h], lgb = c.cst[4 + l * 8 + 4 + h];
    bf16x8 qf[8];
    const bf16_t* RQ = (const bf16_t*)(c.ws + OFF_RQ) + tok * 512 + h * 128;
#pragma unroll
    for (int ks = 0; ks < 8; ++ks) qf[ks] = *(const bf16x8*)(RQ + ks * 16 + c.hl * 8);
    f32x16 o[4];
    const bf16_t* stf = (const bf16_t*)(c.ws + OFF_ST) + (size_t)(((bl * 4 + h) * 2 + 0) * NCH + m) * 16384;
    const bf16_t* stb = (const bf16_t*)(c.ws + OFF_ST) + (size_t)(((bl * 4 + h) * 2 + 1) * NCH + m) * 16384;
    const float qdf = __builtin_amdgcn_exp2f(lgf * (float)(i + 1)), qdb = __builtin_amdgcn_exp2f(lgb * (float)(128 - i));
#pragma unroll
    for (int et = 0; et < 4; ++et) {
        f32x16 tf, tb;
#pragma unroll
        for (int r = 0; r < 16; ++r) { tf[r] = 0.f; tb[r] = 0.f; }
        bf16x8 sa[8], sb[8];
#pragma unroll
        for (int ks = 0; ks < 8; ++ks) {
            sa[ks] = *(const bf16x8*)(stf + (et * 32 + c.l31) * 128 + ks * 16 + c.hl * 8);
            sb[ks] = *(const bf16x8*)(stb + (et * 32 + c.l31) * 128 + ks * 16 + c.hl * 8);
        }
#pragma unroll
        for (int ks = 0; ks < 8; ++ks) {
            tf = MFMA(sa[ks], qf[ks], tf);
            tb = MFMA(sb[ks], qf[ks], tb);
        }
#pragma unroll
        for (int r = 0; r < 16; ++r) o[et][r] = tf[r] * qdf + tb[r] * qdb;
        __builtin_amdgcn_sched_barrier(0);
    }
#pragma unroll
    for (int jt = 0; jt < 4; ++jt) {
        f32x16 sc;
#pragma unroll
        for (int r = 0; r < 16; ++r) sc[r] = 0.f;
#pragma unroll
        for (int ks = 0; ks < 8; ++ks) {
            const bf16x8 a = *(const bf16x8*)(Ks + (jt * 32 + c.l31) * 136 + ks * 16 + c.hl * 8);
            sc = MFMA(a, qf[ks], sc);
        }
#pragma unroll
        for (int r = 0; r < 16; ++r) {
            const int j = jt * 32 + crow(r, c.hl);
            const int dl = i - j;
            const float arg = dl > 0 ? lgf * (float)dl : -lgb * (float)dl;
            float f = __builtin_amdgcn_exp2f(arg);
            f = dl == 0 ? 2.f : f;
            sc[r] *= f;
        }
#pragma unroll
        for (int s2 = 0; s2 < 2; ++s2) {
            u32x4 pp;
            pp[0] = pk2(sc[8 * s2 + 0], sc[8 * s2 + 1]); pp[1] = pk2(sc[8 * s2 + 2], sc[8 * s2 + 3]);
            pp[2] = pk2(sc[8 * s2 + 4], sc[8 * s2 + 5]); pp[3] = pk2(sc[8 * s2 + 6], sc[8 * s2 + 7]);
            const bf16x8 pf = __builtin_bit_cast(bf16x8, pp);
#pragma unroll
            for (int et = 0; et < 4; ++et) {
                const bf16_t* vp = Vs + (et * 32 + c.l31) * 132 + jt * 32 + 16 * s2 + 4 * c.hl;
                const u32x2 lo = *(const u32x2*)vp, hi = *(const u32x2*)(vp + 8);
                u32x4 av; av[0] = lo[0]; av[1] = lo[1]; av[2] = hi[0]; av[3] = hi[1];
                o[et] = MFMA(__builtin_bit_cast(bf16x8, av), pf, o[et]);
            }
        }
        __builtin_amdgcn_sched_barrier(0);
    }
    float ss = 0.f;
#pragma unroll
    for (int et = 0; et < 4; ++et)
#pragma unroll
        for (int r = 0; r < 16; ++r) ss += o[et][r] * o[et][r];
    ss += __shfl_xor(ss, 32);
    const float rn = rsqrtf(ss * (1.f / 128.f) + EPS);
    const bf16_t* RG = (const bf16_t*)(c.ws + OFF_RG) + tok * 512 + h * 128;
    bf16_t* OR = (bf16_t*)(c.ws + OFF_ORET) + tok * 512 + h * 128;
#pragma unroll
    for (int et = 0; et < 4; ++et)
#pragma unroll
        for (int q = 0; q < 4; ++q) {
            const int e0 = et * 32 + 8 * q + 4 * c.hl;
            const u32x2 g = *(const u32x2*)(RG + e0);
            u32x2 ov;
            ov[0] = pk2(o[et][4 * q + 0] * rn * bflo(g[0]), o[et][4 * q + 1] * rn * bfhi(g[0]));
            ov[1] = pk2(o[et][4 * q + 2] * rn * bflo(g[1]), o[et][4 * q + 3] * rn * bfhi(g[1]));
            *(u32x2*)(OR + e0) = ov;
        }
}

DI void pm_item(const Ctx& c, int l, int rt, int nt) {
    f32x16 y[2][2], acc[2][2];
    zero_acc(y);
    const int wn = c.w >> 1, wm = c.w & 1;
    const bf16_t* MLOG = (const bf16_t*)(c.ws + OFF_MLOG);
#pragma unroll 1
    for (int br = 0; br < 3; ++br) {
        const size_t ooff = br == 0 ? OFF_ORET : (br == 1 ? OFF_OMLP : OFF_ODIFF);
        zero_acc(acc);
        gemm_core(c, (const bf16_t*)(c.ws + OFF_WBO) + ((size_t)(l * 3 + br) * 1024 + (size_t)nt * 128) * 512, 512,
                  (const bf16_t*)(c.ws + ooff) + (size_t)rt * 128 * 512, 512, 512, acc);
#pragma unroll
        for (int j = 0; j < 2; ++j) {
            const size_t tok = (size_t)rt * 128 + wm * 64 + j * 32 + c.l31;
#pragma unroll
            for (int i = 0; i < 2; ++i)
#pragma unroll
                for (int q = 0; q < 4; ++q) {
                    const int n0 = nt * 128 + wn * 64 + i * 32 + 8 * q + 4 * c.hl;
                    const u32x2 g = *(const u32x2*)(MLOG + tok * 3072 + br * 1024 + n0);
                    y[i][j][4 * q + 0] += bflo(g[0]) * acc[i][j][4 * q + 0];
                    y[i][j][4 * q + 1] += bfhi(g[0]) * acc[i][j][4 * q + 1];
                    y[i][j][4 * q + 2] += bflo(g[1]) * acc[i][j][4 * q + 2];
                    y[i][j][4 * q + 3] += bfhi(g[1]) * acc[i][j][4 * q + 3];
                }
        }
    }
    bf16_t* Y = (bf16_t*)(c.ws + OFF_Y);
#pragma unroll
    for (int j = 0; j < 2; ++j) {
        const size_t tok = (size_t)rt * 128 + wm * 64 + j * 32 + c.l31;
#pragma unroll
        for (int i = 0; i < 2; ++i)
#pragma unroll
            for (int q = 0; q < 4; ++q) {
                const int n0 = nt * 128 + wn * 64 + i * 32 + 8 * q + 4 * c.hl;
                u32x2 ov; ov[0] = pk2(y[i][j][4 * q + 0], y[i][j][4 * q + 1]); ov[1] = pk2(y[i][j][4 * q + 2], y[i][j][4 * q + 3]);
                *(u32x2*)(Y + tok * 1024 + n0) = ov;
            }
    }
}
DI void po_item(const Ctx& c, int l, int rt2, int nt) {
    f32x16 acc[2][4];
    zero_acc2(acc);
    gemm_core2(c, (const bf16_t*)(c.ws + OFF_WO) + ((size_t)l * 1024 + (size_t)nt * 128) * 1024, 1024,
               (const bf16_t*)(c.ws + OFF_Y) + (size_t)rt2 * 256 * 1024, 1024, 1024, acc);
    const int wn = c.w >> 1, wm = c.w & 1;
    float* OUT = (float*)(c.ws + OFF_OUT);
#pragma unroll
    for (int j = 0; j < 4; ++j) {
        const size_t tok = (size_t)rt2 * 256 + wm * 128 + j * 32 + c.l31;
#pragma unroll
        for (int i = 0; i < 2; ++i)
#pragma unroll
            for (int q = 0; q < 4; ++q) {
                const int n0 = nt * 128 + wn * 64 + i * 32 + 8 * q + 4 * c.hl;
                f32x4 ov; ov[0] = acc[i][j][4 * q + 0]; ov[1] = acc[i][j][4 * q + 1]; ov[2] = acc[i][j][4 * q + 2]; ov[3] = acc[i][j][4 * q + 3];
                *(f32x4*)(OUT + tok * 1024 + n0) = ov;
            }
    }
}

extern __shared__ __attribute__((aligned(16))) unsigned char dynsmem[];
constexpr int LDS_BYTES = 72 * 1024;

DI Ctx mk_ctx(const Params& p, const float* cst, int wv) {
    Ctx c;
    c.x = p.in[0]; c.c = p.in[1]; c.ctx = p.in[2]; c.c_ctx = p.in[3]; c.w_mod = p.in[4]; c.b_mod = p.in[5]; c.g_pre = p.in[6]; c.g_post = p.in[7];
    c.w_in = p.in[8]; c.decay = p.in[9]; c.w_s = p.in[10]; c.b_s = p.in[11]; c.lq = p.in[12]; c.lk = p.in[13]; c.w_bo = p.in[14]; c.w_out = p.in[15];
    c.out = p.out; c.ws = p.ws; c.smem = dynsmem; c.cst = cst;
    unsigned zl = 0u;
    asm volatile("" : "+v"(zl));
    int tid = wv * 64 + (int)__builtin_amdgcn_mbcnt_hi(~0u, __builtin_amdgcn_mbcnt_lo(~0u, zl));
    asm volatile("" : "+v"(tid));
    size_t zoff = 0;
    asm volatile("" : "+s"(zoff));
    c.ws = p.ws + zoff;
    c.tid = tid; c.lane = tid & 63; c.w = tid >> 6; c.l31 = c.lane & 31; c.hl = c.lane >> 5;
    return c;
}
DI void relaunder(Ctx& c) {
    int t = c.tid;
    asm volatile("" : "+v"(t));
    c.tid = t; c.lane = t & 63; c.w = t >> 6; c.l31 = c.lane & 31; c.hl = c.lane >> 5;
}

__global__ void __launch_bounds__(256, 2) mega(Params p) {
    __shared__ uint4 xbw;
    __shared__ float cst[32];
    const int wv = __builtin_amdgcn_readfirstlane((int)threadIdx.x >> 6);
    Ctx c = mk_ctx(p, cst, wv);
    if (c.tid == 0) xbw = make_uint4(0u, 0u, 0u, 0u);
    if (c.tid < 64) {
        for (int l = 0; l < 2; ++l) {
            float a = c.lq[(l * 2 + 0) * 64 + c.tid] * c.lk[(l * 2 + 0) * 64 + c.tid];
            float b = c.lq[(l * 2 + 1) * 64 + c.tid] * c.lk[(l * 2 + 1) * 64 + c.tid];
            a = wave_sum(a); b = wave_sum(b);
            const float lam_init = 0.8f - 0.6f * expf(-0.3f * (float)l);
            if (c.tid == 0) { cst[l] = expf(a) - expf(b) + lam_init; cst[2 + l] = lam_init; }
        }
        if (c.tid < 16) {
            const float z = c.decay[c.tid];
            cst[4 + c.tid] = -log1pf(expf(-z)) * LOG2E;
        }
    }
    __syncthreads();
    XcdBarrier bar = xcd_barrier_post((unsigned*)(p.ws + OFF_BAR), (volatile LAS unsigned*)&xbw, c.tid == 0);
    const int G = gridDim.x, bid = blockIdx.x;
    constexpr int NPH = 2 + NGRP * 12;
#pragma unroll 1
    for (int ph = 0; ph < NPH; ++ph) {
        c = mk_ctx(p, cst, wv);
        int kind, g = 0, l = 0;
        if (ph == 0) kind = 0;
        else if (ph == 1) kind = 1;
        else { const int q = ph - 2; g = q / 12; const int r = q % 12; l = r / 6; kind = 2 + r % 6; }
#ifndef ECHO_KIND
#define ECHO_KIND -1
#endif
        const unsigned long long tph0 = (ECHO_KIND >= 0) ? __builtin_amdgcn_s_memrealtime() : 0ull;
        switch (kind) {
        case 0:
#pragma unroll 1
            for (int it = bid; it < 2 * 1408 + 192; it += G) { relaunder(c); p0_item(c, it); }
            break;
        case 1:
#pragma unroll 1
            for (int it = bid; it < NT / 4; it += G) { relaunder(c); ph_item(c, g, it); }
            break;
        case 2:
            if ((G & 7) == 0) {
                const int x = bid & 7, jl = bid >> 3, GL = G >> 3;
#pragma unroll 1
                for (int k = jl; k < 306; k += GL) {
                    int ct, rt2;
                    if (k < 288) { ct = 8 * (k & 7) + x; rt2 = k >> 3; }
                    else { ct = 64 + (x >> 1); rt2 = (x & 1) * 18 + (k - 288); }
                    if (l == 1 && (rt2 % 9) == 0 && ct >= 16) continue;
                    relaunder(c);
                    pz_item(c, l, rt2, ct);
                }
            } else {
#pragma unroll 1
                for (int it = bid; it < 36 * 68; it += G) {
                    const int ct = it % 68, rt2 = it / 68;
                    if (l == 1 && (rt2 % 9) == 0 && ct >= 16) continue;
                    relaunder(c);
                    pz_item(c, l, rt2, ct);
                }
            }
            break;
        case 3: {
            const int n_att = 512, n_catt = (l == 0) ? 64 : 0, n_scan = 128, n_mlp = (l == 0) ? 288 : 256;
            const int total = n_att + n_catt + n_scan + n_mlp;
#pragma unroll 1
            for (int it = bid; it < total; it += G) {
                int r = it;
                relaunder(c);
                if (r < n_att + n_catt) {
                    int bl, h, q0, nk;
                    if (r < n_att) { bl = r >> 7; h = (r >> 5) & 3; q0 = CTXL + (r & 31) * 64; nk = PP; }
                    else { r -= n_att; bl = r >> 4; h = (r >> 2) & 3; q0 = (r & 3) * 64; nk = CTXL; }
                    attn_item(c, l, bl, h, q0, nk);
                    continue;
                }
                r -= n_att + n_catt;
                if (r < n_scan) { const int bl = r >> 5, h = (r >> 3) & 3, dir = (r >> 2) & 1, es = r & 3; scan_item(c, l, bl, h, dir, es); continue; }
                r -= n_scan;
                int bl, m, gg;
                if (l == 0) { bl = r / 72; const int q = r % 72; m = q >> 2; gg = q & 3; }
                else { bl = r >> 6; const int q = r & 63; m = 2 + (q >> 2); gg = q & 3; }
                mlp_item(c, l, bl, m, gg);
            }
            break; }
        case 4: {
            const int total = (l == 0) ? 288 : 256;
#pragma unroll 1
            for (int it = bid; it < total; it += G) {
                int bl, m, h;
                if (l == 0) { bl = it / 72; const int q = it % 72; h = q & 3; m = q >> 2; }
                else { bl = it >> 6; const int q = it & 63; h = q & 3; m = 2 + (q >> 2); }
                relaunder(c);
                retout_item(c, l, bl, h, m);
            }
            break; }
        case 5: {
            const int nrt = (l == 0) ? 72 : 64;
#pragma unroll 1
            for (int it = bid; it < nrt * 8; it += G) {
                const int nt = it & 7, rr = it >> 3;
                const int rt = (l == 0) ? rr : (rr >> 4) * NCH + 2 + (rr & 15);
                relaunder(c);
                pm_item(c, l, rt, nt);
            }
            break; }
        case 6: {
            const int nrt = (l == 0) ? 72 : 64;
#pragma unroll 1
            for (int it = bid; it < (nrt / 2) * 8; it += G) {
                const int nt = it & 7, rr = it >> 3;
                const int rt2 = (l == 0) ? rr : (rr >> 3) * 9 + 1 + (rr & 7);
                relaunder(c);
                po_item(c, l, rt2, nt);
            }
            break; }
        default:
#pragma unroll 1
            for (int it = bid; it < NT / 4; it += G) { relaunder(c); pr_item(c, l, g, it); }
            if (g + 1 < NGRP && l == 1) {
#pragma unroll 1
                for (int it = bid; it < NT / 4; it += G) { relaunder(c); ph_item(c, g + 1, it); }
            }
            break;
        }
        if (ECHO_KIND >= 0 && kind == ECHO_KIND) { __syncthreads(); const unsigned long long tb = __builtin_amdgcn_s_memrealtime(), dt = tb - tph0; while (__builtin_amdgcn_s_memrealtime() - tb < dt) __builtin_amdgcn_s_sleep(8); }
        if (ph + 1 < NPH) xcd_barrier(bar, c.tid == 0);
    }
}

extern "C" void kernel_launch(void* const* d_in, const int* in_sizes, int n_in, void* d_out, int out_size, void* d_ws, size_t ws_size, hipStream_t stream) {
    static int grid = 0;
    if (grid == 0) {
        int dev = 0, cus = 0, per_cu = 0;
        hipGetDevice(&dev);
        hipDeviceGetAttribute(&cus, hipDeviceAttributeMultiprocessorCount, dev);
        hipFuncSetAttribute((const void*)mega, hipFuncAttributeMaxDynamicSharedMemorySize, LDS_BYTES);
        hipOccupancyMaxActiveBlocksPerMultiprocessor(&per_cu, (const void*)mega, 256, LDS_BYTES);
        if (per_cu > 2) per_cu = 2;
        if (per_cu < 1) per_cu = 1;
        grid = cus * per_cu;
        if (ws_size < WS_END) { fprintf(stderr, "workspace too small: %zu < %zu\n", ws_size, (size_t)WS_END); grid = -1; }
    }
    if (grid < 0) return;
    hipMemsetAsync((unsigned char*)d_ws + OFF_BAR, 0, XCD_BAR_WORDS * 4, stream);
    Params p{};
    for (int i = 0; i < 16; ++i) p.in[i] = (const float*)d_in[i];
    p.out = (float*)d_out; p.ws = (unsigned char*)d_ws;
    void* args[] = {&p};
    hipError_t e = hipLaunchCooperativeKernel((const void*)mega, dim3(grid), dim3(256), args, LDS_BYTES, stream);
    if (e != hipSuccess) fprintf(stderr, "cooperative launch failed: %s (grid %d)\n", hipGetErrorString(e), grid);
}
```

```cpp
#include <hip/hip_runtime.h>
#include <cstdio>
#include <cstdint>

#define DI __device__ __forceinline__
#define LAS __attribute__((address_space(3)))
typedef unsigned short bf16_t;
typedef short bf16x8 __attribute__((ext_vector_type(8)));
typedef float f32x16 __attribute__((ext_vector_type(16)));
typedef float f32x4 __attribute__((ext_vector_type(4)));
typedef float f32x2 __attribute__((ext_vector_type(2)));
typedef unsigned u32x4 __attribute__((ext_vector_type(4)));
typedef unsigned u32x2 __attribute__((ext_vector_type(2)));
#define MFMA(a, b, c) __builtin_amdgcn_mfma_f32_32x32x16_bf16((a), (b), (c), 0, 0, 0)

#define XB_TMO      128
#define XB_XCNT(j)  (256  + 64 * (j))
#define XB_XSUB(j)  (1280 + 64 * (j))
#define XB_XGEN(j)  (2304 + 64 * (j))
#define XB_TOP      3328
#define XB_TOPGEN   3392
#define XCD_BAR_WORDS 3456
#define XB_SPIN_CAP (1u << 22)
DI unsigned xb_ld(unsigned* p)              { return __hip_atomic_load(p, __ATOMIC_RELAXED, __HIP_MEMORY_SCOPE_AGENT); }
DI unsigned xb_add(unsigned* p, unsigned v) { return __hip_atomic_fetch_add(p, v, __ATOMIC_RELAXED, __HIP_MEMORY_SCOPE_AGENT); }
DI unsigned xb_xcc_id() { return (unsigned)__builtin_amdgcn_s_getreg((3 << 11) | 20) & 0xFu; }
#define XB_SPIN(cond, bar) do { unsigned _sp = 0; while (cond) { __builtin_amdgcn_s_sleep(1); \
    if ((++_sp & 255u) == 0u) { if (xb_ld(&(bar)[XB_TMO])) break; if (_sp > XB_SPIN_CAP) { atomicAdd(&(bar)[XB_TMO], 1u); break; } } } } while (0)
struct XcdBarrier { unsigned* bar; unsigned x; volatile LAS unsigned* st; };
DI XcdBarrier xcd_barrier_post(unsigned* bar, volatile LAS unsigned* st, bool t0) {
    XcdBarrier b; b.bar = bar; b.x = xb_xcc_id(); b.st = st;
    if (t0) (void)xb_add(&bar[XB_XCNT(b.x)], 1u);
    return b;
}
DI void xcd_barrier_complete(unsigned* bar, unsigned x, unsigned& nloc, unsigned& nx) {
    const unsigned G = gridDim.x * gridDim.y * gridDim.z;
    unsigned sum, cnt, mine, sp = 0u;
    for (;;) {
        sum = 0u; cnt = 0u; mine = 0u;
#pragma unroll
        for (unsigned j = 0; j < 16; ++j) { const unsigned c = xb_ld(&bar[XB_XCNT(j)]); sum += c; cnt += (c > 0u) ? 1u : 0u; mine = (j == x) ? c : mine; }
        if (sum == G) break;
        __builtin_amdgcn_s_sleep(1);
        if ((++sp & 255u) == 0u) { if (xb_ld(&bar[XB_TMO])) break; if (sp > XB_SPIN_CAP) { atomicAdd(&bar[XB_TMO], 1u); break; } }
    }
    nloc = mine > 0u ? mine : 1u; nx = cnt > 0u ? cnt : 1u;
}
DI void xcd_barrier(const XcdBarrier& b, bool t0) {
    asm volatile("s_waitcnt vmcnt(0)" ::: "memory");
    __syncthreads();
    if (t0) {
        unsigned* bar = b.bar;
        __builtin_amdgcn_s_waitcnt(0);
        unsigned nloc = b.st[0], nx = b.st[1];
        if (nloc == 0u) { xcd_barrier_complete(bar, b.x, nloc, nx); b.st[0] = nloc; b.st[1] = nx; }
        const unsigned old = xb_add(&bar[XB_XSUB(b.x)], 1u);
        const unsigned gen = old / nloc;
        if (old + 1u == (gen + 1u) * nloc) {
            __builtin_amdgcn_fence(__ATOMIC_RELEASE, "agent");
            asm volatile("s_waitcnt vmcnt(0)" ::: "memory");
            const unsigned og = xb_add(&bar[XB_TOP], 1u);
            const unsigned tg = og / nx;
            if (og + 1u == (tg + 1u) * nx) xb_add(&bar[XB_TOPGEN], 1u);
            else XB_SPIN(xb_ld(&bar[XB_TOPGEN]) == tg, bar);
            __builtin_amdgcn_fence(__ATOMIC_ACQUIRE, "agent");
            xb_add(&bar[XB_XGEN(b.x)], 1u);
            asm volatile("s_waitcnt vmcnt(0)" ::: "memory");
        } else {
            XB_SPIN(xb_ld(&bar[XB_XGEN(b.x)]) == gen, bar);
            __builtin_amdgcn_fence(__ATOMIC_ACQUIRE, "agent");
            asm volatile("s_waitcnt vmcnt(0)" ::: "memory");
        }
    }
    __syncthreads();
}

constexpr int DM = 1024, SEQL = 2048, CTXL = 256, PP = 2304  ;
constexpr int NBG = 4  , NGRP = 2, NT = NBG * PP  ;
constexpr int INC = 8704, NCH = 18  ;
constexpr int LDH = 1088, LDW = 1088;
constexpr float EPS = 1e-6f;
constexpr float LOG2E = 1.4426950408889634f;

constexpr size_t TB = (size_t)NT * 512 * 2;
constexpr size_t OFF_BAR = 0;
constexpr size_t OFF_MOD = 16384;
constexpr size_t OFF_WIN = OFF_MOD + 262144;
constexpr size_t OFF_WBO = OFF_WIN + (size_t)2 * INC * LDW * 2;
constexpr size_t OFF_WO  = OFF_WBO + (size_t)2 * 3 * 1024 * 512 * 2;
constexpr size_t OFF_H   = OFF_WO + (size_t)2 * 1024 * 1024 * 2;
constexpr size_t OFF_RK  = OFF_H + (size_t)NT * LDH * 2;
constexpr size_t OFF_RKT = OFF_RK + TB;
constexpr size_t OFF_RVT = OFF_RKT + TB;
constexpr size_t OFF_DK  = OFF_RVT + TB;
constexpr size_t OFF_DVT = OFF_DK + TB;
constexpr size_t OFF_RQ  = OFF_DVT + TB;
constexpr size_t OFF_RG  = OFF_RQ + TB;
constexpr size_t OFF_DQ  = OFF_RG + TB;
constexpr size_t OFF_DG  = OFF_DQ + TB;
constexpr size_t OFF_MU  = OFF_DG + TB;
constexpr size_t OFF_MV  = OFF_MU + TB;
constexpr size_t OFF_MG  = OFF_MV + TB;
constexpr size_t OFF_MLOG = OFF_MG + TB;
constexpr size_t OFF_OMLP = OFF_MLOG + 6 * TB;
constexpr size_t OFF_ODIFF = OFF_OMLP + TB;
constexpr size_t OFF_ROPE = OFF_ODIFF + TB;
constexpr size_t WS_END = OFF_ROPE + (size_t)2048 * 96 * 8;
constexpr size_t OFF_ST = OFF_H;
constexpr size_t OFF_ORET = OFF_DK;
constexpr size_t OFF_Y = OFF_RK;
constexpr size_t OFF_OUT = OFF_MLOG;

struct Params {
    const float* in[16];
    float* out;
    unsigned char* ws;
};

struct Ctx {
    const float *x, *c, *ctx, *c_ctx, *w_mod, *b_mod, *g_pre, *g_post, *w_in, *decay, *w_s, *b_s, *lq, *lk, *w_bo, *w_out;
    float* out;
    unsigned char* ws;
    unsigned char* smem;
    const float* cst;
    int tid, lane, w, l31, hl;
};

DI unsigned pk2(float lo, float hi) {
    typedef __bf16 b2 __attribute__((ext_vector_type(2)));
    f32x2 v = {lo, hi};
    b2 r = __builtin_convertvector(v, b2);
    return __builtin_bit_cast(unsigned, r);
}
DI bf16_t f2bf(float x) { return (bf16_t)(pk2(x, 0.f) & 0xffffu); }
DI float bflo(unsigned u) { return __uint_as_float(u << 16); }
DI float bfhi(unsigned u) { return __uint_as_float(u & 0xffff0000u); }
DI int crow(int r, int hl) { return (r & 3) + 8 * (r >> 2) + 4 * hl; }
DI float wave_sum(float v) {
#pragma unroll
    for (int o = 1; o < 64; o <<= 1) v += __shfl_xor(v, o);
    return v;
}
DI float fsig(float x) { return __builtin_amdgcn_rcpf(1.f + __builtin_amdgcn_exp2f(-LOG2E * x)); }
DI void sincos_rev(float rev, float& sn, float& cs) {
    const float g = __builtin_amdgcn_fractf(rev) - 0.5f;
    const bool fold = fabsf(g) > 0.25f;
    const float h = fold ? (copysignf(0.5f, g) - g) : g;
    const float x = h * 6.283185307179586f;
    const float x2 = x * x;
    const float sp = x * (1.f + x2 * (-1.6666667e-1f + x2 * (8.3333333e-3f + x2 * (-1.9841270e-4f + x2 * (2.7557319e-6f - x2 * 2.5052108e-8f)))));
    const float cp = 1.f + x2 * (-0.5f + x2 * (4.1666667e-2f + x2 * (-1.3888889e-3f + x2 * (2.4801587e-5f + x2 * (-2.7557319e-7f + x2 * 2.0876757e-9f)))));
    sn = -sp;
    cs = fold ? cp : -cp;
}
DI float silu_f(float x) { return x / (1.f + __expf(-x)); }
DI float sigmoid_f(float x) { return 1.f / (1.f + __expf(-x)); }

DI void gemm_core(const Ctx& c, const bf16_t* __restrict__ Wt, int ldw, const bf16_t* __restrict__ Act, int lda, int K, f32x16 (&acc)[2][2]) {
    bf16_t* Ws = (bf16_t*)c.smem;
    bf16_t* As = Ws + 128 * 72;
    const int wn = c.w >> 1, wm = c.w & 1;
    const int lrow = c.tid >> 3, lseg = c.tid & 7;
    u32x4 rw[4], ra[4];
#pragma unroll
    for (int it = 0; it < 4; ++it) {
        rw[it] = *(const u32x4*)(Wt + (size_t)(lrow + 32 * it) * ldw + lseg * 8);
        ra[it] = *(const u32x4*)(Act + (size_t)(lrow + 32 * it) * lda + lseg * 8);
    }
    for (int k0 = 0; k0 < K; k0 += 64) {
        __syncthreads();
#pragma unroll
        for (int it = 0; it < 4; ++it) {
            *(u32x4*)(Ws + (lrow + 32 * it) * 72 + lseg * 8) = rw[it];
            *(u32x4*)(As + (lrow + 32 * it) * 72 + lseg * 8) = ra[it];
        }
        __syncthreads();
        if (k0 + 64 < K) {
#pragma unroll
            for (int it = 0; it < 4; ++it) {
                rw[it] = *(const u32x4*)(Wt + (size_t)(lrow + 32 * it) * ldw + k0 + 64 + lseg * 8);
                ra[it] = *(const u32x4*)(Act + (size_t)(lrow + 32 * it) * lda + k0 + 64 + lseg * 8);
            }
        }
#pragma unroll
        for (int ks = 0; ks < 4; ++ks) {
            const bf16x8 a0 = *(const bf16x8*)(Ws + (wn * 64 + c.l31) * 72 + ks * 16 + c.hl * 8);
            const bf16x8 a1 = *(const bf16x8*)(Ws + (wn * 64 + 32 + c.l31) * 72 + ks * 16 + c.hl * 8);
            const bf16x8 b0 = *(const bf16x8*)(As + (wm * 64 + c.l31) * 72 + ks * 16 + c.hl * 8);
            const bf16x8 b1 = *(const bf16x8*)(As + (wm * 64 + 32 + c.l31) * 72 + ks * 16 + c.hl * 8);
            acc[0][0] = MFMA(a0, b0, acc[0][0]);
            acc[0][1] = MFMA(a0, b1, acc[0][1]);
            acc[1][0] = MFMA(a1, b0, acc[1][0]);
            acc[1][1] = MFMA(a1, b1, acc[1][1]);
        }
    }
}
DI void zero_acc(f32x16 (&acc)[2][2]) {
#pragma unroll
    for (int i = 0; i < 2; ++i)
#pragma unroll
        for (int j = 0; j < 2; ++j)
#pragma unroll
            for (int r = 0; r < 16; ++r) acc[i][j][r] = 0.f;
}


DI void gemm_core2(const Ctx& c, const bf16_t* __restrict__ Wt, int ldw, const bf16_t* __restrict__ Act, int lda, int K, f32x16 (&acc)[2][4]) {
    constexpr int RS = 32;
    constexpr int STG = 384 * RS;
    bf16_t* S = (bf16_t*)c.smem;
    const int wn = c.w >> 1, wm = c.w & 1;
    const int rsw = (c.l31 >> 2) & 3;
    const int ro = c.lane >> 2, lc = (c.lane & 3) ^ ((c.lane >> 4) & 3);
    const bf16_t* wsrc = Wt + (size_t)(c.w * 16 + ro) * ldw + lc * 8;
    const bf16_t* asrc = Act + (size_t)(c.w * 16 + ro) * lda + lc * 8;
#define G2_GLDS(SP, KOFF) { \
        _Pragma("unroll") for (int i = 0; i < 2; ++i) __builtin_amdgcn_global_load_lds((const unsigned*)(wsrc + (size_t)(64 * i) * ldw + (KOFF)), (unsigned*)((SP) + (c.w + 4 * i) * 512), 16, 0, 0); \
        _Pragma("unroll") for (int i = 0; i < 4; ++i) __builtin_amdgcn_global_load_lds((const unsigned*)(asrc + (size_t)(64 * i) * lda + (KOFF)), (unsigned*)((SP) + (8 + c.w + 4 * i) * 512), 16, 0, 0); }
    __syncthreads();
    G2_GLDS(S, 0)
    asm volatile("s_waitcnt vmcnt(0)" ::: "memory");
    __syncthreads();
    for (int k0 = 0; k0 < K; k0 += 32) {
        const int s = (k0 >> 5) & 1;
        bf16_t* Sc = S + s * STG;
        bf16_t* Sn = S + (s ^ 1) * STG;
        if (k0 + 32 < K) G2_GLDS(Sn, k0 + 32)
#pragma unroll
        for (int ks = 0; ks < 2; ++ks) {
            const int rcol = ((ks * 2 + c.hl) ^ rsw) * 8;
            bf16x8 a[2], b[4];
#pragma unroll
            for (int i = 0; i < 2; ++i) a[i] = *(const bf16x8*)(Sc + (wn * 64 + i * 32 + c.l31) * RS + rcol);
#pragma unroll
            for (int j = 0; j < 4; ++j) b[j] = *(const bf16x8*)(Sc + (128 + wm * 128 + j * 32 + c.l31) * RS + rcol);
#pragma unroll
            for (int i = 0; i < 2; ++i)
#pragma unroll
                for (int j = 0; j < 4; ++j) acc[i][j] = MFMA(a[i], b[j], acc[i][j]);
        }
        asm volatile("s_waitcnt vmcnt(0)" ::: "memory");
        __syncthreads();
    }
#undef G2_GLDS
}
DI void zero_acc2(f32x16 (&acc)[2][4]) {
#pragma unroll
    for (int i = 0; i < 2; ++i)
#pragma unroll
        for (int j = 0; j < 4; ++j)
#pragma unroll
            for (int r = 0; r < 16; ++r) acc[i][j][r] = 0.f;
}

DI void transpose_item(const Ctx& c, const float* __restrict__ src, int N, int k0, int n0, int mapk, bf16_t* __restrict__ dst, int ldk) {
    float* T = (float*)c.smem;
    __syncthreads();
    {
        f32x4 tv[8];
#pragma unroll
        for (int it = 0; it < 8; ++it) { const int idx = c.tid + 256 * it; tv[it] = *(const f32x4*)(src + (size_t)(k0 + (idx >> 5)) * N + n0 + (idx & 31) * 4); }
#pragma unroll
        for (int it = 0; it < 8; ++it) {
            const int idx = c.tid + 256 * it, r = idx >> 5, c4 = idx & 31;
            float* t = T + r * 129 + c4 * 4;
            t[0] = tv[it][0]; t[1] = tv[it][1]; t[2] = tv[it][2]; t[3] = tv[it][3];
        }
    }
    __syncthreads();
#pragma unroll
    for (int it = 0; it < 4; ++it) {
        const int idx = c.tid + 256 * it, np = idx >> 3, ch = idx & 7;
        int cs = np;
        if (mapk == 1) cs = (np >> 1) + 64 * (np & 1);
        else if (mapk == 2) { const int r = np & 63; cs = (np & 64) + (r >> 1) + 32 * (r & 1); }
        const float* t = T + (ch * 8) * 129 + cs;
        u32x4 o;
        o[0] = pk2(t[0], t[129]); o[1] = pk2(t[2 * 129], t[3 * 129]); o[2] = pk2(t[4 * 129], t[5 * 129]); o[3] = pk2(t[6 * 129], t[7 * 129]);
        *(u32x4*)(dst + (size_t)(n0 + np) * ldk + k0 + ch * 8) = o;
    }
}
DI void mod_item(const Ctx& c, int l, int jb) {
    float* sv = (float*)c.smem;
    float* red = sv + 9 * 1024;
    __syncthreads();
    for (int idx = c.tid; idx < 9216; idx += 256) {
        const int v = idx >> 10, k = idx & 1023;
        const float x = v < 8 ? c.c[v * 1024 + k] : c.c_ctx[k];
        sv[idx] = x / (1.f + expf(-x));
    }
    __syncthreads();
    const int kk = c.tid >> 5, jj = c.tid & 31, j = jb * 32 + jj;
    float a[9];
#pragma unroll
    for (int v = 0; v < 9; ++v) a[v] = 0.f;
    const float* wp = c.w_mod + (size_t)l * 1024 * 3072 + j;
#pragma unroll 4
    for (int i = 0; i < 128; ++i) {
        const int k = kk + 8 * i;
        const float wv = wp[(size_t)k * 3072];
#pragma unroll
        for (int v = 0; v < 9; ++v) a[v] += sv[v * 1024 + k] * wv;
    }
#pragma unroll
    for (int v = 0; v < 9; ++v) red[(kk * 9 + v) * 32 + jj] = a[v];
    __syncthreads();
    float* MOD = (float*)(c.ws + OFF_MOD);
    for (int idx = c.tid; idx < 288; idx += 256) {
        const int v = idx >> 5, j2 = idx & 31;
        float s = 0.f;
#pragma unroll
        for (int k2 = 0; k2 < 8; ++k2) s += red[(k2 * 9 + v) * 32 + j2];
        MOD[(size_t)(l * 9 + v) * 3072 + jb * 32 + j2] = s + c.b_mod[l * 3072 + jb * 32 + j2];
    }
}

DI void rope_item(const Ctx& c, int it) {
    constexpr float L2B = 13.287712379549449f;
    f32x2* T = (f32x2*)(c.ws + OFF_ROPE);
#pragma unroll 1
    for (int e = 0; e < 8; ++e) {
        const int idx = (it * 8 + e) * 256 + c.tid;
        const int lp = idx / 96, a = idx % 96;
        const float rowp = (float)(lp >> 6), colp = (float)(lp & 63);
        float ang;
        if (a < 64) { const int f = a & 31; ang = (a < 32 ? rowp : colp) * exp2f(-(float)f * (L2B / 32.f)); }
        else { const int a2 = a - 64, f = a2 & 15; ang = (a2 < 16 ? rowp : colp) * exp2f(-(float)f * (L2B / 16.f)); }
        f32x2 v; v[0] = cosf(ang); v[1] = sinf(ang);
        T[idx] = v;
    }
}
DI void p0_item(const Ctx& c, int it) {
    if (it < 2 * 1408) {
        const int l = it / 1408; int r = it % 1408;
        if (r < 1088) {
            const int ct = r % 68, kb = r / 68;
            const int kind = ct >> 2;
            const int mapk = (kind == 0 || kind == 4) ? 1 : ((kind == 2 || kind == 6) ? 2 : 0);
            transpose_item(c, c.w_in + (size_t)l * 1024 * INC, INC, kb * 64, ct * 128, mapk, (bf16_t*)(c.ws + OFF_WIN) + (size_t)l * INC * LDW, LDW);
            return;
        }
        r -= 1088;
        if (r < 192) {
            const int br = r / 64, q = r % 64, kb = q >> 3, nb = q & 7;
            transpose_item(c, c.w_bo + (size_t)(l * 3 + br) * 512 * 1024, 1024, kb * 64, nb * 128, 0,
                           (bf16_t*)(c.ws + OFF_WBO) + (size_t)(l * 3 + br) * 1024 * 512, 512);
            return;
        }
        r -= 192;
        { const int kb = r >> 3, nb = r & 7;
          transpose_item(c, c.w_out + (size_t)l * 1024 * 1024, 1024, kb * 64, nb * 128, 0, (bf16_t*)(c.ws + OFF_WO) + (size_t)l * 1024 * 1024, 1024); }
        return;
    }
    it -= 2 * 1408;
    mod_item(c, it / 96, it % 96);
}

DI void modulate_row(const f32x4 (&x)[4], const float* gpre, const float* mod  , bf16_t* hrow, int lane) {
    float ss = 0.f;
#pragma unroll
    for (int j = 0; j < 4; ++j) ss += x[j][0] * x[j][0] + x[j][1] * x[j][1] + x[j][2] * x[j][2] + x[j][3] * x[j][3];
    ss = wave_sum(ss);
    const float r = rsqrtf(ss * (1.f / 1024.f) + EPS);
    f32x4 gq[4], shq[4], scq[4];
#pragma unroll
    for (int j = 0; j < 4; ++j) { const int col = lane * 4 + 256 * j; gq[j] = *(const f32x4*)(gpre + col); shq[j] = *(const f32x4*)(mod + col); scq[j] = *(const f32x4*)(mod + 1024 + col); }
#pragma unroll
    for (int j = 0; j < 4; ++j) {
        const int col = lane * 4 + 256 * j;
        const f32x4 g = gq[j], sh = shq[j], sc = scq[j];
        f32x4 h;
#pragma unroll
        for (int e = 0; e < 4; ++e) h[e] = x[j][e] * r * g[e] * (1.f + sc[e]) + sh[e];
        u32x2 o; o[0] = pk2(h[0], h[1]); o[1] = pk2(h[2], h[3]);
        *(u32x2*)(hrow + col) = o;
    }
}
DI void ph_item(const Ctx& c, int g, int item) {
    const int tok = item * 4 + c.w, bl = tok / PP, p = tok % PP, b = g * NBG + bl;
    const float* src = p < CTXL ? c.ctx + ((size_t)b * CTXL + p) * DM : c.x + ((size_t)b * SEQL + (p - CTXL)) * DM;
    f32x4 x[4];
#pragma unroll
    for (int j = 0; j < 4; ++j) x[j] = *(const f32x4*)(src + c.lane * 4 + 256 * j);
    const float* mod = (const float*)(c.ws + OFF_MOD) + (size_t)(0 * 9 + (p < CTXL ? 8 : b)) * 3072;
    modulate_row(x, c.g_pre, mod, (bf16_t*)(c.ws + OFF_H) + (size_t)tok * LDH, c.lane);
}
DI void pr_item(const Ctx& c, int l, int g, int item) {
    const int tok = item * 4 + c.w, bl = tok / PP, p = tok % PP, b = g * NBG + bl;
    if (l == 1 && p < CTXL) return;
    const float* orow = (const float*)(c.ws + OFF_OUT) + (size_t)tok * DM;
    const int v = p < CTXL ? 8 : b;
    const float* mod = (const float*)(c.ws + OFF_MOD) + (size_t)(l * 9 + v) * 3072;
    float* xo_lat = c.out + ((size_t)b * SEQL + (p - CTXL)) * DM;
    const float* xold = p < CTXL ? c.ctx + ((size_t)b * CTXL + p) * DM : (l == 0 ? c.x + ((size_t)b * SEQL + (p - CTXL)) * DM : xo_lat);
    f32x4 o[4], gpq[4], gtq[4], xvq[4]; float ss = 0.f;
#pragma unroll
    for (int j = 0; j < 4; ++j) {
        const int col = c.lane * 4 + 256 * j;
        o[j] = *(const f32x4*)(orow + col); gpq[j] = *(const f32x4*)(c.g_post + l * 1024 + col); gtq[j] = *(const f32x4*)(mod + 2048 + col); xvq[j] = *(const f32x4*)(xold + col);
    }
#pragma unroll
    for (int j = 0; j < 4; ++j) ss += o[j][0] * o[j][0] + o[j][1] * o[j][1] + o[j][2] * o[j][2] + o[j][3] * o[j][3];
    ss = wave_sum(ss);
    const float r = rsqrtf(ss * (1.f / 1024.f) + EPS);
    f32x4 xn[4];
#pragma unroll
    for (int j = 0; j < 4; ++j) {
        const int col = c.lane * 4 + 256 * j;
        const f32x4 gp = gpq[j], gt = gtq[j], xv = xvq[j];
#pragma unroll
        for (int e = 0; e < 4; ++e) xn[j][e] = xv[e] + gt[e] * (o[j][e] * r * gp[e]);
        if (p >= CTXL) *(f32x4*)(xo_lat + col) = xn[j];
    }
    if (l == 0) {
        const float* mod1 = (const float*)(c.ws + OFF_MOD) + (size_t)(1 * 9 + v) * 3072;
        modulate_row(xn, c.g_pre + 1024, mod1, (bf16_t*)(c.ws + OFF_H) + (size_t)tok * LDH, c.lane);
    }
}

DI void pz_item(const Ctx& c, int l, int rt2, int ct) {
    f32x16 acc[2][4];
    zero_acc2(acc);
    gemm_core2(c, (const bf16_t*)(c.ws + OFF_WIN) + ((size_t)l * INC + (size_t)ct * 128) * LDW, LDW,
               (const bf16_t*)(c.ws + OFF_H) + (size_t)rt2 * 256 * LDH, LDH, 1024, acc);
    const int wn = c.w >> 1, wm = c.w & 1;
    const int bl = rt2 / 9, pt2 = rt2 % 9;
    const int kind = ct >> 2, h = ct & 3;
    const bool roped = (kind == 0 || kind == 4 || kind == 2 || kind == 6);
    const bool retk = (kind == 0 || kind == 4);
    bf16_t* E = (bf16_t*)c.smem;
    constexpr int ES = 136, ETS = 264;
    const float rsc = kind == 0 ? 0.08838834764831845f : (kind == 6 ? 0.125f * LOG2E : 1.f);
    const bool latent = pt2 > 0;
    const bool mulx = (kind == 5 || kind == 7 || kind == 10);
#define XF_PLAIN  { v0 *= rsc; v1 *= rsc; v2 *= rsc; v3 *= rsc; }
#define XF_SIG    { v0 = fsig(v0); v1 = fsig(v1); v2 = fsig(v2); v3 = fsig(v3); }
#define XF_SILU   { v0 *= fsig(v0); v1 *= fsig(v1); v2 *= fsig(v2); v3 *= fsig(v3); }
#define PZ_STAGE(PASS, XF) \
    _Pragma("unroll") for (int j = 0; j < 4; ++j) { \
        const int m = wm * 128 + j * 32 + c.l31; \
        _Pragma("unroll") for (int i = 0; i < 2; ++i) \
        _Pragma("unroll") for (int q = 0; q < 4; ++q) { \
            const int n0 = wn * 64 + i * 32 + 8 * q + 4 * c.hl; \
            float v0 = acc[i][j][4 * q + 0], v1 = acc[i][j][4 * q + 1], v2 = acc[i][j][4 * q + 2], v3 = acc[i][j][4 * q + 3]; \
            XF \
            if (PASS == 0) { \
                u32x2 o; o[0] = pk2(v0, v1); o[1] = pk2(v2, v3); \
                *(u32x2*)(E + m * ES + n0) = o; \
            } else { \
                E[(n0 + 0) * ETS + m] = f2bf(v0); E[(n0 + 1) * ETS + m] = f2bf(v1); E[(n0 + 2) * ETS + m] = f2bf(v2); E[(n0 + 3) * ETS + m] = f2bf(v3); \
            } \
        } \
    }
    const int cls = roped ? (latent ? 0 : 1) : (kind >= 11 ? 2 : (mulx ? 3 : 1));
    const int nfq = retk ? 32 : 16;
    const float fsc = retk ? (13.287712379549449f / 32.f) : (13.287712379549449f / 16.f);
    if (cls == 0) {
        const int lbase = pt2 * 256 + wm * 128 - CTXL;
        const float rowA = (float)(lbase >> 6), colA = (float)c.l31;
#pragma unroll
        for (int i = 0; i < 2; ++i) {
            const bool rowpart = retk ? (wn == 0) : (i == 0);
            const float posA = rowpart ? rowA : colA;
            const float posB = rowpart ? rowA + 1.f : colA + 32.f;
#pragma unroll
            for (int q = 0; q < 4; ++q) {
                const int n0 = wn * 64 + i * 32 + 8 * q + 4 * c.hl;
                const int c0 = retk ? (n0 >> 1) : ((n0 & 63) >> 1);
                const float iv0 = __builtin_amdgcn_exp2f(-(float)(c0 & (nfq - 1)) * fsc) * 0.15915494309189535f;
                const float iv1 = __builtin_amdgcn_exp2f(-(float)((c0 + 1) & (nfq - 1)) * fsc) * 0.15915494309189535f;
#define ROPE_APPLY(POS, JA, JB) { float s0, c0f, s1, c1f; sincos_rev((POS) * iv0, s0, c0f); sincos_rev((POS) * iv1, s1, c1f); \
                    { const float v0 = acc[i][JA][4 * q + 0], v1 = acc[i][JA][4 * q + 1], v2 = acc[i][JA][4 * q + 2], v3 = acc[i][JA][4 * q + 3]; \
                      acc[i][JA][4 * q + 0] = v0 * c0f - v1 * s0; acc[i][JA][4 * q + 1] = v0 * s0 + v1 * c0f; acc[i][JA][4 * q + 2] = v2 * c1f - v3 * s1; acc[i][JA][4 * q + 3] = v2 * s1 + v3 * c1f; } \
                    { const float v0 = acc[i][JB][4 * q + 0], v1 = acc[i][JB][4 * q + 1], v2 = acc[i][JB][4 * q + 2], v3 = acc[i][JB][4 * q + 3]; \
                      acc[i][JB][4 * q + 0] = v0 * c0f - v1 * s0; acc[i][JB][4 * q + 1] = v0 * s0 + v1 * c0f; acc[i][JB][4 * q + 2] = v2 * c1f - v3 * s1; acc[i][JB][4 * q + 3] = v2 * s1 + v3 * c1f; } }
                if (rowpart) { ROPE_APPLY(posA, 0, 1) ROPE_APPLY(posB, 2, 3) }
                else { ROPE_APPLY(posA, 0, 2) ROPE_APPLY(posB, 1, 3) }
#undef ROPE_APPLY
            }
        }
    }
    if (kind != 1 && kind != 3) {
        if (cls <= 1) { PZ_STAGE(0, XF_PLAIN) }
        else if (cls == 2) { PZ_STAGE(0, XF_SIG) }
        else { PZ_STAGE(0, XF_SILU) }
        __syncthreads();
        bf16_t* dst; size_t ld;
        if (kind >= 11) { dst = (bf16_t*)(c.ws + OFF_MLOG) + (size_t)(ct - 44) * 128; ld = 3072; }
        else {
            size_t off;
            switch (kind) { case 0: off = OFF_RK; break; case 2: off = OFF_DK; break; case 4: off = OFF_RQ; break; case 5: off = OFF_RG; break;
                            case 6: off = OFF_DQ; break; case 7: off = OFF_DG; break; case 8: off = OFF_MU; break; case 9: off = OFF_MV; break; default: off = OFF_MG; break; }
            dst = (bf16_t*)(c.ws + off) + h * 128; ld = 512;
        }
        dst += (size_t)rt2 * 256 * ld;
#pragma unroll 4
        for (int it = 0; it < 16; ++it) {
            const int id = c.tid + 256 * it, row = id >> 4, seg = id & 15;
            *(u32x4*)(dst + (size_t)row * ld + seg * 8) = *(const u32x4*)(E + row * ES + seg * 8);
        }
    }
    if (kind == 0 || kind == 1 || kind == 3) {
        if (kind == 0) __syncthreads();
        PZ_STAGE(1, XF_PLAIN)
        __syncthreads();
        const size_t off = kind == 0 ? OFF_RKT : (kind == 1 ? OFF_RVT : OFF_DVT);
        bf16_t* dst = (bf16_t*)(c.ws + off) + (size_t)(bl * 4 + h) * 128 * PP + pt2 * 256;
#pragma unroll 4
        for (int it = 0; it < 16; ++it) {
            const int id = c.tid + 256 * it, n = id >> 5, seg = id & 31;
            *(u32x4*)(dst + (size_t)n * PP + seg * 8) = *(const u32x4*)(E + n * ETS + seg * 8);
        }
    }
    __builtin_amdgcn_s_setprio(0);
#undef PZ_STAGE
#undef XF_PLAIN
#undef XF_SIG
#undef XF_SILU
}

DI void attn_item(const Ctx& c, int l, int bl, int h, int q0, int nk) {
    bf16_t* Ks = (bf16_t*)c.smem;
    bf16_t* Vs = Ks + 64 * 136;
    const int mp = c.w >> 1, qs = c.w & 1;
    const int qpos = q0 + qs * 32 + c.l31;
    const size_t qtok = (size_t)bl * PP + qpos;
    const bf16_t* DQ = (const bf16_t*)(c.ws + OFF_DQ);
    const bf16_t* DK = (const bf16_t*)(c.ws + OFF_DK) + (size_t)bl * PP * 512 + h * 128;
    const bf16_t* DVT = (const bf16_t*)(c.ws + OFF_DVT) + (size_t)(bl * 4 + h) * 128 * PP;
    bf16x8 qf[4];
#pragma unroll
    for (int ks = 0; ks < 4; ++ks) qf[ks] = *(const bf16x8*)(DQ + qtok * 512 + h * 128 + mp * 64 + ks * 16 + c.hl * 8);
    f32x16 o[4];
#pragma unroll
    for (int et = 0; et < 4; ++et)
#pragma unroll
        for (int r = 0; r < 16; ++r) o[et][r] = 0.f;
    float mrun = -1e30f, lrun = 0.f;
    u32x4 rk[4], rv[4];
    constexpr int BUF = 64 * 136 + 128 * 68;
#define AT_LOAD(KT0) { _Pragma("unroll") for (int it = 0; it < 4; ++it) { const int idx = c.tid + 256 * it; \
        rk[it] = *(const u32x4*)(DK + (size_t)((KT0) + (idx >> 4)) * 512 + (idx & 15) * 8); \
        rv[it] = *(const u32x4*)(DVT + (size_t)(idx >> 3) * PP + (KT0) + (idx & 7) * 8); } }
#define AT_STORE(BP) { _Pragma("unroll") for (int it = 0; it < 4; ++it) { const int idx = c.tid + 256 * it; \
        *(u32x4*)((BP) + (idx >> 4) * 136 + (idx & 15) * 8) = rk[it]; \
        u32x2 lo2, hi2; lo2[0] = rv[it][0]; lo2[1] = rv[it][1]; hi2[0] = rv[it][2]; hi2[1] = rv[it][3]; \
        *(u32x2*)((BP) + 64 * 136 + (idx >> 3) * 68 + (idx & 7) * 8) = lo2; *(u32x2*)((BP) + 64 * 136 + (idx >> 3) * 68 + (idx & 7) * 8 + 4) = hi2; } }
    AT_LOAD(0)
    __syncthreads();
    AT_STORE(Ks)
    if (64 < nk) AT_LOAD(64)
    __syncthreads();
    for (int kt0 = 0; kt0 < nk; kt0 += 64) {
        const int cb = (kt0 >> 6) & 1;
        const bf16_t* Kc = Ks + cb * BUF;
        const bf16_t* Vc = Kc + 64 * 136;
        if (kt0 + 64 < nk) {
            AT_STORE(Ks + (cb ^ 1) * BUF)
            if (kt0 + 128 < nk) AT_LOAD(kt0 + 128)
        }
        f32x16 s[2];
#pragma unroll
        for (int kt = 0; kt < 2; ++kt) {
#pragma unroll
            for (int r = 0; r < 16; ++r) s[kt][r] = 0.f;
#pragma unroll
            for (int ks = 0; ks < 4; ++ks) {
                const bf16x8 a = *(const bf16x8*)(Kc + (kt * 32 + c.l31) * 136 + mp * 64 + ks * 16 + c.hl * 8);
                s[kt] = MFMA(a, qf[ks], s[kt]);
            }
        }
        float mx = s[0][0];
#pragma unroll
        for (int r = 0; r < 16; ++r) { mx = fmaxf(mx, s[0][r]); mx = fmaxf(mx, s[1][r]); }
        mx = fmaxf(mx, __shfl_xor(mx, 32));
        const float mold = mrun;
        const float mnew = fmaxf(mrun, mx);
        const float alpha = __builtin_amdgcn_exp2f(mrun - mnew);
        mrun = mnew;
        float lsum = 0.f;
#pragma unroll
        for (int kt = 0; kt < 2; ++kt)
#pragma unroll
            for (int r = 0; r < 16; ++r) { const float pv = __builtin_amdgcn_exp2f(s[kt][r] - mnew); s[kt][r] = pv; lsum += pv; }
        lrun = lrun * alpha + lsum;
        if (__any(mx > mold)) {
#pragma unroll
            for (int et = 0; et < 4; ++et)
#pragma unroll
                for (int r = 0; r < 16; ++r) o[et][r] *= alpha;
        }
#pragma unroll
        for (int kt = 0; kt < 2; ++kt) {
#pragma unroll
            for (int st = 0; st < 2; ++st) {
                u32x4 pp;
                pp[0] = pk2(s[kt][8 * st + 0], s[kt][8 * st + 1]); pp[1] = pk2(s[kt][8 * st + 2], s[kt][8 * st + 3]);
                pp[2] = pk2(s[kt][8 * st + 4], s[kt][8 * st + 5]); pp[3] = pk2(s[kt][8 * st + 6], s[kt][8 * st + 7]);
                const bf16x8 pf = __builtin_bit_cast(bf16x8, pp);
#pragma unroll
                for (int et = 0; et < 4; ++et) {
                    const bf16_t* vp = Vc + (et * 32 + c.l31) * 68 + kt * 32 + 16 * st + 4 * c.hl;
                    const u32x2 lo = *(const u32x2*)vp, hi = *(const u32x2*)(vp + 8);
                    u32x4 av; av[0] = lo[0]; av[1] = lo[1]; av[2] = hi[0]; av[3] = hi[1];
                    o[et] = MFMA(__builtin_bit_cast(bf16x8, av), pf, o[et]);
                }
            }
        }
        __syncthreads();
    }
#undef AT_LOAD
#undef AT_STORE
    const float ltot = lrun + __shfl_xor(lrun, 32);
    const float linv = 1.f / ltot;
    float* Oc = (float*)c.smem;
    if (mp == 1) {
#pragma unroll
        for (int et = 0; et < 4; ++et)
#pragma unroll
            for (int r = 0; r < 16; ++r) Oc[(qs * 128 + et * 32 + crow(r, c.hl)) * 32 + c.l31] = o[et][r] * linv;
    }
    __syncthreads();
    if (mp == 0) {
        const float lam = c.cst[l], lam_init = c.cst[2 + l];
        float ss = 0.f;
#pragma unroll
        for (int et = 0; et < 4; ++et)
#pragma unroll
            for (int r = 0; r < 16; ++r) {
                const float d = o[et][r] * linv - lam * Oc[(qs * 128 + et * 32 + crow(r, c.hl)) * 32 + c.l31];
                o[et][r] = d; ss += d * d;
            }
        ss += __shfl_xor(ss, 32);
        const float rn = rsqrtf(ss * (1.f / 128.f) + EPS) * (1.f - lam_init);
        const bf16_t* DG = (const bf16_t*)(c.ws + OFF_DG) + qtok * 512 + h * 128;
        bf16_t* OD = (bf16_t*)(c.ws + OFF_ODIFF) + qtok * 512 + h * 128;
#pragma unroll
        for (int et = 0; et < 4; ++et)
#pragma unroll
            for (int q = 0; q < 4; ++q) {
                const int e0 = et * 32 + 8 * q + 4 * c.hl;
                const u32x2 g = *(const u32x2*)(DG + e0);
                u32x2 ov;
                ov[0] = pk2(o[et][4 * q + 0] * rn * bflo(g[0]), o[et][4 * q + 1] * rn * bfhi(g[0]));
                ov[1] = pk2(o[et][4 * q + 2] * rn * bflo(g[1]), o[et][4 * q + 3] * rn * bfhi(g[1]));
                *(u32x2*)(OD + e0) = ov;
            }
    }
}

DI void scan_item(const Ctx& c, int l, int bl, int h, int dir, int es) {
    const float lg2 = c.cst[4 + l * 8 + dir * 4 + h];
    const float decayC = __builtin_amdgcn_exp2f(lg2 * 128.f);
    f32x16 st;
#pragma unroll
    for (int r = 0; r < 16; ++r) st[r] = 0.f;
    const bf16_t* vt = (const bf16_t*)(c.ws + OFF_RVT) + ((size_t)(bl * 4 + h) * 128 + es * 32 + c.l31) * PP;
    const bf16_t* kt = (const bf16_t*)(c.ws + OFF_RKT) + ((size_t)(bl * 4 + h) * 128 + c.w * 32 + c.l31) * PP;
    bf16_t* stbase = (bf16_t*)(c.ws + OFF_ST) + (size_t)(((bl * 4 + h) * 2 + dir) * NCH) * 16384;
#pragma unroll 1
    for (int step = 0; step < NCH; ++step) {
        const int m = dir == 0 ? step : (step < 2 ? 1 - step : 19 - step);
        bf16_t* sp = stbase + (size_t)m * 16384;
#pragma unroll
        for (int r = 0; r < 16; ++r) sp[(es * 32 + crow(r, c.hl)) * 128 + c.w * 32 + c.l31] = f2bf(st[r]);
        if (step == NCH - 1) break;
#pragma unroll
        for (int r = 0; r < 16; ++r) st[r] *= decayC;
#pragma unroll
        for (int ks = 0; ks < 8; ++ks) {
            const int j0 = ks * 16 + c.hl * 8;
            const u32x4 av = *(const u32x4*)(vt + m * 128 + j0);
            const u32x4 bv = *(const u32x4*)(kt + m * 128 + j0);
            u32x4 as;
#pragma unroll
            for (int e = 0; e < 4; ++e) {
                const int ja = j0 + 2 * e;
                const float e0 = dir == 0 ? (float)(127 - ja) : (float)ja;
                const float e1 = dir == 0 ? (float)(126 - ja) : (float)(ja + 1);
                const float w0 = __builtin_amdgcn_exp2f(lg2 * e0), w1 = __builtin_amdgcn_exp2f(lg2 * e1);
                as[e] = pk2(bflo(av[e]) * w0, bfhi(av[e]) * w1);
            }
            st = MFMA(__builtin_bit_cast(bf16x8, as), __builtin_bit_cast(bf16x8, bv), st);
        }
    }
}

DI void mlp_item(const Ctx& c, int l, int bl, int m, int g) {
    bf16_t* Vn = (bf16_t*)c.smem;
    bf16_t* Wsm = Vn + 128 * 136;
    float* stat = (float*)(Wsm + 128 * 136);
    const size_t tok0 = (size_t)bl * PP + m * 128;
    const bf16_t* MV = (const bf16_t*)(c.ws + OFF_MV);
    __syncthreads();
#pragma unroll 1
    for (int rb = 0; rb < 4; ++rb) {
        u32x4 vv[8];
#pragma unroll
        for (int r8 = 0; r8 < 8; ++r8) vv[r8] = *(const u32x4*)(MV + (tok0 + c.w * 32 + rb * 8 + r8) * 512 + c.lane * 8);
#pragma unroll
        for (int r8 = 0; r8 < 8; ++r8) {
            const int row = c.w * 32 + rb * 8 + r8;
            float xv[8];
#pragma unroll
            for (int e = 0; e < 4; ++e) { xv[2 * e] = bflo(vv[r8][e]); xv[2 * e + 1] = bfhi(vv[r8][e]); }
            float sm = 0.f;
#pragma unroll
            for (int e = 0; e < 8; ++e) sm += xv[e];
            sm = wave_sum(sm);
            const float mu = sm * (1.f / 512.f);
            float ss = 0.f;
#pragma unroll
            for (int e = 0; e < 8; ++e) { const float d = xv[e] - mu; ss += d * d; }
            ss = wave_sum(ss);
            if (c.lane == 0) { stat[row] = mu; stat[128 + row] = rsqrtf(ss * (1.f / 512.f) + EPS); }
        }
    }
    __syncthreads();
    {
        u32x4 tv[8];
#pragma unroll
        for (int it = 0; it < 8; ++it) { const int idx = c.tid + 256 * it; tv[it] = *(const u32x4*)(MV + (tok0 + (idx >> 4)) * 512 + g * 128 + (idx & 15) * 8); }
#pragma unroll
        for (int it = 0; it < 8; ++it) {
            const int idx = c.tid + 256 * it, j = idx >> 4, seg = idx & 15;
            const float mu = stat[j], rs = stat[128 + j];
#pragma unroll
            for (int e = 0; e < 4; ++e) {
                Vn[(seg * 8 + 2 * e) * 136 + j] = f2bf((bflo(tv[it][e]) - mu) * rs);
                Vn[(seg * 8 + 2 * e + 1) * 136 + j] = f2bf((bfhi(tv[it][e]) - mu) * rs);
            }
        }
    }
    {
        const float* wsrc = c.w_s + (size_t)(l * 4 + g) * 128 * 128;
#pragma unroll 1
        for (int hb = 0; hb < 2; ++hb) {
            f32x4 wv[8];
#pragma unroll
            for (int it = 0; it < 8; ++it) { const int idx = c.tid + 256 * (hb * 8 + it); wv[it] = *(const f32x4*)(wsrc + (idx >> 5) * 128 + (idx & 31) * 4); }
#pragma unroll
            for (int it = 0; it < 8; ++it) {
                const int idx = c.tid + 256 * (hb * 8 + it);
                u32x2 o; o[0] = pk2(wv[it][0], wv[it][1]); o[1] = pk2(wv[it][2], wv[it][3]);
                *(u32x2*)(Wsm + (idx >> 5) * 136 + (idx & 31) * 4) = o;
            }
        }
    }
    __syncthreads();
    const int wc = c.w >> 1, wi = c.w & 1;
    f32x16 acc[2][2];
    zero_acc(acc);
#pragma unroll
    for (int ks = 0; ks < 8; ++ks) {
        const bf16x8 a0 = *(const bf16x8*)(Vn + (wc * 64 + c.l31) * 136 + ks * 16 + c.hl * 8);
        const bf16x8 a1 = *(const bf16x8*)(Vn + (wc * 64 + 32 + c.l31) * 136 + ks * 16 + c.hl * 8);
        const bf16x8 b0 = *(const bf16x8*)(Wsm + (wi * 64 + c.l31) * 136 + ks * 16 + c.hl * 8);
        const bf16x8 b1 = *(const bf16x8*)(Wsm + (wi * 64 + 32 + c.l31) * 136 + ks * 16 + c.hl * 8);
        acc[0][0] = MFMA(a0, b0, acc[0][0]); acc[0][1] = MFMA(a0, b1, acc[0][1]);
        acc[1][0] = MFMA(a1, b0, acc[1][0]); acc[1][1] = MFMA(a1, b1, acc[1][1]);
    }
    const bf16_t* MU = (const bf16_t*)(c.ws + OFF_MU);
    const bf16_t* MG = (const bf16_t*)(c.ws + OFF_MG);
    bf16_t* OM = (bf16_t*)(c.ws + OFF_OMLP);
    u32x2 uq[2][2][4], gq[2][2][4];
    float bsq[2];
#pragma unroll
    for (int ii = 0; ii < 2; ++ii) {
        const int i = wi * 64 + ii * 32 + c.l31;
        const size_t tok = tok0 + i;
        bsq[ii] = c.b_s[(l * 4 + g) * 128 + i];
#pragma unroll
        for (int ci = 0; ci < 2; ++ci)
#pragma unroll
            for (int q = 0; q < 4; ++q) {
                const int c0 = g * 128 + wc * 64 + ci * 32 + 8 * q + 4 * c.hl;
                uq[ii][ci][q] = *(const u32x2*)(MU + tok * 512 + c0); gq[ii][ci][q] = *(const u32x2*)(MG + tok * 512 + c0);
            }
    }
#pragma unroll
    for (int ii = 0; ii < 2; ++ii) {
        const int i = wi * 64 + ii * 32 + c.l31;
        const size_t tok = tok0 + i;
        const float bs = bsq[ii];
#pragma unroll
        for (int ci = 0; ci < 2; ++ci)
#pragma unroll
            for (int q = 0; q < 4; ++q) {
                const int c0 = g * 128 + wc * 64 + ci * 32 + 8 * q + 4 * c.hl;
                const u32x2 u = uq[ii][ci][q], gg = gq[ii][ci][q];
                u32x2 ov;
                ov[0] = pk2(bflo(u[0]) * (acc[ci][ii][4 * q + 0] + bs) * bflo(gg[0]), bfhi(u[0]) * (acc[ci][ii][4 * q + 1] + bs) * bfhi(gg[0]));
                ov[1] = pk2(bflo(u[1]) * (acc[ci][ii][4 * q + 2] + bs) * bflo(gg[1]), bfhi(u[1]) * (acc[ci][ii][4 * q + 3] + bs) * bfhi(gg[1]));
                *(u32x2*)(OM + tok * 512 + c0) = ov;
            }
    }
}

DI void retout_item(const Ctx& c, int l, int bl, int h, int m) {
    bf16_t* Ks = (bf16_t*)c.smem;
    bf16_t* Vs = Ks + 128 * 136;
    const size_t tok0 = (size_t)bl * PP + m * 128;
    const bf16_t* RK = (const bf16_t*)(c.ws + OFF_RK) + tok0 * 512 + h * 128;
    const bf16_t* RVT = (const bf16_t*)(c.ws + OFF_RVT) + (size_t)(bl * 4 + h) * 128 * PP + m * 128;
    __syncthreads();
    {
        u32x4 tk[8], tv[8];
#pragma unroll
        for (int it = 0; it < 8; ++it) {
            const int idx = c.tid + 256 * it, row = idx >> 4, seg = idx & 15;
            tk[it] = *(const u32x4*)(RK + (size_t)row * 512 + seg * 8);
            tv[it] = *(const u32x4*)(RVT + (size_t)row * PP + seg * 8);
        }
#pragma unroll
        for (int it = 0; it < 8; ++it) {
            const int idx = c.tid + 256 * it, row = idx >> 4, seg = idx & 15;
            *(u32x4*)(Ks + row * 136 + seg * 8) = tk[it];
            u32x2 lo2, hi2; lo2[0] = tv[it][0]; lo2[1] = tv[it][1]; hi2[0] = tv[it][2]; hi2[1] = tv[it][3];
            *(u32x2*)(Vs + row * 132 + seg * 8) = lo2; *(u32x2*)(Vs + row * 132 + seg * 8 + 4) = hi2;
        }
    }
    __syncthreads();
    const int i = c.w * 32 + c.l31;
    const size_t tok = tok0 + i;
    const float lgf = c.cst[4 + l * 8 + h], lgb = c.cst[4 + l * 8 + 4 + h];
    bf16x8 qf[8];
    const bf16_t* RQ = (const bf16_t*)(c.ws + OFF_RQ) + tok * 512 + h * 128;
#pragma unroll
    for (int ks = 0; ks < 8; ++ks) qf[ks] = *(const bf16x8*)(RQ + ks * 16 + c.hl * 8);
    f32x16 o[4];
    const bf16_t* stf = (const bf16_t*)(c.ws + OFF_ST) + (size_t)(((bl * 4 + h) * 2 + 0) * NCH + m) * 16384;
    const bf16_t* stb = (const bf16_t*)(c.ws + OFF_ST) + (size_t)(((bl * 4 + h) * 2 + 1) * NCH + m) * 16384;
    const float qdf = __builtin_amdgcn_exp2f(lgf * (float)(i + 1)), qdb = __builtin_amdgcn_exp2f(lgb * (float)(128 - i));
#pragma unroll
    for (int et = 0; et < 4; ++et) {
        f32x16 tf, tb;
#pragma unroll
        for (int r = 0; r < 16; ++r) { tf[r] = 0.f; tb[r] = 0.f; }
        bf16x8 sa[8], sb[8];
#pragma unroll
        for (int ks = 0; ks < 8; ++ks) {
            sa[ks] = *(const bf16x8*)(stf + (et * 32 + c.l31) * 128 + ks * 16 + c.hl * 8);
            sb[ks] = *(const bf16x8*)(stb + (et * 32 + c.l31) * 128 + ks * 16 + c.hl * 8);
        }
#pragma unroll
        for (int ks = 0; ks < 8; ++ks) {
            tf = MFMA(sa[ks], qf[ks], tf);
            tb = MFMA(sb[ks], qf[ks], tb);
        }
#pragma unroll
        for (int r = 0; r < 16; ++r) o[et][r] = tf[r] * qdf + tb[r] * qdb;
        __builtin_amdgcn_sched_barrier(0);
    }
#pragma unroll
    for (int jt = 0; jt < 4; ++jt) {
        f32x16 sc;
#pragma unroll
        for (int r = 0; r < 16; ++r) sc[r] = 0.f;
#pragma unroll
        for (int ks = 0; ks < 8; ++ks) {
            const bf16x8 a = *(const bf16x8*)(Ks + (jt * 32 + c.l31) * 136 + ks * 16 + c.hl * 8);
            sc = MFMA(a, qf[ks], sc);
        }
#pragma unroll
        for (int r = 0; r < 16; ++r) {
            const int j = jt * 32 + crow(r, c.hl);
            const int dl = i - j;
            const float arg = dl > 0 ? lgf * (float)dl : -lgb * (float)dl;
            float f = __builtin_amdgcn_exp2f(arg);
            f = dl == 0 ? 2.f : f;
            sc[r] *= f;
        }
#pragma unroll
        for (int s2 = 0; s2 < 2; ++s2) {
            u32x4 pp;
            pp[0] = pk2(sc[8 * s2 + 0], sc[8 * s2 + 1]); pp[1] = pk2(sc[8 * s2 + 2], sc[8 * s2 + 3]);
            pp[2] = pk2(sc[8 * s2 + 4], sc[8 * s2 + 5]); pp[3] = pk2(sc[8 * s2 + 6], sc[8 * s2 + 7]);
            const bf16x8 pf = __builtin_bit_cast(bf16x8, pp);
#pragma unroll
            for (int et = 0; et < 4; ++et) {
                const bf16_t* vp = Vs + (et * 32 + c.l31) * 132 + jt * 32 + 16 * s2 + 4 * c.hl;
                const u32x2 lo = *(const u32x2*)vp, hi = *(const u32x2*)(vp + 8);
                u32x4 av; av[0] = lo[0]; av[1] = lo[1]; av[2] = hi[0]; av[3] = hi[1];
                o[et] = MFMA(__builtin_bit_cast(bf16x8, av), pf, o[et]);
            }
        }
        __builtin_amdgcn_sched_barrier(0);
    }
    float ss = 0.f;
#pragma unroll
    for (int et = 0; et < 4; ++et)
#pragma unroll
        for (int r = 0; r < 16; ++r) ss += o[et][r] * o[et][r];
    ss += __shfl_xor(ss, 32);
    const float rn = rsqrtf(ss * (1.f / 128.f) + EPS);
    const bf16_t* RG = (const bf16_t*)(c.ws + OFF_RG) + tok * 512 + h * 128;
    bf16_t* OR = (bf16_t*)(c.ws + OFF_ORET) + tok * 512 + h * 128;
#pragma unroll
    for (int et = 0; et < 4; ++et)
#pragma unroll
        for (int q = 0; q < 4; ++q) {
            const int e0 = et * 32 + 8 * q + 4 * c.hl;
            const u32x2 g = *(const u32x2*)(RG + e0);
            u32x2 ov;
            ov[0] = pk2(o[et][4 * q + 0] * rn * bflo(g[0]), o[et][4 * q + 1] * rn * bfhi(g[0]));
            ov[1] = pk2(o[et][4 * q + 2] * rn * bflo(g[1]), o[et][4 * q + 3] * rn * bfhi(g[1]));
            *(u32x2*)(OR + e0) = ov;
        }
}

DI void pm_item(const Ctx& c, int l, int rt, int nt) {
    f32x16 y[2][2], acc[2][2];
    zero_acc(y);
    const int wn = c.w >> 1, wm = c.w & 1;
    const bf16_t* MLOG = (const bf16_t*)(c.ws + OFF_MLOG);
#pragma unroll 1
    for (int br = 0; br < 3; ++br) {
        const size_t ooff = br == 0 ? OFF_ORET : (br == 1 ? OFF_OMLP : OFF_ODIFF);
        zero_acc(acc);
        gemm_core(c, (const bf16_t*)(c.ws + OFF_WBO) + ((size_t)(l * 3 + br) * 1024 + (size_t)nt * 128) * 512, 512,
                  (const bf16_t*)(c.ws + ooff) + (size_t)rt * 128 * 512, 512, 512, acc);
#pragma unroll
        for (int j = 0; j < 2; ++j) {
            const size_t tok = (size_t)rt * 128 + wm * 64 + j * 32 + c.l31;
#pragma unroll
            for (int i = 0; i < 2; ++i)
#pragma unroll
                for (int q = 0; q < 4; ++q) {
                    const int n0 = nt * 128 + wn * 64 + i * 32 + 8 * q + 4 * c.hl;
                    const u32x2 g = *(const u32x2*)(MLOG + tok * 3072 + br * 1024 + n0);
                    y[i][j][4 * q + 0] += bflo(g[0]) * acc[i][j][4 * q + 0];
                    y[i][j][4 * q + 1] += bfhi(g[0]) * acc[i][j][4 * q + 1];
                    y[i][j][4 * q + 2] += bflo(g[1]) * acc[i][j][4 * q + 2];
                    y[i][j][4 * q + 3] += bfhi(g[1]) * acc[i][j][4 * q + 3];
                }
        }
    }
    bf16_t* Y = (bf16_t*)(c.ws + OFF_Y);
#pragma unroll
    for (int j = 0; j < 2; ++j) {
        const size_t tok = (size_t)rt * 128 + wm * 64 + j * 32 + c.l31;
#pragma unroll
        for (int i = 0; i < 2; ++i)
#pragma unroll
            for (int q = 0; q < 4; ++q) {
                const int n0 = nt * 128 + wn * 64 + i * 32 + 8 * q + 4 * c.hl;
                u32x2 ov; ov[0] = pk2(y[i][j][4 * q + 0], y[i][j][4 * q + 1]); ov[1] = pk2(y[i][j][4 * q + 2], y[i][j][4 * q + 3]);
                *(u32x2*)(Y + tok * 1024 + n0) = ov;
            }
    }
}
DI void po_item(const Ctx& c, int l, int rt2, int nt) {
    f32x16 acc[2][4];
    zero_acc2(acc);
    gemm_core2(c, (const bf16_t*)(c.ws + OFF_WO) + ((size_t)l * 1024 + (size_t)nt * 128) * 1024, 1024,
               (const bf16_t*)(c.ws + OFF_Y) + (size_t)rt2 * 256 * 1024, 1024, 1024, acc);
    const int wn = c.w >> 1, wm = c.w & 1;
    float* OUT = (float*)(c.ws + OFF_OUT);
#pragma unroll
    for (int j = 0; j < 4; ++j) {
        const size_t tok = (size_t)rt2 * 256 + wm * 128 + j * 32 + c.l31;
#pragma unroll
        for (int i = 0; i < 2; ++i)
#pragma unroll
            for (int q = 0; q < 4; ++q) {
                const int n0 = nt * 128 + wn * 64 + i * 32 + 8 * q + 4 * c.hl;
                f32x4 ov; ov[0] = acc[i][j][4 * q + 0]; ov[1] = acc[i][j][4 * q + 1]; ov[2] = acc[i][j][4 * q + 2]; ov[3] = acc[i][j][4 * q + 3];
                *(f32x4*)(OUT + tok * 1024 + n0) = ov;
            }
    }
}

extern __shared__ __attribute__((aligned(16))) unsigned char dynsmem[];
constexpr int LDS_BYTES = 72 * 1024;

DI Ctx mk_ctx(const Params& p, const float* cst, int wv) {
    Ctx c;
    c.x = p.in[0]; c.c = p.in[1]; c.ctx = p.in[2]; c.c_ctx = p.in[3]; c.w_mod = p.in[4]; c.b_mod = p.in[5]; c.g_pre = p.in[6]; c.g_post = p.in[7];
    c.w_in = p.in[8]; c.decay = p.in[9]; c.w_s = p.in[10]; c.b_s = p.in[11]; c.lq = p.in[12]; c.lk = p.in[13]; c.w_bo = p.in[14]; c.w_out = p.in[15];
    c.out = p.out; c.ws = p.ws; c.smem = dynsmem; c.cst = cst;
    unsigned zl = 0u;
    asm volatile("" : "+v"(zl));
    int tid = wv * 64 + (int)__builtin_amdgcn_mbcnt_hi(~0u, __builtin_amdgcn_mbcnt_lo(~0u, zl));
    asm volatile("" : "+v"(tid));
    size_t zoff = 0;
    asm volatile("" : "+s"(zoff));
    c.ws = p.ws + zoff;
    c.tid = tid; c.lane = tid & 63; c.w = tid >> 6; c.l31 = c.lane & 31; c.hl = c.lane >> 5;
    return c;
}
DI void relaunder(Ctx& c) {
    int t = c.tid;
    asm volatile("" : "+v"(t));
    c.tid = t; c.lane = t & 63; c.w = t >> 6; c.l31 = c.lane & 31; c.hl = c.lane >> 5;
}

__global__ void __launch_bounds__(256, 2) mega(Params p) {
    __shared__ uint4 xbw;
    __shared__ float cst[32];
    const int wv = __builtin_amdgcn_readfirstlane((int)threadIdx.x >> 6);
    Ctx c = mk_ctx(p, cst, wv);
    if (c.tid == 0) xbw = make_uint4(0u, 0u, 0u, 0u);
    if (c.tid < 64) {
        for (int l = 0; l < 2; ++l) {
            float a = c.lq[(l * 2 + 0) * 64 + c.tid] * c.lk[(l * 2 + 0) * 64 + c.tid];
            float b = c.lq[(l * 2 + 1) * 64 + c.tid] * c.lk[(l * 2 + 1) * 64 + c.tid];
            a = wave_sum(a); b = wave_sum(b);
            const float lam_init = 0.8f - 0.6f * expf(-0.3f * (float)l);
            if (c.tid == 0) { cst[l] = expf(a) - expf(b) + lam_init; cst[2 + l] = lam_init; }
        }
        if (c.tid < 16) {
            const float z = c.decay[c.tid];
            cst[4 + c.tid] = -log1pf(expf(-z)) * LOG2E;
        }
    }
    __syncthreads();
    XcdBarrier bar = xcd_barrier_post((unsigned*)(p.ws + OFF_BAR), (volatile LAS unsigned*)&xbw, c.tid == 0);
    const int G = gridDim.x, bid = blockIdx.x;
    constexpr int NPH = 2 + NGRP * 12;
#pragma unroll 1
    for (int ph = 0; ph < NPH; ++ph) {
        c = mk_ctx(p, cst, wv);
        int kind, g = 0, l = 0;
        if (ph == 0) kind = 0;
        else if (ph == 1) kind = 1;
        else { const int q = ph - 2; g = q / 12; const int r = q % 12; l = r / 6; kind = 2 + r % 6; }
#ifndef ECHO_KIND
#define ECHO_KIND -1
#endif
        const unsigned long long tph0 = (ECHO_KIND >= 0) ? __builtin_amdgcn_s_memrealtime() : 0ull;
        switch (kind) {
        case 0:
#pragma unroll 1
            for (int it = bid; it < 2 * 1408 + 192; it += G) { relaunder(c); p0_item(c, it); }
            break;
        case 1:
#pragma unroll 1
            for (int it = bid; it < NT / 4; it += G) { relaunder(c); ph_item(c, g, it); }
            break;
        case 2:
            if ((G & 7) == 0) {
                const int x = bid & 7, jl = bid >> 3, GL = G >> 3;
#pragma unroll 1
                for (int k = jl; k < 306; k += GL) {
                    int ct, rt2;
                    if (k < 288) { ct = 8 * (k & 7) + x; rt2 = k >> 3; }
                    else { ct = 64 + (x >> 1); rt2 = (x & 1) * 18 + (k - 288); }
                    if (l == 1 && (rt2 % 9) == 0 && ct >= 16) continue;
                    relaunder(c);
                    pz_item(c, l, rt2, ct);
                }
            } else {
#pragma unroll 1
                for (int it = bid; it < 36 * 68; it += G) {
                    const int ct = it % 68, rt2 = it / 68;
                    if (l == 1 && (rt2 % 9) == 0 && ct >= 16) continue;
                    relaunder(c);
                    pz_item(c, l, rt2, ct);
                }
            }
            break;
        case 3: {
            const int n_att = 512, n_catt = (l == 0) ? 64 : 0, n_scan = 128, n_mlp = (l == 0) ? 288 : 256;
            const int total = n_att + n_catt + n_scan + n_mlp;
#pragma unroll 1
            for (int it = bid; it < total; it += G) {
                int r = it;
                relaunder(c);
                if (r < n_att + n_catt) {
                    int bl, h, q0, nk;
                    if (r < n_att) { bl = r >> 7; h = (r >> 5) & 3; q0 = CTXL + (r & 31) * 64; nk = PP; }
                    else { r -= n_att; bl = r >> 4; h = (r >> 2) & 3; q0 = (r & 3) * 64; nk = CTXL; }
                    attn_item(c, l, bl, h, q0, nk);
                    continue;
                }
                r -= n_att + n_catt;
                if (r < n_scan) { const int bl = r >> 5, h = (r >> 3) & 3, dir = (r >> 2) & 1, es = r & 3; scan_item(c, l, bl, h, dir, es); continue; }
                r -= n_scan;
                int bl, m, gg;
                if (l == 0) { bl = r / 72; const int q = r % 72; m = q >> 2; gg = q & 3; }
                else { bl = r >> 6; const int q = r & 63; m = 2 + (q >> 2); gg = q & 3; }
                mlp_item(c, l, bl, m, gg);
            }
            break; }
        case 4: {
            const int total = (l == 0) ? 288 : 256;
#pragma unroll 1
            for (int it = bid; it < total; it += G) {
                int bl, m, h;
                if (l == 0) { bl = it / 72; const int q = it % 72; h = q & 3; m = q >> 2; }
                else { bl = it >> 6; const int q = it & 63; h = q & 3; m = 2 + (q >> 2); }
                relaunder(c);
                retout_item(c, l, bl, h, m);
            }
            break; }
        case 5: {
            const int nrt = (l == 0) ? 72 : 64;
#pragma unroll 1
            for (int it = bid; it < nrt * 8; it += G) {
                const int nt = it & 7, rr = it >> 3;
                const int rt = (l == 0) ? rr : (rr >> 4) * NCH + 2 + (rr & 15);
                relaunder(c);
                pm_item(c, l, rt, nt);
            }
            break; }
        case 6: {
            const int nrt = (l == 0) ? 72 : 64;
#pragma unroll 1
            for (int it = bid; it < (nrt / 2) * 8; it += G) {
                const int nt = it & 7, rr = it >> 3;
                const int rt2 = (l == 0) ? rr : (rr >> 3) * 9 + 1 + (rr & 7);
                relaunder(c);
                po_item(c, l, rt2, nt);
            }
            break; }
        default:
#pragma unroll 1
            for (int it = bid; it < NT / 4; it += G) { relaunder(c); pr_item(c, l, g, it); }
            if (g + 1 < NGRP && l == 1) {
#pragma unroll 1
                for (int it = bid; it < NT / 4; it += G) { relaunder(c); ph_item(c, g + 1, it); }
            }
            break;
        }
        if (ECHO_KIND >= 0 && kind == ECHO_KIND) { __syncthreads(); const unsigned long long tb = __builtin_amdgcn_s_memrealtime(), dt = tb - tph0; while (__builtin_amdgcn_s_memrealtime() - tb < dt) __builtin_amdgcn_s_sleep(8); }
        if (ph + 1 < NPH) xcd_barrier(bar, c.tid == 0);
    }
}

extern "C" void kernel_launch(void* const* d_in, const int* in_sizes, int n_in, void* d_out, int out_size, void* d_ws, size_t ws_size, hipStream_t stream) {
    static int grid = 0;
    if (grid == 0) {
        int dev = 0, cus = 0, per_cu = 0;
        hipGetDevice(&dev);
        hipDeviceGetAttribute(&cus, hipDeviceAttributeMultiprocessorCount, dev);
        hipFuncSetAttribute((const void*)mega, hipFuncAttributeMaxDynamicSharedMemorySize, LDS_BYTES);
        hipOccupancyMaxActiveBlocksPerMultiprocessor(&per_cu, (const void*)mega, 256, LDS_BYTES);
        if (per_cu > 2) per_cu = 2;
        if (per_cu < 1) per_cu = 1;
        grid = cus * per_cu;
        if (ws_size < WS_END) { fprintf(stderr, "workspace too small: %zu < %zu\n", ws_size, (size_t)WS_END); grid = -1; }
    }
    if (grid < 0) return;
    hipMemsetAsync((unsigned char*)d_ws + OFF_BAR, 0, XCD_BAR_WORDS * 4, stream);
    Params p{};
    for (int i = 0; i < 16; ++i) p.in[i] = (const float*)d_in[i];
    p.out = (float*)d_out; p.ws = (unsigned char*)d_ws;
    void* args[] = {&p};
    hipError_t e = hipLaunchCooperativeKernel((const void*)mega, dim3(grid), dim3(256), args, LDS_BYTES, stream);
    if (e != hipSuccess) fprintf(stderr, "cooperative launch failed: %s (grid %d)\n", hipGetErrorString(e), grid);
}
```

```cpp
#include <hip/hip_runtime.h>
#include <cstdio>
#include <cstdint>

#define DI __device__ __forceinline__
#define LAS __attribute__((address_space(3)))
typedef unsigned short bf16_t;
typedef short bf16x8 __attribute__((ext_vector_type(8)));
typedef float f32x16 __attribute__((ext_vector_type(16)));
typedef float f32x4 __attribute__((ext_vector_type(4)));
typedef float f32x2 __attribute__((ext_vector_type(2)));
typedef unsigned u32x4 __attribute__((ext_vector_type(4)));
typedef unsigned u32x2 __attribute__((ext_vector_type(2)));
#define MFMA(a, b, c) __builtin_amdgcn_mfma_f32_32x32x16_bf16((a), (b), (c), 0, 0, 0)

#define XB_TMO      128
#define XB_XCNT(j)  (256  + 64 * (j))
#define XB_XSUB(j)  (1280 + 64 * (j))
#define XB_XGEN(j)  (2304 + 64 * (j))
#define XB_TOP      3328
#define XB_TOPGEN   3392
#define XCD_BAR_WORDS 3456
#define XB_SPIN_CAP (1u << 22)
DI unsigned xb_ld(unsigned* p)              { return __hip_atomic_load(p, __ATOMIC_RELAXED, __HIP_MEMORY_SCOPE_AGENT); }
DI unsigned xb_add(unsigned* p, unsigned v) { return __hip_atomic_fetch_add(p, v, __ATOMIC_RELAXED, __HIP_MEMORY_SCOPE_AGENT); }
DI unsigned xb_xcc_id() { return (unsigned)__builtin_amdgcn_s_getreg((3 << 11) | 20) & 0xFu; }
#define XB_SPIN(cond, bar) do { unsigned _sp = 0; while (cond) { __builtin_amdgcn_s_sleep(1); \
    if ((++_sp & 255u) == 0u) { if (xb_ld(&(bar)[XB_TMO])) break; if (_sp > XB_SPIN_CAP) { atomicAdd(&(bar)[XB_TMO], 1u); break; } } } } while (0)
struct XcdBarrier { unsigned* bar; unsigned x; volatile LAS unsigned* st; };
DI XcdBarrier xcd_barrier_post(unsigned* bar, volatile LAS unsigned* st, bool t0) {
    XcdBarrier b; b.bar = bar; b.x = xb_xcc_id(); b.st = st;
    if (t0) (void)xb_add(&bar[XB_XCNT(b.x)], 1u);
    return b;
}
DI void xcd_barrier_complete(unsigned* bar, unsigned x, unsigned& nloc, unsigned& nx) {
    const unsigned G = gridDim.x * gridDim.y * gridDim.z;
    unsigned sum, cnt, mine, sp = 0u;
    for (;;) {
        sum = 0u; cnt = 0u; mine = 0u;
#pragma unroll
        for (unsigned j = 0; j < 16; ++j) { const unsigned c = xb_ld(&bar[XB_XCNT(j)]); sum += c; cnt += (c > 0u) ? 1u : 0u; mine = (j == x) ? c : mine; }
        if (sum == G) break;
        __builtin_amdgcn_s_sleep(1);
        if ((++sp & 255u) == 0u) { if (xb_ld(&bar[XB_TMO])) break; if (sp > XB_SPIN_CAP) { atomicAdd(&bar[XB_TMO], 1u); break; } }
    }
    nloc = mine > 0u ? mine : 1u; nx = cnt > 0u ? cnt : 1u;
}
DI void xcd_barrier(const XcdBarrier& b, bool t0) {
    asm volatile("s_waitcnt vmcnt(0)" ::: "memory");
    __syncthreads();
    if (t0) {
        unsigned* bar = b.bar;
        __builtin_amdgcn_s_waitcnt(0);
        unsigned nloc = b.st[0], nx = b.st[1];
        if (nloc == 0u) { xcd_barrier_complete(bar, b.x, nloc, nx); b.st[0] = nloc; b.st[1] = nx; }
        const unsigned old = xb_add(&bar[XB_XSUB(b.x)], 1u);
        const unsigned gen = old / nloc;
        if (old + 1u == (gen + 1u) * nloc) {
            __builtin_amdgcn_fence(__ATOMIC_RELEASE, "agent");
            asm volatile("s_waitcnt vmcnt(0)" ::: "memory");
            const unsigned og = xb_add(&bar[XB_TOP], 1u);
            const unsigned tg = og / nx;
            if (og + 1u == (tg + 1u) * nx) xb_add(&bar[XB_TOPGEN], 1u);
            else XB_SPIN(xb_ld(&bar[XB_TOPGEN]) == tg, bar);
            __builtin_amdgcn_fence(__ATOMIC_ACQUIRE, "agent");
            xb_add(&bar[XB_XGEN(b.x)], 1u);
            asm volatile("s_waitcnt vmcnt(0)" ::: "memory");
        } else {
            XB_SPIN(xb_ld(&bar[XB_XGEN(b.x)]) == gen, bar);
            __builtin_amdgcn_fence(__ATOMIC_ACQUIRE, "agent");
            asm volatile("s_waitcnt vmcnt(0)" ::: "memory");
        }
    }
    __syncthreads();
}

constexpr int DM = 1024, SEQL = 2048, CTXL = 256, PP = 2304  ;
constexpr int NBG = 4  , NGRP = 2, NT = NBG * PP  ;
constexpr int INC = 8704, NCH = 18  ;
constexpr int LDH = 1088, LDW = 1088;
constexpr float EPS = 1e-6f;
constexpr float LOG2E = 1.4426950408889634f;

constexpr size_t TB = (size_t)NT * 512 * 2;
constexpr size_t OFF_BAR = 0;
constexpr size_t OFF_MOD = 16384;
constexpr size_t OFF_WIN = OFF_MOD + 262144;
constexpr size_t OFF_WBO = OFF_WIN + (size_t)2 * INC * LDW * 2;
constexpr size_t OFF_WO  = OFF_WBO + (size_t)2 * 3 * 1024 * 512 * 2;
constexpr size_t OFF_H   = OFF_WO + (size_t)2 * 1024 * 1024 * 2;
constexpr size_t OFF_RK  = OFF_H + (size_t)NT * LDH * 2;
constexpr size_t OFF_RKT = OFF_RK + TB;
constexpr size_t OFF_RVT = OFF_RKT + TB;
constexpr size_t OFF_DK  = OFF_RVT + TB;
constexpr size_t OFF_DVT = OFF_DK + TB;
constexpr size_t OFF_RQ  = OFF_DVT + TB;
constexpr size_t OFF_RG  = OFF_RQ + TB;
constexpr size_t OFF_DQ  = OFF_RG + TB;
constexpr size_t OFF_DG  = OFF_DQ + TB;
constexpr size_t OFF_MU  = OFF_DG + TB;
constexpr size_t OFF_MV  = OFF_MU + TB;
constexpr size_t OFF_MG  = OFF_MV + TB;
constexpr size_t OFF_MLOG = OFF_MG + TB;
constexpr size_t OFF_OMLP = OFF_MLOG + 6 * TB;
constexpr size_t OFF_ODIFF = OFF_OMLP + TB;
constexpr size_t OFF_ROPE = OFF_ODIFF + TB;
constexpr size_t WS_END = OFF_ROPE + (size_t)2048 * 96 * 8;
constexpr size_t OFF_ST = OFF_H;
constexpr size_t OFF_ORET = OFF_DK;
constexpr size_t OFF_Y = OFF_RK;
constexpr size_t OFF_OUT = OFF_MLOG;

struct Params {
    const float* in[16];
    float* out;
    unsigned char* ws;
};

struct Ctx {
    const float *x, *c, *ctx, *c_ctx, *w_mod, *b_mod, *g_pre, *g_post, *w_in, *decay, *w_s, *b_s, *lq, *lk, *w_bo, *w_out;
    float* out;
    unsigned char* ws;
    unsigned char* smem;
    const float* cst;
    int tid, lane, w, l31, hl;
};

DI unsigned pk2(float lo, float hi) {
    typedef __bf16 b2 __attribute__((ext_vector_type(2)));
    f32x2 v = {lo, hi};
    b2 r = __builtin_convertvector(v, b2);
    return __builtin_bit_cast(unsigned, r);
}
DI bf16_t f2bf(float x) { return (bf16_t)(pk2(x, 0.f) & 0xffffu); }
DI float bflo(unsigned u) { return __uint_as_float(u << 16); }
DI float bfhi(unsigned u) { return __uint_as_float(u & 0xffff0000u); }
DI int crow(int r, int hl) { return (r & 3) + 8 * (r >> 2) + 4 * hl; }
DI float wave_sum(float v) {
#pragma unroll
    for (int o = 1; o < 64; o <<= 1) v += __shfl_xor(v, o);
    return v;
}
DI float fsig(float x) { return __builtin_amdgcn_rcpf(1.f + __builtin_amdgcn_exp2f(-LOG2E * x)); }
DI void sincos_rev(float rev, float& sn, float& cs) {
    const float g = __builtin_amdgcn_fractf(rev) - 0.5f;
    const bool fold = fabsf(g) > 0.25f;
    const float h = fold ? (copysignf(0.5f, g) - g) : g;
    const float x = h * 6.283185307179586f;
    const float x2 = x * x;
    const float sp = x * (1.f + x2 * (-1.6666667e-1f + x2 * (8.3333333e-3f + x2 * (-1.9841270e-4f + x2 * (2.7557319e-6f - x2 * 2.5052108e-8f)))));
    const float cp = 1.f + x2 * (-0.5f + x2 * (4.1666667e-2f + x2 * (-1.3888889e-3f + x2 * (2.4801587e-5f + x2 * (-2.7557319e-7f + x2 * 2.0876757e-9f)))));
    sn = -sp;
    cs = fold ? cp : -cp;
}
DI float silu_f(float x) { return x / (1.f + __expf(-x)); }
DI float sigmoid_f(float x) { return 1.f / (1.f + __expf(-x)); }

DI void gemm_core(const Ctx& c, const bf16_t* __restrict__ Wt, int ldw, const bf16_t* __restrict__ Act, int lda, int K, f32x16 (&acc)[2][2]) {
    bf16_t* Ws = (bf16_t*)c.smem;
    bf16_t* As = Ws + 128 * 72;
    const int wn = c.w >> 1, wm = c.w & 1;
    const int lrow = c.tid >> 3, lseg = c.tid & 7;
    u32x4 rw[4], ra[4];
#pragma unroll
    for (int it = 0; it < 4; ++it) {
        rw[it] = *(const u32x4*)(Wt + (size_t)(lrow + 32 * it) * ldw + lseg * 8);
        ra[it] = *(const u32x4*)(Act + (size_t)(lrow + 32 * it) * lda + lseg * 8);
    }
    for (int k0 = 0; k0 < K; k0 += 64) {
        __syncthreads();
#pragma unroll
        for (int it = 0; it < 4; ++it) {
            *(u32x4*)(Ws + (lrow + 32 * it) * 72 + lseg * 8) = rw[it];
            *(u32x4*)(As + (lrow + 32 * it) * 72 + lseg * 8) = ra[it];
        }
        __syncthreads();
        if (k0 + 64 < K) {
#pragma unroll
            for (int it = 0; it < 4; ++it) {
                rw[it] = *(const u32x4*)(Wt + (size_t)(lrow + 32 * it) * ldw + k0 + 64 + lseg * 8);
                ra[it] = *(const u32x4*)(Act + (size_t)(lrow + 32 * it) * lda + k0 + 64 + lseg * 8);
            }
        }
#pragma unroll
        for (int ks = 0; ks < 4; ++ks) {
            const bf16x8 a0 = *(const bf16x8*)(Ws + (wn * 64 + c.l31) * 72 + ks * 16 + c.hl * 8);
            const bf16x8 a1 = *(const bf16x8*)(Ws + (wn * 64 + 32 + c.l31) * 72 + ks * 16 + c.hl * 8);
            const bf16x8 b0 = *(const bf16x8*)(As + (wm * 64 + c.l31) * 72 + ks * 16 + c.hl * 8);
            const bf16x8 b1 = *(const bf16x8*)(As + (wm * 64 + 32 + c.l31) * 72 + ks * 16 + c.hl * 8);
            acc[0][0] = MFMA(a0, b0, acc[0][0]);
            acc[0][1] = MFMA(a0, b1, acc[0][1]);
            acc[1][0] = MFMA(a1, b0, acc[1][0]);
            acc[1][1] = MFMA(a1, b1, acc[1][1]);
        }
    }
}
DI void zero_acc(f32x16 (&acc)[2][2]) {
#pragma unroll
    for (int i = 0; i < 2; ++i)
#pragma unroll
        for (int j = 0; j < 2; ++j)
#pragma unroll
            for (int r = 0; r < 16; ++r) acc[i][j][r] = 0.f;
}


DI void gemm_core2(const Ctx& c, const bf16_t* __restrict__ Wt, int ldw, const bf16_t* __restrict__ Act, int lda, int K, f32x16 (&acc)[2][4]) {
    constexpr int RS = 32;
    constexpr int STG = 384 * RS;
    bf16_t* S = (bf16_t*)c.smem;
    const int wn = c.w >> 1, wm = c.w & 1;
    const int rsw = (c.l31 >> 2) & 3;
    const int ro = c.lane >> 2, lc = (c.lane & 3) ^ ((c.lane >> 4) & 3);
    const bf16_t* wsrc = Wt + (size_t)(c.w * 16 + ro) * ldw + lc * 8;
    const bf16_t* asrc = Act + (size_t)(c.w * 16 + ro) * lda + lc * 8;
#define G2_GLDS(SP, KOFF) { \
        _Pragma("unroll") for (int i = 0; i < 2; ++i) __builtin_amdgcn_global_load_lds((const unsigned*)(wsrc + (size_t)(64 * i) * ldw + (KOFF)), (unsigned*)((SP) + (c.w + 4 * i) * 512), 16, 0, 0); \
        _Pragma("unroll") for (int i = 0; i < 4; ++i) __builtin_amdgcn_global_load_lds((const unsigned*)(asrc + (size_t)(64 * i) * lda + (KOFF)), (unsigned*)((SP) + (8 + c.w + 4 * i) * 512), 16, 0, 0); }
    __syncthreads();
    G2_GLDS(S, 0)
    asm volatile("s_waitcnt vmcnt(0)" ::: "memory");
    __syncthreads();
    for (int k0 = 0; k0 < K; k0 += 32) {
        const int s = (k0 >> 5) & 1;
        bf16_t* Sc = S + s * STG;
        bf16_t* Sn = S + (s ^ 1) * STG;
        if (k0 + 32 < K) G2_GLDS(Sn, k0 + 32)
#pragma unroll
        for (int ks = 0; ks < 2; ++ks) {
            const int rcol = ((ks * 2 + c.hl) ^ rsw) * 8;
            bf16x8 a[2], b[4];
#pragma unroll
            for (int i = 0; i < 2; ++i) a[i] = *(const bf16x8*)(Sc + (wn * 64 + i * 32 + c.l31) * RS + rcol);
#pragma unroll
            for (int j = 0; j < 4; ++j) b[j] = *(const bf16x8*)(Sc + (128 + wm * 128 + j * 32 + c.l31) * RS + rcol);
#pragma unroll
            for (int i = 0; i < 2; ++i)
#pragma unroll
                for (int j = 0; j < 4; ++j) acc[i][j] = MFMA(a[i], b[j], acc[i][j]);
        }
        asm volatile("s_waitcnt vmcnt(0)" ::: "memory");
        __syncthreads();
    }
#undef G2_GLDS
}
DI void zero_acc2(f32x16 (&acc)[2][4]) {
#pragma unroll
    for (int i = 0; i < 2; ++i)
#pragma unroll
        for (int j = 0; j < 4; ++j)
#pragma unroll
            for (int r = 0; r < 16; ++r) acc[i][j][r] = 0.f;
}

DI void transpose_item(const Ctx& c, const float* __restrict__ src, int N, int k0, int n0, int mapk, bf16_t* __restrict__ dst, int ldk) {
    float* T = (float*)c.smem;
    __syncthreads();
    {
        f32x4 tv[8];
#pragma unroll
        for (int it = 0; it < 8; ++it) { const int idx = c.tid + 256 * it; tv[it] = *(const f32x4*)(src + (size_t)(k0 + (idx >> 5)) * N + n0 + (idx & 31) * 4); }
#pragma unroll
        for (int it = 0; it < 8; ++it) {
            const int idx = c.tid + 256 * it, r = idx >> 5, c4 = idx & 31;
            float* t = T + r * 129 + c4 * 4;
            t[0] = tv[it][0]; t[1] = tv[it][1]; t[2] = tv[it][2]; t[3] = tv[it][3];
        }
    }
    __syncthreads();
#pragma unroll
    for (int it = 0; it < 4; ++it) {
        const int idx = c.tid + 256 * it, np = idx >> 3, ch = idx & 7;
        int cs = np;
        if (mapk == 1) cs = (np >> 1) + 64 * (np & 1);
        else if (mapk == 2) { const int r = np & 63; cs = (np & 64) + (r >> 1) + 32 * (r & 1); }
        const float* t = T + (ch * 8) * 129 + cs;
        u32x4 o;
        o[0] = pk2(t[0], t[129]); o[1] = pk2(t[2 * 129], t[3 * 129]); o[2] = pk2(t[4 * 129], t[5 * 129]); o[3] = pk2(t[6 * 129], t[7 * 129]);
        *(u32x4*)(dst + (size_t)(n0 + np) * ldk + k0 + ch * 8) = o;
    }
}
DI void mod_item(const Ctx& c, int l, int jb) {
    float* sv = (float*)c.smem;
    float* red = sv + 9 * 1024;
    __syncthreads();
    for (int idx = c.tid; idx < 9216; idx += 256) {
        const int v = idx >> 10, k = idx & 1023;
        const float x = v < 8 ? c.c[v * 1024 + k] : c.c_ctx[k];
        sv[idx] = x / (1.f + expf(-x));
    }
    __syncthreads();
    const int kk = c.tid >> 5, jj = c.tid & 31, j = jb * 32 + jj;
    float a[9];
#pragma unroll
    for (int v = 0; v < 9; ++v) a[v] = 0.f;
    const float* wp = c.w_mod + (size_t)l * 1024 * 3072 + j;
#pragma unroll 4
    for (int i = 0; i < 128; ++i) {
        const int k = kk + 8 * i;
        const float wv = wp[(size_t)k * 3072];
#pragma unroll
        for (int v = 0; v < 9; ++v) a[v] += sv[v * 1024 + k] * wv;
    }
#pragma unroll
    for (int v = 0; v < 9; ++v) red[(kk * 9 + v) * 32 + jj] = a[v];
    __syncthreads();
    float* MOD = (float*)(c.ws + OFF_MOD);
    for (int idx = c.tid; idx < 288; idx += 256) {
        const int v = idx >> 5, j2 = idx & 31;
        float s = 0.f;
#pragma unroll
        for (int k2 = 0; k2 < 8; ++k2) s += red[(k2 * 9 + v) * 32 + j2];
        MOD[(size_t)(l * 9 + v) * 3072 + jb * 32 + j2] = s + c.b_mod[l * 3072 + jb * 32 + j2];
    }
}

DI void rope_item(const Ctx& c, int it) {
    constexpr float L2B = 13.287712379549449f;
    f32x2* T = (f32x2*)(c.ws + OFF_ROPE);
#pragma unroll 1
    for (int e = 0; e < 8; ++e) {
        const int idx = (it * 8 + e) * 256 + c.tid;
        const int lp = idx / 96, a = idx % 96;
        const float rowp = (float)(lp >> 6), colp = (float)(lp & 63);
        float ang;
        if (a < 64) { const int f = a & 31; ang = (a < 32 ? rowp : colp) * exp2f(-(float)f * (L2B / 32.f)); }
        else { const int a2 = a - 64, f = a2 & 15; ang = (a2 < 16 ? rowp : colp) * exp2f(-(float)f * (L2B / 16.f)); }
        f32x2 v; v[0] = cosf(ang); v[1] = sinf(ang);
        T[idx] = v;
    }
}
DI void p0_item(const Ctx& c, int it) {
    if (it < 2 * 1408) {
        const int l = it / 1408; int r = it % 1408;
        if (r < 1088) {
            const int ct = r % 68, kb = r / 68;
            const int kind = ct >> 2;
            const int mapk = (kind == 0 || kind == 4) ? 1 : ((kind == 2 || kind == 6) ? 2 : 0);
            transpose_item(c, c.w_in + (size_t)l * 1024 * INC, INC, kb * 64, ct * 128, mapk, (bf16_t*)(c.ws + OFF_WIN) + (size_t)l * INC * LDW, LDW);
            return;
        }
        r -= 1088;
        if (r < 192) {
            const int br = r / 64, q = r % 64, kb = q >> 3, nb = q & 7;
            transpose_item(c, c.w_bo + (size_t)(l * 3 + br) * 512 * 1024, 1024, kb * 64, nb * 128, 0,
                           (bf16_t*)(c.ws + OFF_WBO) + (size_t)(l * 3 + br) * 1024 * 512, 512);
            return;
        }
        r -= 192;
        { const int kb = r >> 3, nb = r & 7;
          transpose_item(c, c.w_out + (size_t)l * 1024 * 1024, 1024, kb * 64, nb * 128, 0, (bf16_t*)(c.ws + OFF_WO) + (size_t)l * 1024 * 1024, 1024); }
        return;
    }
    it -= 2 * 1408;
    mod_item(c, it / 96, it % 96);
}

DI void modulate_row(const f32x4 (&x)[4], const float* gpre, const float* mod  , bf16_t* hrow, int lane) {
    float ss = 0.f;
#pragma unroll
    for (int j = 0; j < 4; ++j) ss += x[j][0] * x[j][0] + x[j][1] * x[j][1] + x[j][2] * x[j][2] + x[j][3] * x[j][3];
    ss = wave_sum(ss);
    const float r = rsqrtf(ss * (1.f / 1024.f) + EPS);
    f32x4 gq[4], shq[4], scq[4];
#pragma unroll
    for (int j = 0; j < 4; ++j) { const int col = lane * 4 + 256 * j; gq[j] = *(const f32x4*)(gpre + col); shq[j] = *(const f32x4*)(mod + col); scq[j] = *(const f32x4*)(mod + 1024 + col); }
#pragma unroll
    for (int j = 0; j < 4; ++j) {
        const int col = lane * 4 + 256 * j;
        const f32x4 g = gq[j], sh = shq[j], sc = scq[j];
        f32x4 h;
#pragma unroll
        for (int e = 0; e < 4; ++e) h[e] = x[j][e] * r * g[e] * (1.f + sc[e]) + sh[e];
        u32x2 o; o[0] = pk2(h[0], h[1]); o[1] = pk2(h[2], h[3]);
        *(u32x2*)(hrow + col) = o;
    }
}
DI void ph_item(const Ctx& c, int g, int item) {
    const int tok = item * 4 + c.w, bl = tok / PP, p = tok % PP, b = g * NBG + bl;
    const float* src = p < CTXL ? c.ctx + ((size_t)b * CTXL + p) * DM : c.x + ((size_t)b * SEQL + (p - CTXL)) * DM;
    f32x4 x[4];
#pragma unroll
    for (int j = 0; j < 4; ++j) x[j] = *(const f32x4*)(src + c.lane * 4 + 256 * j);
    const float* mod = (const float*)(c.ws + OFF_MOD) + (size_t)(0 * 9 + (p < CTXL ? 8 : b)) * 3072;
    modulate_row(x, c.g_pre, mod, (bf16_t*)(c.ws + OFF_H) + (size_t)tok * LDH, c.lane);
}
DI void pr_item(const Ctx& c, int l, int g, int item) {
    const int tok = item * 4 + c.w, bl = tok / PP, p = tok % PP, b = g * NBG + bl;
    if (l == 1 && p < CTXL) return;
    const float* orow = (const float*)(c.ws + OFF_OUT) + (size_t)tok * DM;
    const int v = p < CTXL ? 8 : b;
    const float* mod = (const float*)(c.ws + OFF_MOD) + (size_t)(l * 9 + v) * 3072;
    float* xo_lat = c.out + ((size_t)b * SEQL + (p - CTXL)) * DM;
    const float* xold = p < CTXL ? c.ctx + ((size_t)b * CTXL + p) * DM : (l == 0 ? c.x + ((size_t)b * SEQL + (p - CTXL)) * DM : xo_lat);
    f32x4 o[4], gpq[4], gtq[4], xvq[4]; float ss = 0.f;
#pragma unroll
    for (int j = 0; j < 4; ++j) {
        const int col = c.lane * 4 + 256 * j;
        o[j] = *(const f32x4*)(orow + col); gpq[j] = *(const f32x4*)(c.g_post + l * 1024 + col); gtq[j] = *(const f32x4*)(mod + 2048 + col); xvq[j] = *(const f32x4*)(xold + col);
    }
#pragma unroll
    for (int j = 0; j < 4; ++j) ss += o[j][0] * o[j][0] + o[j][1] * o[j][1] + o[j][2] * o[j][2] + o[j][3] * o[j][3];
    ss = wave_sum(ss);
    const float r = rsqrtf(ss * (1.f / 1024.f) + EPS);
    f32x4 xn[4];
#pragma unroll
    for (int j = 0; j < 4; ++j) {
        const int col = c.lane * 4 + 256 * j;
        const f32x4 gp = gpq[j], gt = gtq[j], xv = xvq[j];
#pragma unroll
        for (int e = 0; e < 4; ++e) xn[j][e] = xv[e] + gt[e] * (o[j][e] * r * gp[e]);
        if (p >= CTXL) *(f32x4*)(xo_lat + col) = xn[j];
    }
    if (l == 0) {
        const float* mod1 = (const float*)(c.ws + OFF_MOD) + (size_t)(1 * 9 + v) * 3072;
        modulate_row(xn, c.g_pre + 1024, mod1, (bf16_t*)(c.ws + OFF_H) + (size_t)tok * LDH, c.lane);
    }
}

DI void pz_item(const Ctx& c, int l, int rt2, int ct) {
    f32x16 acc[2][4];
    zero_acc2(acc);
    gemm_core2(c, (const bf16_t*)(c.ws + OFF_WIN) + ((size_t)l * INC + (size_t)ct * 128) * LDW, LDW,
               (const bf16_t*)(c.ws + OFF_H) + (size_t)rt2 * 256 * LDH, LDH, 1024, acc);
    const int wn = c.w >> 1, wm = c.w & 1;
    const int bl = rt2 / 9, pt2 = rt2 % 9;
    const int kind = ct >> 2, h = ct & 3;
    const bool roped = (kind == 0 || kind == 4 || kind == 2 || kind == 6);
    const bool retk = (kind == 0 || kind == 4);
    bf16_t* E = (bf16_t*)c.smem;
    constexpr int ES = 136, ETS = 264;
    const float rsc = kind == 0 ? 0.08838834764831845f : (kind == 6 ? 0.125f * LOG2E : 1.f);
    const bool latent = pt2 > 0;
    const bool mulx = (kind == 5 || kind == 7 || kind == 10);
#define XF_PLAIN  { v0 *= rsc; v1 *= rsc; v2 *= rsc; v3 *= rsc; }
#define XF_SIG    { v0 = fsig(v0); v1 = fsig(v1); v2 = fsig(v2); v3 = fsig(v3); }
#define XF_SILU   { v0 *= fsig(v0); v1 *= fsig(v1); v2 *= fsig(v2); v3 *= fsig(v3); }
#define PZ_STAGE(PASS, XF) \
    _Pragma("unroll") for (int j = 0; j < 4; ++j) { \
        const int m = wm * 128 + j * 32 + c.l31; \
        _Pragma("unroll") for (int i = 0; i < 2; ++i) \
        _Pragma("unroll") for (int q = 0; q < 4; ++q) { \
            const int n0 = wn * 64 + i * 32 + 8 * q + 4 * c.hl; \
            float v0 = acc[i][j][4 * q + 0], v1 = acc[i][j][4 * q + 1], v2 = acc[i][j][4 * q + 2], v3 = acc[i][j][4 * q + 3]; \
            XF \
            if (PASS == 0) { \
                u32x2 o; o[0] = pk2(v0, v1); o[1] = pk2(v2, v3); \
                *(u32x2*)(E + m * ES + n0) = o; \
            } else { \
                E[(n0 + 0) * ETS + m] = f2bf(v0); E[(n0 + 1) * ETS + m] = f2bf(v1); E[(n0 + 2) * ETS + m] = f2bf(v2); E[(n0 + 3) * ETS + m] = f2bf(v3); \
            } \
        } \
    }
    const int cls = roped ? (latent ? 0 : 1) : (kind >= 11 ? 2 : (mulx ? 3 : 1));
    const int nfq = retk ? 32 : 16;
    const float fsc = retk ? (13.287712379549449f / 32.f) : (13.287712379549449f / 16.f);
    if (cls == 0) {
        const int lbase = pt2 * 256 + wm * 128 - CTXL;
        const float rowA = (float)(lbase >> 6), colA = (float)c.l31;
#pragma unroll
        for (int i = 0; i < 2; ++i) {
            const bool rowpart = retk ? (wn == 0) : (i == 0);
            const float posA = rowpart ? rowA : colA;
            const float posB = rowpart ? rowA + 1.f : colA + 32.f;
#pragma unroll
            for (int q = 0; q < 4; ++q) {
                const int n0 = wn * 64 + i * 32 + 8 * q + 4 * c.hl;
                const int c0 = retk ? (n0 >> 1) : ((n0 & 63) >> 1);
                const float iv0 = __builtin_amdgcn_exp2f(-(float)(c0 & (nfq - 1)) * fsc) * 0.15915494309189535f;
                const float iv1 = __builtin_amdgcn_exp2f(-(float)((c0 + 1) & (nfq - 1)) * fsc) * 0.15915494309189535f;
#define ROPE_APPLY(POS, JA, JB) { float s0, c0f, s1, c1f; sincos_rev((POS) * iv0, s0, c0f); sincos_rev((POS) * iv1, s1, c1f); \
                    { const float v0 = acc[i][JA][4 * q + 0], v1 = acc[i][JA][4 * q + 1], v2 = acc[i][JA][4 * q + 2], v3 = acc[i][JA][4 * q + 3]; \
                      acc[i][JA][4 * q + 0] = v0 * c0f - v1 * s0; acc[i][JA][4 * q + 1] = v0 * s0 + v1 * c0f; acc[i][JA][4 * q + 2] = v2 * c1f - v3 * s1; acc[i][JA][4 * q + 3] = v2 * s1 + v3 * c1f; } \
                    { const float v0 = acc[i][JB][4 * q + 0], v1 = acc[i][JB][4 * q + 1], v2 = acc[i][JB][4 * q + 2], v3 = acc[i][JB][4 * q + 3]; \
                      acc[i][JB][4 * q + 0] = v0 * c0f - v1 * s0; acc[i][JB][4 * q + 1] = v0 * s0 + v1 * c0f; acc[i][JB][4 * q + 2] = v2 * c1f - v3 * s1; acc[i][JB][4 * q + 3] = v2 * s1 + v3 * c1f; } }
                if (rowpart) { ROPE_APPLY(posA, 0, 1) ROPE_APPLY(posB, 2, 3) }
                else { ROPE_APPLY(posA, 0, 2) ROPE_APPLY(posB, 1, 3) }
#undef ROPE_APPLY
            }
        }
    }
    if (kind != 1 && kind != 3) {
        if (cls <= 1) { PZ_STAGE(0, XF_PLAIN) }
        else if (cls == 2) { PZ_STAGE(0, XF_SIG) }
        else { PZ_STAGE(0, XF_SILU) }
        __syncthreads();
        bf16_t* dst; size_t ld;
        if (kind >= 11) { dst = (bf16_t*)(c.ws + OFF_MLOG) + (size_t)(ct - 44) * 128; ld = 3072; }
        else {
            size_t off;
            switch (kind) { case 0: off = OFF_RK; break; case 2: off = OFF_DK; break; case 4: off = OFF_RQ; break; case 5: off = OFF_RG; break;
                            case 6: off = OFF_DQ; break; case 7: off = OFF_DG; break; case 8: off = OFF_MU; break; case 9: off = OFF_MV; break; default: off = OFF_MG; break; }
            dst = (bf16_t*)(c.ws + off) + h * 128; ld = 512;
        }
        dst += (size_t)rt2 * 256 * ld;
#pragma unroll 4
        for (int it = 0; it < 16; ++it) {
            const int id = c.tid + 256 * it, row = id >> 4, seg = id & 15;
            *(u32x4*)(dst + (size_t)row * ld + seg * 8) = *(const u32x4*)(E + row * ES + seg * 8);
        }
    }
    if (kind == 0 || kind == 1 || kind == 3) {
        if (kind == 0) __syncthreads();
        PZ_STAGE(1, XF_PLAIN)
        __syncthreads();
        const size_t off = kind == 0 ? OFF_RKT : (kind == 1 ? OFF_RVT : OFF_DVT);
        bf16_t* dst = (bf16_t*)(c.ws + off) + (size_t)(bl * 4 + h) * 128 * PP + pt2 * 256;
#pragma unroll 4
        for (int it = 0; it < 16; ++it) {
            const int id = c.tid + 256 * it, n = id >> 5, seg = id & 31;
            *(u32x4*)(dst + (size_t)n * PP + seg * 8) = *(const u32x4*)(E + n * ETS + seg * 8);
        }
    }
    __builtin_amdgcn_s_setprio(0);
#undef PZ_STAGE
#undef XF_PLAIN
#undef XF_SIG
#undef XF_SILU
}

DI void attn_item(const Ctx& c, int l, int bl, int h, int q0, int nk) {
    bf16_t* Ks = (bf16_t*)c.smem;
    bf16_t* Vs = Ks + 64 * 136;
    const int mp = c.w >> 1, qs = c.w & 1;
    const int qpos = q0 + qs * 32 + c.l31;
    const size_t qtok = (size_t)bl * PP + qpos;
    const bf16_t* DQ = (const bf16_t*)(c.ws + OFF_DQ);
    const bf16_t* DK = (const bf16_t*)(c.ws + OFF_DK) + (size_t)bl * PP * 512 + h * 128;
    const bf16_t* DVT = (const bf16_t*)(c.ws + OFF_DVT) + (size_t)(bl * 4 + h) * 128 * PP;
    bf16x8 qf[4];
#pragma unroll
    for (int ks = 0; ks < 4; ++ks) qf[ks] = *(const bf16x8*)(DQ + qtok * 512 + h * 128 + mp * 64 + ks * 16 + c.hl * 8);
    f32x16 o[4];
#pragma unroll
    for (int et = 0; et < 4; ++et)
#pragma unroll
        for (int r = 0; r < 16; ++r) o[et][r] = 0.f;
    float mrun = -1e30f, lrun = 0.f;
    u32x4 rk[4], rv[4];
    constexpr int BUF = 64 * 136 + 128 * 68;
#define AT_LOAD(KT0) { _Pragma("unroll") for (int it = 0; it < 4; ++it) { const int idx = c.tid + 256 * it; \
        rk[it] = *(const u32x4*)(DK + (size_t)((KT0) + (idx >> 4)) * 512 + (idx & 15) * 8); \
        rv[it] = *(const u32x4*)(DVT + (size_t)(idx >> 3) * PP + (KT0) + (idx & 7) * 8); } }
#define AT_STORE(BP) { _Pragma("unroll") for (int it = 0; it < 4; ++it) { const int idx = c.tid + 256 * it; \
        *(u32x4*)((BP) + (idx >> 4) * 136 + (idx & 15) * 8) = rk[it]; \
        u32x2 lo2, hi2; lo2[0] = rv[it][0]; lo2[1] = rv[it][1]; hi2[0] = rv[it][2]; hi2[1] = rv[it][3]; \
        *(u32x2*)((BP) + 64 * 136 + (idx >> 3) * 68 + (idx & 7) * 8) = lo2; *(u32x2*)((BP) + 64 * 136 + (idx >> 3) * 68 + (idx & 7) * 8 + 4) = hi2; } }
    AT_LOAD(0)
    __syncthreads();
    AT_STORE(Ks)
    if (64 < nk) AT_LOAD(64)
    __syncthreads();
    for (int kt0 = 0; kt0 < nk; kt0 += 64) {
        const int cb = (kt0 >> 6) & 1;
        const bf16_t* Kc = Ks + cb * BUF;
        const bf16_t* Vc = Kc + 64 * 136;
        if (kt0 + 64 < nk) {
            AT_STORE(Ks + (cb ^ 1) * BUF)
            if (kt0 + 128 < nk) AT_LOAD(kt0 + 128)
        }
        f32x16 s[2];
#pragma unroll
        for (int kt = 0; kt < 2; ++kt) {
#pragma unroll
            for (int r = 0; r < 16; ++r) s[kt][r] = 0.f;
#pragma unroll
            for (int ks = 0; ks < 4; ++ks) {
                const bf16x8 a = *(const bf16x8*)(Kc + (kt * 32 + c.l31) * 136 + mp * 64 + ks * 16 + c.hl * 8);
                s[kt] = MFMA(a, qf[ks], s[kt]);
            }
        }
        float mx = s[0][0];
#pragma unroll
        for (int r = 0; r < 16; ++r) { mx = fmaxf(mx, s[0][r]); mx = fmaxf(mx, s[1][r]); }
        mx = fmaxf(mx, __shfl_xor(mx, 32));
        const float mold = mrun;
        const float mnew = fmaxf(mrun, mx);
        const float alpha = __builtin_amdgcn_exp2f(mrun - mnew);
        mrun = mnew;
        float lsum = 0.f;
#pragma unroll
        for (int kt = 0; kt < 2; ++kt)
#pragma unroll
            for (int r = 0; r < 16; ++r) { const float pv = __builtin_amdgcn_exp2f(s[kt][r] - mnew); s[kt][r] = pv; lsum += pv; }
        lrun = lrun * alpha + lsum;
        if (__any(mx > mold)) {
#pragma unroll
            for (int et = 0; et < 4; ++et)
#pragma unroll
                for (int r = 0; r < 16; ++r) o[et][r] *= alpha;
        }
#pragma unroll
        for (int kt = 0; kt < 2; ++kt) {
#pragma unroll
            for (int st = 0; st < 2; ++st) {
                u32x4 pp;
                pp[0] = pk2(s[kt][8 * st + 0], s[kt][8 * st + 1]); pp[1] = pk2(s[kt][8 * st + 2], s[kt][8 * st + 3]);
                pp[2] = pk2(s[kt][8 * st + 4], s[kt][8 * st + 5]); pp[3] = pk2(s[kt][8 * st + 6], s[kt][8 * st + 7]);
                const bf16x8 pf = __builtin_bit_cast(bf16x8, pp);
#pragma unroll
                for (int et = 0; et < 4; ++et) {
                    const bf16_t* vp = Vc + (et * 32 + c.l31) * 68 + kt * 32 + 16 * st + 4 * c.hl;
                    const u32x2 lo = *(const u32x2*)vp, hi = *(const u32x2*)(vp + 8);
                    u32x4 av; av[0] = lo[0]; av[1] = lo[1]; av[2] = hi[0]; av[3] = hi[1];
                    o[et] = MFMA(__builtin_bit_cast(bf16x8, av), pf, o[et]);
                }
            }
        }
        __syncthreads();
    }
#undef AT_LOAD
#undef AT_STORE
    const float ltot = lrun + __shfl_xor(lrun, 32);
    const float linv = 1.f / ltot;
    float* Oc = (float*)c.smem;
    if (mp == 1) {
#pragma unroll
        for (int et = 0; et < 4; ++et)
#pragma unroll
            for (int r = 0; r < 16; ++r) Oc[(qs * 128 + et * 32 + crow(r, c.hl)) * 32 + c.l31] = o[et][r] * linv;
    }
    __syncthreads();
    if (mp == 0) {
        const float lam = c.cst[l], lam_init = c.cst[2 + l];
        float ss = 0.f;
#pragma unroll
        for (int et = 0; et < 4; ++et)
#pragma unroll
            for (int r = 0; r < 16; ++r) {
                const float d = o[et][r] * linv - lam * Oc[(qs * 128 + et * 32 + crow(r, c.hl)) * 32 + c.l31];
                o[et][r] = d; ss += d * d;
            }
        ss += __shfl_xor(ss, 32);
        const float rn = rsqrtf(ss * (1.f / 128.f) + EPS) * (1.f - lam_init);
        const bf16_t* DG = (const bf16_t*)(c.ws + OFF_DG) + qtok * 512 + h * 128;
        bf16_t* OD = (bf16_t*)(c.ws + OFF_ODIFF) + qtok * 512 + h * 128;
#pragma unroll
        for (int et = 0; et < 4; ++et)
#pragma unroll
            for (int q = 0; q < 4; ++q) {
                const int e0 = et * 32 + 8 * q + 4 * c.hl;
                const u32x2 g = *(const u32x2*)(DG + e0);
                u32x2 ov;
                ov[0] = pk2(o[et][4 * q + 0] * rn * bflo(g[0]), o[et][4 * q + 1] * rn * bfhi(g[0]));
                ov[1] = pk2(o[et][4 * q + 2] * rn * bflo(g[1]), o[et][4 * q + 3] * rn * bfhi(g[1]));
                *(u32x2*)(OD + e0) = ov;
            }
    }
}

DI void scan_item(const Ctx& c, int l, int bl, int h, int dir, int es) {
    const float lg2 = c.cst[4 + l * 8 + dir * 4 + h];
    const float decayC = __builtin_amdgcn_exp2f(lg2 * 128.f);
    f32x16 st;
#pragma unroll
    for (int r = 0; r < 16; ++r) st[r] = 0.f;
    const bf16_t* vt = (const bf16_t*)(c.ws + OFF_RVT) + ((size_t)(bl * 4 + h) * 128 + es * 32 + c.l31) * PP;
    const bf16_t* kt = (const bf16_t*)(c.ws + OFF_RKT) + ((size_t)(bl * 4 + h) * 128 + c.w * 32 + c.l31) * PP;
    bf16_t* stbase = (bf16_t*)(c.ws + OFF_ST) + (size_t)(((bl * 4 + h) * 2 + dir) * NCH) * 16384;
#pragma unroll 1
    for (int step = 0; step < NCH; ++step) {
        const int m = dir == 0 ? step : (step < 2 ? 1 - step : 19 - step);
        bf16_t* sp = stbase + (size_t)m * 16384;
#pragma unroll
        for (int r = 0; r < 16; ++r) sp[(es * 32 + crow(r, c.hl)) * 128 + c.w * 32 + c.l31] = f2bf(st[r]);
        if (step == NCH - 1) break;
#pragma unroll
        for (int r = 0; r < 16; ++r) st[r] *= decayC;
#pragma unroll
        for (int ks = 0; ks < 8; ++ks) {
            const int j0 = ks * 16 + c.hl * 8;
            const u32x4 av = *(const u32x4*)(vt + m * 128 + j0);
            const u32x4 bv = *(const u32x4*)(kt + m * 128 + j0);
            u32x4 as;
#pragma unroll
            for (int e = 0; e < 4; ++e) {
                const int ja = j0 + 2 * e;
                const float e0 = dir == 0 ? (float)(127 - ja) : (float)ja;
                const float e1 = dir == 0 ? (float)(126 - ja) : (float)(ja + 1);
                const float w0 = __builtin_amdgcn_exp2f(lg2 * e0), w1 = __builtin_amdgcn_exp2f(lg2 * e1);
                as[e] = pk2(bflo(av[e]) * w0, bfhi(av[e]) * w1);
            }
            st = MFMA(__builtin_bit_cast(bf16x8, as), __builtin_bit_cast(bf16x8, bv), st);
        }
    }
}

DI void mlp_item(const Ctx& c, int l, int bl, int m, int g) {
    bf16_t* Vn = (bf16_t*)c.smem;
    bf16_t* Wsm = Vn + 128 * 136;
    float* stat = (float*)(Wsm + 128 * 136);
    const size_t tok0 = (size_t)bl * PP + m * 128;
    const bf16_t* MV = (const bf16_t*)(c.ws + OFF_MV);
    __syncthreads();
#pragma unroll 1
    for (int rb = 0; rb < 4; ++rb) {
        u32x4 vv[8];
#pragma unroll
        for (int r8 = 0; r8 < 8; ++r8) vv[r8] = *(const u32x4*)(MV + (tok0 + c.w * 32 + rb * 8 + r8) * 512 + c.lane * 8);
#pragma unroll
        for (int r8 = 0; r8 < 8; ++r8) {
            const int row = c.w * 32 + rb * 8 + r8;
            float xv[8];
#pragma unroll
            for (int e = 0; e < 4; ++e) { xv[2 * e] = bflo(vv[r8][e]); xv[2 * e + 1] = bfhi(vv[r8][e]); }
            float sm = 0.f;
#pragma unroll
            for (int e = 0; e < 8; ++e) sm += xv[e];
            sm = wave_sum(sm);
            const float mu = sm * (1.f / 512.f);
            float ss = 0.f;
#pragma unroll
            for (int e = 0; e < 8; ++e) { const float d = xv[e] - mu; ss += d * d; }
            ss = wave_sum(ss);
            if (c.lane == 0) { stat[row] = mu; stat[128 + row] = rsqrtf(ss * (1.f / 512.f) + EPS); }
        }
    }
    __syncthreads();
    {
        u32x4 tv[8];
#pragma unroll
        for (int it = 0; it < 8; ++it) { const int idx = c.tid + 256 * it; tv[it] = *(const u32x4*)(MV + (tok0 + (idx >> 4)) * 512 + g * 128 + (idx & 15) * 8); }
#pragma unroll
        for (int it = 0; it < 8; ++it) {
            const int idx = c.tid + 256 * it, j = idx >> 4, seg = idx & 15;
            const float mu = stat[j], rs = stat[128 + j];
#pragma unroll
            for (int e = 0; e < 4; ++e) {
                Vn[(seg * 8 + 2 * e) * 136 + j] = f2bf((bflo(tv[it][e]) - mu) * rs);
                Vn[(seg * 8 + 2 * e + 1) * 136 + j] = f2bf((bfhi(tv[it][e]) - mu) * rs);
            }
        }
    }
    {
        const float* wsrc = c.w_s + (size_t)(l * 4 + g) * 128 * 128;
#pragma unroll 1
        for (int hb = 0; hb < 2; ++hb) {
            f32x4 wv[8];
#pragma unroll
            for (int it = 0; it < 8; ++it) { const int idx = c.tid + 256 * (hb * 8 + it); wv[it] = *(const f32x4*)(wsrc + (idx >> 5) * 128 + (idx & 31) * 4); }
#pragma unroll
            for (int it = 0; it < 8; ++it) {
                const int idx = c.tid + 256 * (hb * 8 + it);
                u32x2 o; o[0] = pk2(wv[it][0], wv[it][1]); o[1] = pk2(wv[it][2], wv[it][3]);
                *(u32x2*)(Wsm + (idx >> 5) * 136 + (idx & 31) * 4) = o;
            }
        }
    }
    __syncthreads();
    const int wc = c.w >> 1, wi = c.w & 1;
    f32x16 acc[2][2];
    zero_acc(acc);
#pragma unroll
    for (int ks = 0; ks < 8; ++ks) {
        const bf16x8 a0 = *(const bf16x8*)(Vn + (wc * 64 + c.l31) * 136 + ks * 16 + c.hl * 8);
        const bf16x8 a1 = *(const bf16x8*)(Vn + (wc * 64 + 32 + c.l31) * 136 + ks * 16 + c.hl * 8);
        const bf16x8 b0 = *(const bf16x8*)(Wsm + (wi * 64 + c.l31) * 136 + ks * 16 + c.hl * 8);
        const bf16x8 b1 = *(const bf16x8*)(Wsm + (wi * 64 + 32 + c.l31) * 136 + ks * 16 + c.hl * 8);
        acc[0][0] = MFMA(a0, b0, acc[0][0]); acc[0][1] = MFMA(a0, b1, acc[0][1]);
        acc[1][0] = MFMA(a1, b0, acc[1][0]); acc[1][1] = MFMA(a1, b1, acc[1][1]);
    }
    const bf16_t* MU = (const bf16_t*)(c.ws + OFF_MU);
    const bf16_t* MG = (const bf16_t*)(c.ws + OFF_MG);
    bf16_t* OM = (bf16_t*)(c.ws + OFF_OMLP);
    u32x2 uq[2][2][4], gq[2][2][4];
    float bsq[2];
#pragma unroll
    for (int ii = 0; ii < 2; ++ii) {
        const int i = wi * 64 + ii * 32 + c.l31;
        const size_t tok = tok0 + i;
        bsq[ii] = c.b_s[(l * 4 + g) * 128 + i];
#pragma unroll
        for (int ci = 0; ci < 2; ++ci)
#pragma unroll
            for (int q = 0; q < 4; ++q) {
                const int c0 = g * 128 + wc * 64 + ci * 32 + 8 * q + 4 * c.hl;
                uq[ii][ci][q] = *(const u32x2*)(MU + tok * 512 + c0); gq[ii][ci][q] = *(const u32x2*)(MG + tok * 512 + c0);
            }
    }
#pragma unroll
    for (int ii = 0; ii < 2; ++ii) {
        const int i = wi * 64 + ii * 32 + c.l31;
        const size_t tok = tok0 + i;
        const float bs = bsq[ii];
#pragma unroll
        for (int ci = 0; ci < 2; ++ci)
#pragma unroll
            for (int q = 0; q < 4; ++q) {
                const int c0 = g * 128 + wc * 64 + ci * 32 + 8 * q + 4 * c.hl;
                const u32x2 u = uq[ii][ci][q], gg = gq[ii][ci][q];
                u32x2 ov;
                ov[0] = pk2(bflo(u[0]) * (acc[ci][ii][4 * q + 0] + bs) * bflo(gg[0]), bfhi(u[0]) * (acc[ci][ii][4 * q + 1] + bs) * bfhi(gg[0]));
                ov[1] = pk2(bflo(u[1]) * (acc[ci][ii][4 * q + 2] + bs) * bflo(gg[1]), bfhi(u[1]) * (acc[ci][ii][4 * q + 3] + bs) * bfhi(gg[1]));
                *(u32x2*)(OM + tok * 512 + c0) = ov;
            }
    }
}

DI void retout_item(const Ctx& c, int l, int bl, int h, int m) {
    bf16_t* Ks = (bf16_t*)c.smem;
    bf16_t* Vs = Ks + 128 * 136;
    const size_t tok0 = (size_t)bl * PP + m * 128;
    const bf16_t* RK = (const bf16_t*)(c.ws + OFF_RK) + tok0 * 512 + h * 128;
    const bf16_t* RVT = (const bf16_t*)(c.ws + OFF_RVT) + (size_t)(bl * 4 + h) * 128 * PP + m * 128;
    __syncthreads();
    {
        u32x4 tk[8], tv[8];
#pragma unroll
        for (int it = 0; it < 8; ++it) {
            const int idx = c.tid + 256 * it, row = idx >> 4, seg = idx & 15;
            tk[it] = *(const u32x4*)(RK + (size_t)row * 512 + seg * 8);
            tv[it] = *(const u32x4*)(RVT + (size_t)row * PP + seg * 8);
        }
#pragma unroll
        for (int it = 0; it < 8; ++it) {
            const int idx = c.tid + 256 * it, row = idx >> 4, seg = idx & 15;
            *(u32x4*)(Ks + row * 136 + seg * 8) = tk[it];
            u32x2 lo2, hi2; lo2[0] = tv[it][0]; lo2[1] = tv[it][1]; hi2[0] = tv[it][2]; hi2[1] = tv[it][3];
            *(u32x2*)(Vs + row * 132 + seg * 8) = lo2; *(u32x2*)(Vs + row * 132 + seg * 8 + 4) = hi2;
        }
    }
    __syncthreads();
    const int i = c.w * 32 + c.l31;
    const size_t tok = tok0 + i;
    const float lgf = c.cst[4 + l * 8 + h], lgb = c.cst[4 + l * 8 + 4 + h];
    bf16x8 qf[8];
    const bf16_t* RQ = (const bf16_t*)(c.ws + OFF_RQ) + tok * 512 + h * 128;
#pragma unroll
    for (int ks = 0; ks < 8; ++ks) qf[ks] = *(const bf16x8*)(RQ + ks * 16 + c.hl * 8);
    f32x16 o[4];
    const bf16_t* stf = (const bf16_t*)(c.ws + OFF_ST) + (size_t)(((bl * 4 + h) * 2 + 0) * NCH + m) * 16384;
    const bf16_t* stb = (const bf16_t*)(c.ws + OFF_ST) + (size_t)(((bl * 4 + h) * 2 + 1) * NCH + m) * 16384;
    const float qdf = __builtin_amdgcn_exp2f(lgf * (float)(i + 1)), qdb = __builtin_amdgcn_exp2f(lgb * (float)(128 - i));
#pragma unroll
    for (int et = 0; et < 4; ++et) {
        f32x16 tf, tb;
#pragma unroll
        for (int r = 0; r < 16; ++r) { tf[r] = 0.f; tb[r] = 0.f; }
        bf16x8 sa[8], sb[8];
#pragma unroll
        for (int ks = 0; ks < 8; ++ks) {
            sa[ks] = *(const bf16x8*)(stf + (et * 32 + c.l31) * 128 + ks * 16 + c.hl * 8);
            sb[ks] = *(const bf16x8*)(stb + (et * 32 + c.l31) * 128 + ks * 16 + c.hl * 8);
        }
#pragma unroll
        for (int ks = 0; ks < 8; ++ks) {
            tf = MFMA(sa[ks], qf[ks], tf);
            tb = MFMA(sb[ks], qf[ks], tb);
        }
#pragma unroll
        for (int r = 0; r < 16; ++r) o[et][r] = tf[r] * qdf + tb[r] * qdb;
        __builtin_amdgcn_sched_barrier(0);
    }
#pragma unroll
    for (int jt = 0; jt < 4; ++jt) {
        f32x16 sc;
#pragma unroll
        for (int r = 0; r < 16; ++r) sc[r] = 0.f;
#pragma unroll
        for (int ks = 0; ks < 8; ++ks) {
            const bf16x8 a = *(const bf16x8*)(Ks + (jt * 32 + c.l31) * 136 + ks * 16 + c.hl * 8);
            sc = MFMA(a, qf[ks], sc);
        }
#pragma unroll
        for (int r = 0; r < 16; ++r) {
            const int j = jt * 32 + crow(r, c.hl);
            const int dl = i - j;
            const float arg = dl > 0 ? lgf * (float)dl : -lgb * (float)dl;
            float f = __builtin_amdgcn_exp2f(arg);
            f = dl == 0 ? 2.f : f;
            sc[r] *= f;
        }
#pragma unroll
        for (int s2 = 0; s2 < 2; ++s2) {
            u32x4 pp;
            pp[0] = pk2(sc[8 * s2 + 0], sc[8 * s2 + 1]); pp[1] = pk2(sc[8 * s2 + 2], sc[8 * s2 + 3]);
            pp[2] = pk2(sc[8 * s2 + 4], sc[8 * s2 + 5]); pp[3] = pk2(sc[8 * s2 + 6], sc[8 * s2 + 7]);
            const bf16x8 pf = __builtin_bit_cast(bf16x8, pp);
#pragma unroll
            for (int et = 0; et < 4; ++et) {
                const bf16_t* vp = Vs + (et * 32 + c.l31) * 132 + jt * 32 + 16 * s2 + 4 * c.hl;
                const u32x2 lo = *(const u32x2*)vp, hi = *(const u32x2*)(vp + 8);
                u32x4 av; av[0] = lo[0]; av[1] = lo[1]; av[2] = hi[0]; av[3] = hi[1];
                o[et] = MFMA(__builtin_bit_cast(bf16x8, av), pf, o[et]);
            }
        }
        __builtin_amdgcn_sched_barrier(0);
    }
    float ss = 0.f;
#pragma unroll
    for (int et = 0; et < 4; ++et)
#pragma unroll
        for (int r = 0; r < 16; ++r) ss += o[et][r] * o[et][r];
    ss += __shfl_xor(ss, 32);
    const float rn = rsqrtf(ss * (1.f / 128.f) + EPS);
    const bf16_t* RG = (const bf16_t*)(c.ws + OFF_RG) + tok * 512 + h * 128;
    bf16_t* OR = (bf16_t*)(c.ws + OFF_ORET) + tok * 512 + h * 128;
#pragma unroll
    for (int et = 0; et < 4; ++et)
#pragma unroll
        for (int q = 0; q < 4; ++q) {
            const int e0 = et * 32 + 8 * q + 4 * c.hl;
            const u32x2 g = *(const u32x2*)(RG + e0);
            u32x2 ov;
            ov[0] = pk2(o[et][4 * q + 0] * rn * bflo(g[0]), o[et][4 * q + 1] * rn * bfhi(g[0]));
            ov[1] = pk2(o[et][4 * q + 2] * rn * bflo(g[1]), o[et][4 * q + 3] * rn * bfhi(g[1]));
            *(u32x2*)(OR + e0) = ov;
        }
}

DI void pm_item(const Ctx& c, int l, int rt, int nt) {
    f32x16 y[2][2], acc[2][2];
    zero_acc(y);
    const int wn = c.w >> 1, wm = c.w & 1;
    const bf16_t* MLOG = (const bf16_t*)(c.ws + OFF_MLOG);
#pragma unroll 1
    for (int br = 0; br < 3; ++br) {
        const size_t ooff = br == 0 ? OFF_ORET : (br == 1 ? OFF_OMLP : OFF_ODIFF);
        zero_acc(acc);
        gemm_core(c, (const bf16_t*)(c.ws + OFF_WBO) + ((size_t)(l * 3 + br) * 1024 + (size_t)nt * 128) * 512, 512,
                  (const bf16_t*)(c.ws + ooff) + (size_t)rt * 128 * 512, 512, 512, acc);
#pragma unroll
        for (int j = 0; j < 2; ++j) {
            const size_t tok = (size_t)rt * 128 + wm * 64 + j * 32 + c.l31;
#pragma unroll
            for (int i = 0; i < 2; ++i)
#pragma unroll
                for (int q = 0; q < 4; ++q) {
                    const int n0 = nt * 128 + wn * 64 + i * 32 + 8 * q + 4 * c.hl;
                    const u32x2 g = *(const u32x2*)(MLOG + tok * 3072 + br * 1024 + n0);
                    y[i][j][4 * q + 0] += bflo(g[0]) * acc[i][j][4 * q + 0];
                    y[i][j][4 * q + 1] += bfhi(g[0]) * acc[i][j][4 * q + 1];
                    y[i][j][4 * q + 2] += bflo(g[1]) * acc[i][j][4 * q + 2];
                    y[i][j][4 * q + 3] += bfhi(g[1]) * acc[i][j][4 * q + 3];
                }
        }
    }
    bf16_t* Y = (bf16_t*)(c.ws + OFF_Y);
#pragma unroll
    for (int j = 0; j < 2; ++j) {
        const size_t tok = (size_t)rt * 128 + wm * 64 + j * 32 + c.l31;
#pragma unroll
        for (int i = 0; i < 2; ++i)
#pragma unroll
            for (int q = 0; q < 4; ++q) {
                const int n0 = nt * 128 + wn * 64 + i * 32 + 8 * q + 4 * c.hl;
                u32x2 ov; ov[0] = pk2(y[i][j][4 * q + 0], y[i][j][4 * q + 1]); ov[1] = pk2(y[i][j][4 * q + 2], y[i][j][4 * q + 3]);
                *(u32x2*)(Y + tok * 1024 + n0) = ov;
            }
    }
}
DI void po_item(const Ctx& c, int l, int rt2, int nt) {
    f32x16 acc[2][4];
    zero_acc2(acc);
    gemm_core2(c, (const bf16_t*)(c.ws + OFF_WO) + ((size_t)l * 1024 + (size_t)nt * 128) * 1024, 1024,
               (const bf16_t*)(c.ws + OFF_Y) + (size_t)rt2 * 256 * 1024, 1024, 1024, acc);
    const int wn = c.w >> 1, wm = c.w & 1;
    float* OUT = (float*)(c.ws + OFF_OUT);
#pragma unroll
    for (int j = 0; j < 4; ++j) {
        const size_t tok = (size_t)rt2 * 256 + wm * 128 + j * 32 + c.l31;
#pragma unroll
        for (int i = 0; i < 2; ++i)
#pragma unroll
            for (int q = 0; q < 4; ++q) {
                const int n0 = nt * 128 + wn * 64 + i * 32 + 8 * q + 4 * c.hl;
                f32x4 ov; ov[0] = acc[i][j][4 * q + 0]; ov[1] = acc[i][j][4 * q + 1]; ov[2] = acc[i][j][4 * q + 2]; ov[3] = acc[i][j][4 * q + 3];
                *(f32x4*)(OUT + tok * 1024 + n0) = ov;
            }
    }
}

extern __shared__ __attribute__((aligned(16))) unsigned char dynsmem[];
constexpr int LDS_BYTES = 72 * 1024;

DI Ctx mk_ctx(const Params& p, const float* cst, int wv) {
    Ctx c;
    c.x = p.in[0]; c.c = p.in[1]; c.ctx = p.in[2]; c.c_ctx = p.in[3]; c.w_mod = p.in[4]; c.b_mod = p.in[5]; c.g_pre = p.in[6]; c.g_post = p.in[7];
    c.w_in = p.in[8]; c.decay = p.in[9]; c.w_s = p.in[10]; c.b_s = p.in[11]; c.lq = p.in[12]; c.lk = p.in[13]; c.w_bo = p.in[14]; c.w_out = p.in[15];
    c.out = p.out; c.ws = p.ws; c.smem = dynsmem; c.cst = cst;
    unsigned zl = 0u;
    asm volatile("" : "+v"(zl));
    int tid = wv * 64 + (int)__builtin_amdgcn_mbcnt_hi(~0u, __builtin_amdgcn_mbcnt_lo(~0u, zl));
    asm volatile("" : "+v"(tid));
    size_t zoff = 0;
    asm volatile("" : "+s"(zoff));
    c.ws = p.ws + zoff;
    c.tid = tid; c.lane = tid & 63; c.w = tid >> 6; c.l31 = c.lane & 31; c.hl = c.lane >> 5;
    return c;
}
DI void relaunder(Ctx& c) {
    int t = c.tid;
    asm volatile("" : "+v"(t));
    c.tid = t; c.lane = t & 63; c.w = t >> 6; c.l31 = c.lane & 31; c.hl = c.lane >> 5;
}

__global__ void __launch_bounds__(256, 2) mega(Params p) {
    __shared__ uint4 xbw;
    __shared__ float cst[32];
    const int wv = __builtin_amdgcn_readfirstlane((int)threadIdx.x >> 6);
    Ctx c = mk_ctx(p, cst, wv);
    if (c.tid == 0) xbw = make_uint4(0u, 0u, 0u, 0u);
    if (c.tid < 64) {
        for (int l = 0; l < 2; ++l) {
            float a = c.lq[(l * 2 + 0) * 64 + c.tid] * c.lk[(l * 2 + 0) * 64 + c.tid];
            float b = c.lq[(l * 2 + 1) * 64 + c.tid] * c.lk[(l * 2 + 1) * 64 + c.tid];
            a = wave_sum(a); b = wave_sum(b);
            const float lam_init = 0.8f - 0.6f * expf(-0.3f * (float)l);
            if (c.tid == 0) { cst[l] = expf(a) - expf(b) + lam_init; cst[2 + l] = lam_init; }
        }
        if (c.tid < 16) {
            const float z = c.decay[c.tid];
            cst[4 + c.tid] = -log1pf(expf(-z)) * LOG2E;
        }
    }
    __syncthreads();
    XcdBarrier bar = xcd_barrier_post((unsigned*)(p.ws + OFF_BAR), (volatile LAS unsigned*)&xbw, c.tid == 0);
    const int G = gridDim.x, bid = blockIdx.x;
    constexpr int NPH = 2 + NGRP * 12;
#pragma unroll 1
    for (int ph = 0; ph < NPH; ++ph) {
        c = mk_ctx(p, cst, wv);
        int kind, g = 0, l = 0;
        if (ph == 0) kind = 0;
        else if (ph == 1) kind = 1;
        else { const int q = ph - 2; g = q / 12; const int r = q % 12; l = r / 6; kind = 2 + r % 6; }
#ifndef ECHO_KIND
#define ECHO_KIND -1
#endif
        const unsigned long long tph0 = (ECHO_KIND >= 0) ? __builtin_amdgcn_s_memrealtime() : 0ull;
        switch (kind) {
        case 0:
#pragma unroll 1
            for (int it = bid; it < 2 * 1408 + 192; it += G) { relaunder(c); p0_item(c, it); }
            break;
        case 1:
#pragma unroll 1
            for (int it = bid; it < NT / 4; it += G) { relaunder(c); ph_item(c, g, it); }
            break;
        case 2:
            if ((G & 7) == 0) {
                const int x = bid & 7, jl = bid >> 3, GL = G >> 3;
#pragma unroll 1
                for (int k = jl; k < 306; k += GL) {
                    int ct, rt2;
                    if (k < 288) { ct = 8 * (k & 7) + x; rt2 = k >> 3; }
                    else { ct = 64 + (x >> 1); rt2 = (x & 1) * 18 + (k - 288); }
                    if (l == 1 && (rt2 % 9) == 0 && ct >= 16) continue;
                    relaunder(c);
                    pz_item(c, l, rt2, ct);
                }
            } else {
#pragma unroll 1
                for (int it = bid; it < 36 * 68; it += G) {
                    const int ct = it % 68, rt2 = it / 68;
                    if (l == 1 && (rt2 % 9) == 0 && ct >= 16) continue;
                    relaunder(c);
                    pz_item(c, l, rt2, ct);
                }
            }
            break;
        case 3: {
            const int n_att = 512, n_catt = (l == 0) ? 64 : 0, n_scan = 128, n_mlp = (l == 0) ? 288 : 256;
            const int total = n_att + n_catt + n_scan + n_mlp;
#pragma unroll 1
            for (int it = bid; it < total; it += G) {
                int r = it;
                relaunder(c);
                if (r < n_att + n_catt) {
                    int bl, h, q0, nk;
                    if (r < n_att) {
                        int pr, qb;
                        if ((G & 7) == 0) { const int x = r & 7, k = r >> 3; pr = 2 * x + (k >> 5); qb = k & 31; } else { pr = r >> 5; qb = r & 31; }
                        bl = pr >> 2; h = pr & 3; q0 = CTXL + qb * 64; nk = PP;
                    }
                    else { r -= n_att; bl = r >> 4; h = (r >> 2) & 3; q0 = (r & 3) * 64; nk = CTXL; }
                    attn_item(c, l, bl, h, q0, nk);
                    continue;
                }
                r -= n_att + n_catt;
                if (r < n_scan) { const int bl = r >> 5, h = (r >> 3) & 3, dir = (r >> 2) & 1, es = r & 3; scan_item(c, l, bl, h, dir, es); continue; }
                r -= n_scan;
                int bl, m, gg;
                if (l == 0) { bl = r / 72; const int q = r % 72; m = q >> 2; gg = q & 3; }
                else { bl = r >> 6; const int q = r & 63; m = 2 + (q >> 2); gg = q & 3; }
                mlp_item(c, l, bl, m, gg);
            }
            break; }
        case 4: {
            const int total = (l == 0) ? 288 : 256;
#pragma unroll 1
            for (int it = bid; it < total; it += G) {
                int bl, m, h;
                if (l == 0) { bl = it / 72; const int q = it % 72; h = q & 3; m = q >> 2; }
                else { bl = it >> 6; const int q = it & 63; h = q & 3; m = 2 + (q >> 2); }
                relaunder(c);
                retout_item(c, l, bl, h, m);
            }
            break; }
        case 5: {
            const int nrt = (l == 0) ? 72 : 64;
#pragma unroll 1
            for (int it = bid; it < nrt * 8; it += G) {
                const int nt = it & 7, rr = it >> 3;
                const int rt = (l == 0) ? rr : (rr >> 4) * NCH + 2 + (rr & 15);
                relaunder(c);
                pm_item(c, l, rt, nt);
            }
            break; }
        case 6: {
            const int nrt = (l == 0) ? 72 : 64;
#pragma unroll 1
            for (int it = bid; it < (nrt / 2) * 8; it += G) {
                const int nt = it & 7, rr = it >> 3;
                const int rt2 = (l == 0) ? rr : (rr >> 3) * 9 + 1 + (rr & 7);
                relaunder(c);
                po_item(c, l, rt2, nt);
            }
            break; }
        default:
#pragma unroll 1
            for (int it = bid; it < NT / 4; it += G) { relaunder(c); pr_item(c, l, g, it); }
            if (g + 1 < NGRP && l == 1) {
#pragma unroll 1
                for (int it = bid; it < NT / 4; it += G) { relaunder(c); ph_item(c, g + 1, it); }
            }
            break;
        }
        if (ECHO_KIND >= 0 && kind == ECHO_KIND) { __syncthreads(); const unsigned long long tb = __builtin_amdgcn_s_memrealtime(), dt = tb - tph0; while (__builtin_amdgcn_s_memrealtime() - tb < dt) __builtin_amdgcn_s_sleep(8); }
        if (ph + 1 < NPH) xcd_barrier(bar, c.tid == 0);
    }
}

extern "C" void kernel_launch(void* const* d_in, const int* in_sizes, int n_in, void* d_out, int out_size, void* d_ws, size_t ws_size, hipStream_t stream) {
    static int grid = 0;
    if (grid == 0) {
        int dev = 0, cus = 0, per_cu = 0;
        hipGetDevice(&dev);
        hipDeviceGetAttribute(&cus, hipDeviceAttributeMultiprocessorCount, dev);
        hipFuncSetAttribute((const void*)mega, hipFuncAttributeMaxDynamicSharedMemorySize, LDS_BYTES);
        hipOccupancyMaxActiveBlocksPerMultiprocessor(&per_cu, (const void*)mega, 256, LDS_BYTES);
        if (per_cu > 2) per_cu = 2;
        if (per_cu < 1) per_cu = 1;
        grid = cus * per_cu;
        if (ws_size < WS_END) { fprintf(stderr, "workspace too small: %zu < %zu\n", ws_size, (size_t)WS_END); grid = -1; }
    }
    if (grid < 0) return;
    hipMemsetAsync((unsigned char*)d_ws + OFF_BAR, 0, XCD_BAR_WORDS * 4, stream);
    Params p{};
    for (int i = 0; i < 16; ++i) p.in[i] = (const float*)d_in[i];
    p.out = (float*)d_out; p.ws = (unsigned char*)d_ws;
    void* args[] = {&p};
    hipError_t e = hipLaunchCooperativeKernel((const void*)mega, dim3(grid), dim3(256), args, LDS_BYTES, stream);
    if (e != hipSuccess) fprintf(stderr, "cooperative launch failed: %s (grid %d)\n", hipGetErrorString(e), grid);
}
```

```cpp
#include <hip/hip_runtime.h>
#include <cstdio>
#include <cstdint>

#define DI __device__ __forceinline__
#define LAS __attribute__((address_space(3)))
typedef unsigned short bf16_t;
typedef short bf16x8 __attribute__((ext_vector_type(8)));
typedef float f32x16 __attribute__((ext_vector_type(16)));
typedef float f32x4 __attribute__((ext_vector_type(4)));
typedef float f32x2 __attribute__((ext_vector_type(2)));
typedef unsigned u32x4 __attribute__((ext_vector_type(4)));
typedef unsigned u32x2 __attribute__((ext_vector_type(2)));
#define MFMA(a, b, c) __builtin_amdgcn_mfma_f32_32x32x16_bf16((a), (b), (c), 0, 0, 0)

#define XB_TMO      128
#define XB_XCNT(j)  (256  + 64 * (j))
#define XB_XSUB(j)  (1280 + 64 * (j))
#define XB_XGEN(j)  (2304 + 64 * (j))
#define XB_TOP      3328
#define XB_TOPGEN   3392
#define XCD_BAR_WORDS 3456
#define XB_SPIN_CAP (1u << 22)
DI unsigned xb_ld(unsigned* p)              { return __hip_atomic_load(p, __ATOMIC_RELAXED, __HIP_MEMORY_SCOPE_AGENT); }
DI unsigned xb_add(unsigned* p, unsigned v) { return __hip_atomic_fetch_add(p, v, __ATOMIC_RELAXED, __HIP_MEMORY_SCOPE_AGENT); }
DI unsigned xb_xcc_id() { return (unsigned)__builtin_amdgcn_s_getreg((3 << 11) | 20) & 0xFu; }
#define XB_SPIN(cond, bar) do { unsigned _sp = 0; while (cond) { __builtin_amdgcn_s_sleep(1); \
    if ((++_sp & 255u) == 0u) { if (xb_ld(&(bar)[XB_TMO])) break; if (_sp > XB_SPIN_CAP) { atomicAdd(&(bar)[XB_TMO], 1u); break; } } } } while (0)
struct XcdBarrier { unsigned* bar; unsigned x; volatile LAS unsigned* st; };
DI XcdBarrier xcd_barrier_post(unsigned* bar, volatile LAS unsigned* st, bool t0) {
    XcdBarrier b; b.bar = bar; b.x = xb_xcc_id(); b.st = st;
    if (t0) (void)xb_add(&bar[XB_XCNT(b.x)], 1u);
    return b;
}
DI void xcd_barrier_complete(unsigned* bar, unsigned x, unsigned& nloc, unsigned& nx) {
    const unsigned G = gridDim.x * gridDim.y * gridDim.z;
    unsigned sum, cnt, mine, sp = 0u;
    for (;;) {
        sum = 0u; cnt = 0u; mine = 0u;
#pragma unroll
        for (unsigned j = 0; j < 16; ++j) { const unsigned c = xb_ld(&bar[XB_XCNT(j)]); sum += c; cnt += (c > 0u) ? 1u : 0u; mine = (j == x) ? c : mine; }
        if (sum == G) break;
        __builtin_amdgcn_s_sleep(1);
        if ((++sp & 255u) == 0u) { if (xb_ld(&bar[XB_TMO])) break; if (sp > XB_SPIN_CAP) { atomicAdd(&bar[XB_TMO], 1u); break; } }
    }
    nloc = mine > 0u ? mine : 1u; nx = cnt > 0u ? cnt : 1u;
}
DI void xcd_barrier(const XcdBarrier& b, bool t0) {
    asm volatile("s_waitcnt vmcnt(0)" ::: "memory");
    __syncthreads();
    if (t0) {
        unsigned* bar = b.bar;
        __builtin_amdgcn_s_waitcnt(0);
        unsigned nloc = b.st[0], nx = b.st[1];
        if (nloc == 0u) { xcd_barrier_complete(bar, b.x, nloc, nx); b.st[0] = nloc; b.st[1] = nx; }
        const unsigned old = xb_add(&bar[XB_XSUB(b.x)], 1u);
        const unsigned gen = old / nloc;
        if (old + 1u == (gen + 1u) * nloc) {
            __builtin_amdgcn_fence(__ATOMIC_RELEASE, "agent");
            asm volatile("s_waitcnt vmcnt(0)" ::: "memory");
            const unsigned og = xb_add(&bar[XB_TOP], 1u);
            const unsigned tg = og / nx;
            if (og + 1u == (tg + 1u) * nx) xb_add(&bar[XB_TOPGEN], 1u);
            else XB_SPIN(xb_ld(&bar[XB_TOPGEN]) == tg, bar);
            __builtin_amdgcn_fence(__ATOMIC_ACQUIRE, "agent");
            xb_add(&bar[XB_XGEN(b.x)], 1u);
            asm volatile("s_waitcnt vmcnt(0)" ::: "memory");
        } else {
            XB_SPIN(xb_ld(&bar[XB_XGEN(b.x)]) == gen, bar);
            __builtin_amdgcn_fence(__ATOMIC_ACQUIRE, "agent");
            asm volatile("s_waitcnt vmcnt(0)" ::: "memory");
        }
    }
    __syncthreads();
}

constexpr int DM = 1024, SEQL = 2048, CTXL = 256, PP = 2304  ;
constexpr int NBG = 4  , NGRP = 2, NT = NBG * PP  ;
constexpr int INC = 8704, NCH = 18  ;
constexpr int LDH = 1088, LDW = 1088;
constexpr float EPS = 1e-6f;
constexpr float LOG2E = 1.4426950408889634f;

constexpr size_t TB = (size_t)NT * 512 * 2;
constexpr size_t OFF_BAR = 0;
constexpr size_t OFF_MOD = 16384;
constexpr size_t OFF_WIN = OFF_MOD + 262144;
constexpr size_t OFF_WBO = OFF_WIN + (size_t)2 * INC * LDW * 2;
constexpr size_t OFF_WO  = OFF_WBO + (size_t)2 * 3 * 1024 * 512 * 2;
constexpr size_t OFF_H   = OFF_WO + (size_t)2 * 1024 * 1024 * 2;
constexpr size_t OFF_RK  = OFF_H + (size_t)NT * LDH * 2;
constexpr size_t OFF_RKT = OFF_RK + TB;
constexpr size_t OFF_RVT = OFF_RKT + TB;
constexpr size_t OFF_DK  = OFF_RVT + TB;
constexpr size_t OFF_DVT = OFF_DK + TB;
constexpr size_t OFF_RQ  = OFF_DVT + TB;
constexpr size_t OFF_RG  = OFF_RQ + TB;
constexpr size_t OFF_DQ  = OFF_RG + TB;
constexpr size_t OFF_DG  = OFF_DQ + TB;
constexpr size_t OFF_MU  = OFF_DG + TB;
constexpr size_t OFF_MV  = OFF_MU + TB;
constexpr size_t OFF_MG  = OFF_MV + TB;
constexpr size_t OFF_MLOG = OFF_MG + TB;
constexpr size_t OFF_OMLP = OFF_MLOG + 6 * TB;
constexpr size_t OFF_ODIFF = OFF_OMLP + TB;
constexpr size_t OFF_ROPE = OFF_ODIFF + TB;
constexpr size_t WS_END = OFF_ROPE + (size_t)2048 * 96 * 8;
constexpr size_t OFF_ST = OFF_H;
constexpr size_t OFF_ORET = OFF_DK;
constexpr size_t OFF_Y = OFF_RK;
constexpr size_t OFF_OUT = OFF_MLOG;

struct Params {
    const float* in[16];
    float* out;
    unsigned char* ws;
};

struct Ctx {
    const float *x, *c, *ctx, *c_ctx, *w_mod, *b_mod, *g_pre, *g_post, *w_in, *decay, *w_s, *b_s, *lq, *lk, *w_bo, *w_out;
    float* out;
    unsigned char* ws;
    unsigned char* smem;
    const float* cst;
    int tid, lane, w, l31, hl;
};

DI unsigned pk2(float lo, float hi) {
    typedef __bf16 b2 __attribute__((ext_vector_type(2)));
    f32x2 v = {lo, hi};
    b2 r = __builtin_convertvector(v, b2);
    return __builtin_bit_cast(unsigned, r);
}
DI bf16_t f2bf(float x) { return (bf16_t)(pk2(x, 0.f) & 0xffffu); }
DI float bflo(unsigned u) { return __uint_as_float(u << 16); }
DI float bfhi(unsigned u) { return __uint_as_float(u & 0xffff0000u); }
DI int crow(int r, int hl) { return (r & 3) + 8 * (r >> 2) + 4 * hl; }
DI float wave_sum(float v) {
#pragma unroll
    for (int o = 1; o < 64; o <<= 1) v += __shfl_xor(v, o);
    return v;
}
DI float fsig(float x) { return __builtin_amdgcn_rcpf(1.f + __builtin_amdgcn_exp2f(-LOG2E * x)); }
DI void sincos_rev(float rev, float& sn, float& cs) {
    const float g = __builtin_amdgcn_fractf(rev) - 0.5f;
    const bool fold = fabsf(g) > 0.25f;
    const float h = fold ? (copysignf(0.5f, g) - g) : g;
    const float x = h * 6.283185307179586f;
    const float x2 = x * x;
    const float sp = x * (1.f + x2 * (-1.6666667e-1f + x2 * (8.3333333e-3f + x2 * (-1.9841270e-4f + x2 * (2.7557319e-6f - x2 * 2.5052108e-8f)))));
    const float cp = 1.f + x2 * (-0.5f + x2 * (4.1666667e-2f + x2 * (-1.3888889e-3f + x2 * (2.4801587e-5f + x2 * (-2.7557319e-7f + x2 * 2.0876757e-9f)))));
    sn = -sp;
    cs = fold ? cp : -cp;
}
DI float silu_f(float x) { return x / (1.f + __expf(-x)); }
DI float sigmoid_f(float x) { return 1.f / (1.f + __expf(-x)); }

DI void gemm_core(const Ctx& c, const bf16_t* __restrict__ Wt, int ldw, const bf16_t* __restrict__ Act, int lda, int K, f32x16 (&acc)[2][2]) {
    bf16_t* Ws = (bf16_t*)c.smem;
    bf16_t* As = Ws + 128 * 72;
    const int wn = c.w >> 1, wm = c.w & 1;
    const int lrow = c.tid >> 3, lseg = c.tid & 7;
    u32x4 rw[4], ra[4];
#pragma unroll
    for (int it = 0; it < 4; ++it) {
        rw[it] = *(const u32x4*)(Wt + (size_t)(lrow + 32 * it) * ldw + lseg * 8);
        ra[it] = *(const u32x4*)(Act + (size_t)(lrow + 32 * it) * lda + lseg * 8);
    }
    for (int k0 = 0; k0 < K; k0 += 64) {
        __syncthreads();
#pragma unroll
        for (int it = 0; it < 4; ++it) {
            *(u32x4*)(Ws + (lrow + 32 * it) * 72 + lseg * 8) = rw[it];
            *(u32x4*)(As + (lrow + 32 * it) * 72 + lseg * 8) = ra[it];
        }
        __syncthreads();
        if (k0 + 64 < K) {
#pragma unroll
            for (int it = 0; it < 4; ++it) {
                rw[it] = *(const u32x4*)(Wt + (size_t)(lrow + 32 * it) * ldw + k0 + 64 + lseg * 8);
                ra[it] = *(const u32x4*)(Act + (size_t)(lrow + 32 * it) * lda + k0 + 64 + lseg * 8);
            }
        }
#pragma unroll
        for (int ks = 0; ks < 4; ++ks) {
            const bf16x8 a0 = *(const bf16x8*)(Ws + (wn * 64 + c.l31) * 72 + ks * 16 + c.hl * 8);
            const bf16x8 a1 = *(const bf16x8*)(Ws + (wn * 64 + 32 + c.l31) * 72 + ks * 16 + c.hl * 8);
            const bf16x8 b0 = *(const bf16x8*)(As + (wm * 64 + c.l31) * 72 + ks * 16 + c.hl * 8);
            const bf16x8 b1 = *(const bf16x8*)(As + (wm * 64 + 32 + c.l31) * 72 + ks * 16 + c.hl * 8);
            acc[0][0] = MFMA(a0, b0, acc[0][0]);
            acc[0][1] = MFMA(a0, b1, acc[0][1]);
            acc[1][0] = MFMA(a1, b0, acc[1][0]);
            acc[1][1] = MFMA(a1, b1, acc[1][1]);
        }
    }
}
DI void zero_acc(f32x16 (&acc)[2][2]) {
#pragma unroll
    for (int i = 0; i < 2; ++i)
#pragma unroll
        for (int j = 0; j < 2; ++j)
#pragma unroll
            for (int r = 0; r < 16; ++r) acc[i][j][r] = 0.f;
}


DI void gemm_core2(const Ctx& c, const bf16_t* __restrict__ Wt, int ldw, const bf16_t* __restrict__ Act, int lda, int K, f32x16 (&acc)[2][4]) {
    constexpr int RS = 32;
    constexpr int STG = 384 * RS;
    bf16_t* S = (bf16_t*)c.smem;
    const int wn = c.w >> 1, wm = c.w & 1;
    const int rsw = (c.l31 >> 2) & 3;
    const int ro = c.lane >> 2, lc = (c.lane & 3) ^ ((c.lane >> 4) & 3);
    const bf16_t* wsrc = Wt + (size_t)(c.w * 16 + ro) * ldw + lc * 8;
    const bf16_t* asrc = Act + (size_t)(c.w * 16 + ro) * lda + lc * 8;
#define G2_GLDS(SP, KOFF) { \
        _Pragma("unroll") for (int i = 0; i < 2; ++i) __builtin_amdgcn_global_load_lds((const unsigned*)(wsrc + (size_t)(64 * i) * ldw + (KOFF)), (unsigned*)((SP) + (c.w + 4 * i) * 512), 16, 0, 0); \
        _Pragma("unroll") for (int i = 0; i < 4; ++i) __builtin_amdgcn_global_load_lds((const unsigned*)(asrc + (size_t)(64 * i) * lda + (KOFF)), (unsigned*)((SP) + (8 + c.w + 4 * i) * 512), 16, 0, 0); }
    __syncthreads();
    G2_GLDS(S, 0)
    asm volatile("s_waitcnt vmcnt(0)" ::: "memory");
    __syncthreads();
    for (int k0 = 0; k0 < K; k0 += 32) {
        const int s = (k0 >> 5) & 1;
        bf16_t* Sc = S + s * STG;
        bf16_t* Sn = S + (s ^ 1) * STG;
        if (k0 + 32 < K) G2_GLDS(Sn, k0 + 32)
#pragma unroll
        for (int ks = 0; ks < 2; ++ks) {
            const int rcol = ((ks * 2 + c.hl) ^ rsw) * 8;
            bf16x8 a[2], b[4];
#pragma unroll
            for (int i = 0; i < 2; ++i) a[i] = *(const bf16x8*)(Sc + (wn * 64 + i * 32 + c.l31) * RS + rcol);
#pragma unroll
            for (int j = 0; j < 4; ++j) b[j] = *(const bf16x8*)(Sc + (128 + wm * 128 + j * 32 + c.l31) * RS + rcol);
#pragma unroll
            for (int i = 0; i < 2; ++i)
#pragma unroll
                for (int j = 0; j < 4; ++j) acc[i][j] = MFMA(a[i], b[j], acc[i][j]);
        }
        asm volatile("s_waitcnt vmcnt(0)" ::: "memory");
        __syncthreads();
    }
#undef G2_GLDS
}
DI void zero_acc2(f32x16 (&acc)[2][4]) {
#pragma unroll
    for (int i = 0; i < 2; ++i)
#pragma unroll
        for (int j = 0; j < 4; ++j)
#pragma unroll
            for (int r = 0; r < 16; ++r) acc[i][j][r] = 0.f;
}

DI void transpose_item(const Ctx& c, const float* __restrict__ src, int N, int k0, int n0, int mapk, bf16_t* __restrict__ dst, int ldk) {
    float* T = (float*)c.smem;
    __syncthreads();
    {
        f32x4 tv[8];
#pragma unroll
        for (int it = 0; it < 8; ++it) { const int idx = c.tid + 256 * it; tv[it] = *(const f32x4*)(src + (size_t)(k0 + (idx >> 5)) * N + n0 + (idx & 31) * 4); }
#pragma unroll
        for (int it = 0; it < 8; ++it) {
            const int idx = c.tid + 256 * it, r = idx >> 5, c4 = idx & 31;
            float* t = T + r * 129 + c4 * 4;
            t[0] = tv[it][0]; t[1] = tv[it][1]; t[2] = tv[it][2]; t[3] = tv[it][3];
        }
    }
    __syncthreads();
#pragma unroll
    for (int it = 0; it < 4; ++it) {
        const int idx = c.tid + 256 * it, np = idx >> 3, ch = idx & 7;
        int cs = np;
        if (mapk == 1) cs = (np >> 1) + 64 * (np & 1);
        else if (mapk == 2) { const int r = np & 63; cs = (np & 64) + (r >> 1) + 32 * (r & 1); }
        const float* t = T + (ch * 8) * 129 + cs;
        u32x4 o;
        o[0] = pk2(t[0], t[129]); o[1] = pk2(t[2 * 129], t[3 * 129]); o[2] = pk2(t[4 * 129], t[5 * 129]); o[3] = pk2(t[6 * 129], t[7 * 129]);
        *(u32x4*)(dst + (size_t)(n0 + np) * ldk + k0 + ch * 8) = o;
    }
}
DI void mod_item(const Ctx& c, int l, int jb) {
    float* sv = (float*)c.smem;
    float* red = sv + 9 * 1024;
    __syncthreads();
    for (int idx = c.tid; idx < 9216; idx += 256) {
        const int v = idx >> 10, k = idx & 1023;
        const float x = v < 8 ? c.c[v * 1024 + k] : c.c_ctx[k];
        sv[idx] = x / (1.f + expf(-x));
    }
    __syncthreads();
    const int kk = c.tid >> 5, jj = c.tid & 31, j = jb * 32 + jj;
    float a[9];
#pragma unroll
    for (int v = 0; v < 9; ++v) a[v] = 0.f;
    const float* wp = c.w_mod + (size_t)l * 1024 * 3072 + j;
#pragma unroll 4
    for (int i = 0; i < 128; ++i) {
        const int k = kk + 8 * i;
        const float wv = wp[(size_t)k * 3072];
#pragma unroll
        for (int v = 0; v < 9; ++v) a[v] += sv[v * 1024 + k] * wv;
    }
#pragma unroll
    for (int v = 0; v < 9; ++v) red[(kk * 9 + v) * 32 + jj] = a[v];
    __syncthreads();
    float* MOD = (float*)(c.ws + OFF_MOD);
    for (int idx = c.tid; idx < 288; idx += 256) {
        const int v = idx >> 5, j2 = idx & 31;
        float s = 0.f;
#pragma unroll
        for (int k2 = 0; k2 < 8; ++k2) s += red[(k2 * 9 + v) * 32 + j2];
        MOD[(size_t)(l * 9 + v) * 3072 + jb * 32 + j2] = s + c.b_mod[l * 3072 + jb * 32 + j2];
    }
}

DI void rope_item(const Ctx& c, int it) {
    constexpr float L2B = 13.287712379549449f;
    f32x2* T = (f32x2*)(c.ws + OFF_ROPE);
#pragma unroll 1
    for (int e = 0; e < 8; ++e) {
        const int idx = (it * 8 + e) * 256 + c.tid;
        const int lp = idx / 96, a = idx % 96;
        const float rowp = (float)(lp >> 6), colp = (float)(lp & 63);
        float ang;
        if (a < 64) { const int f = a & 31; ang = (a < 32 ? rowp : colp) * exp2f(-(float)f * (L2B / 32.f)); }
        else { const int a2 = a - 64, f = a2 & 15; ang = (a2 < 16 ? rowp : colp) * exp2f(-(float)f * (L2B / 16.f)); }
        f32x2 v; v[0] = cosf(ang); v[1] = sinf(ang);
        T[idx] = v;
    }
}
DI void p0_item(const Ctx& c, int it) {
    if (it < 2 * 1408) {
        const int l = it / 1408; int r = it % 1408;
        if (r < 1088) {
            const int ct = r % 68, kb = r / 68;
            const int kind = ct >> 2;
            const int mapk = (kind == 0 || kind == 4) ? 1 : ((kind == 2 || kind == 6) ? 2 : 0);
            transpose_item(c, c.w_in + (size_t)l * 1024 * INC, INC, kb * 64, ct * 128, mapk, (bf16_t*)(c.ws + OFF_WIN) + (size_t)l * INC * LDW, LDW);
            return;
        }
        r -= 1088;
        if (r < 192) {
            const int br = r / 64, q = r % 64, kb = q >> 3, nb = q & 7;
            transpose_item(c, c.w_bo + (size_t)(l * 3 + br) * 512 * 1024, 1024, kb * 64, nb * 128, 0,
                           (bf16_t*)(c.ws + OFF_WBO) + (size_t)(l * 3 + br) * 1024 * 512, 512);
            return;
        }
        r -= 192;
        { const int kb = r >> 3, nb = r & 7;
          transpose_item(c, c.w_out + (size_t)l * 1024 * 1024, 1024, kb * 64, nb * 128, 0, (bf16_t*)(c.ws + OFF_WO) + (size_t)l * 1024 * 1024, 1024); }
        return;
    }
    it -= 2 * 1408;
    mod_item(c, it / 96, it % 96);
}

DI void modulate_row(const f32x4 (&x)[4], const float* gpre, const float* mod  , bf16_t* hrow, int lane) {
    float ss = 0.f;
#pragma unroll
    for (int j = 0; j < 4; ++j) ss += x[j][0] * x[j][0] + x[j][1] * x[j][1] + x[j][2] * x[j][2] + x[j][3] * x[j][3];
    ss = wave_sum(ss);
    const float r = rsqrtf(ss * (1.f / 1024.f) + EPS);
    f32x4 gq[4], shq[4], scq[4];
#pragma unroll
    for (int j = 0; j < 4; ++j) { const int col = lane * 4 + 256 * j; gq[j] = *(const f32x4*)(gpre + col); shq[j] = *(const f32x4*)(mod + col); scq[j] = *(const f32x4*)(mod + 1024 + col); }
#pragma unroll
    for (int j = 0; j < 4; ++j) {
        const int col = lane * 4 + 256 * j;
        const f32x4 g = gq[j], sh = shq[j], sc = scq[j];
        f32x4 h;
#pragma unroll
        for (int e = 0; e < 4; ++e) h[e] = x[j][e] * r * g[e] * (1.f + sc[e]) + sh[e];
        u32x2 o; o[0] = pk2(h[0], h[1]); o[1] = pk2(h[2], h[3]);
        *(u32x2*)(hrow + col) = o;
    }
}
DI void ph_item(const Ctx& c, int g, int item) {
    const int tok = item * 4 + c.w, bl = tok / PP, p = tok % PP, b = g * NBG + bl;
    const float* src = p < CTXL ? c.ctx + ((size_t)b * CTXL + p) * DM : c.x + ((size_t)b * SEQL + (p - CTXL)) * DM;
    f32x4 x[4];
#pragma unroll
    for (int j = 0; j < 4; ++j) x[j] = *(const f32x4*)(src + c.lane * 4 + 256 * j);
    const float* mod = (const float*)(c.ws + OFF_MOD) + (size_t)(0 * 9 + (p < CTXL ? 8 : b)) * 3072;
    modulate_row(x, c.g_pre, mod, (bf16_t*)(c.ws + OFF_H) + (size_t)tok * LDH, c.lane);
}
DI void pr_item(const Ctx& c, int l, int g, int item) {
    const int tok = item * 4 + c.w, bl = tok / PP, p = tok % PP, b = g * NBG + bl;
    if (l == 1 && p < CTXL) return;
    const float* orow = (const float*)(c.ws + OFF_OUT) + (size_t)tok * DM;
    const int v = p < CTXL ? 8 : b;
    const float* mod = (const float*)(c.ws + OFF_MOD) + (size_t)(l * 9 + v) * 3072;
    float* xo_lat = c.out + ((size_t)b * SEQL + (p - CTXL)) * DM;
    const float* xold = p < CTXL ? c.ctx + ((size_t)b * CTXL + p) * DM : (l == 0 ? c.x + ((size_t)b * SEQL + (p - CTXL)) * DM : xo_lat);
    f32x4 o[4], gpq[4], gtq[4], xvq[4]; float ss = 0.f;
#pragma unroll
    for (int j = 0; j < 4; ++j) {
        const int col = c.lane * 4 + 256 * j;
        o[j] = *(const f32x4*)(orow + col); gpq[j] = *(const f32x4*)(c.g_post + l * 1024 + col); gtq[j] = *(const f32x4*)(mod + 2048 + col); xvq[j] = *(const f32x4*)(xold + col);
    }
#pragma unroll
    for (int j = 0; j < 4; ++j) ss += o[j][0] * o[j][0] + o[j][1] * o[j][1] + o[j][2] * o[j][2] + o[j][3] * o[j][3];
    ss = wave_sum(ss);
    const float r = rsqrtf(ss * (1.f / 1024.f) + EPS);
    f32x4 xn[4];
#pragma unroll
    for (int j = 0; j < 4; ++j) {
        const int col = c.lane * 4 + 256 * j;
        const f32x4 gp = gpq[j], gt = gtq[j], xv = xvq[j];
#pragma unroll
        for (int e = 0; e < 4; ++e) xn[j][e] = xv[e] + gt[e] * (o[j][e] * r * gp[e]);
        if (p >= CTXL) *(f32x4*)(xo_lat + col) = xn[j];
    }
    if (l == 0) {
        const float* mod1 = (const float*)(c.ws + OFF_MOD) + (size_t)(1 * 9 + v) * 3072;
        modulate_row(xn, c.g_pre + 1024, mod1, (bf16_t*)(c.ws + OFF_H) + (size_t)tok * LDH, c.lane);
    }
}

DI void pz_item(const Ctx& c, int l, int rt2, int ct) {
    f32x16 acc[2][4];
    zero_acc2(acc);
    gemm_core2(c, (const bf16_t*)(c.ws + OFF_WIN) + ((size_t)l * INC + (size_t)ct * 128) * LDW, LDW,
               (const bf16_t*)(c.ws + OFF_H) + (size_t)rt2 * 256 * LDH, LDH, 1024, acc);
    const int wn = c.w >> 1, wm = c.w & 1;
    const int bl = rt2 / 9, pt2 = rt2 % 9;
    const int kind = ct >> 2, h = ct & 3;
    const bool roped = (kind == 0 || kind == 4 || kind == 2 || kind == 6);
    const bool retk = (kind == 0 || kind == 4);
    bf16_t* E = (bf16_t*)c.smem;
    constexpr int ES = 136, ETS = 264;
    const float rsc = kind == 0 ? 0.08838834764831845f : (kind == 6 ? 0.125f * LOG2E : 1.f);
    const bool latent = pt2 > 0;
    const bool mulx = (kind == 5 || kind == 7 || kind == 10);
#define XF_PLAIN  { v0 *= rsc; v1 *= rsc; v2 *= rsc; v3 *= rsc; }
#define XF_SIG    { v0 = fsig(v0); v1 = fsig(v1); v2 = fsig(v2); v3 = fsig(v3); }
#define XF_SILU   { v0 *= fsig(v0); v1 *= fsig(v1); v2 *= fsig(v2); v3 *= fsig(v3); }
#define PZ_STAGE(PASS, XF) \
    _Pragma("unroll") for (int j = 0; j < 4; ++j) { \
        const int m = wm * 128 + j * 32 + c.l31; \
        _Pragma("unroll") for (int i = 0; i < 2; ++i) \
        _Pragma("unroll") for (int q = 0; q < 4; ++q) { \
            const int n0 = wn * 64 + i * 32 + 8 * q + 4 * c.hl; \
            float v0 = acc[i][j][4 * q + 0], v1 = acc[i][j][4 * q + 1], v2 = acc[i][j][4 * q + 2], v3 = acc[i][j][4 * q + 3]; \
            XF \
            if (PASS == 0) { \
                u32x2 o; o[0] = pk2(v0, v1); o[1] = pk2(v2, v3); \
                *(u32x2*)(E + m * ES + n0) = o; \
            } else { \
                E[(n0 + 0) * ETS + m] = f2bf(v0); E[(n0 + 1) * ETS + m] = f2bf(v1); E[(n0 + 2) * ETS + m] = f2bf(v2); E[(n0 + 3) * ETS + m] = f2bf(v3); \
            } \
        } \
    }
    const int cls = roped ? (latent ? 0 : 1) : (kind >= 11 ? 2 : (mulx ? 3 : 1));
    const int nfq = retk ? 32 : 16;
    const float fsc = retk ? (13.287712379549449f / 32.f) : (13.287712379549449f / 16.f);
    if (cls == 0) {
        const int lbase = pt2 * 256 + wm * 128 - CTXL;
        const float rowA = (float)(lbase >> 6), colA = (float)c.l31;
#pragma unroll
        for (int i = 0; i < 2; ++i) {
            const bool rowpart = retk ? (wn == 0) : (i == 0);
            const float posA = rowpart ? rowA : colA;
            const float posB = rowpart ? rowA + 1.f : colA + 32.f;
#pragma unroll
            for (int q = 0; q < 4; ++q) {
                const int n0 = wn * 64 + i * 32 + 8 * q + 4 * c.hl;
                const int c0 = retk ? (n0 >> 1) : ((n0 & 63) >> 1);
                const float iv0 = __builtin_amdgcn_exp2f(-(float)(c0 & (nfq - 1)) * fsc) * 0.15915494309189535f;
                const float iv1 = __builtin_amdgcn_exp2f(-(float)((c0 + 1) & (nfq - 1)) * fsc) * 0.15915494309189535f;
#define ROPE_APPLY(POS, JA, JB) { float s0, c0f, s1, c1f; sincos_rev((POS) * iv0, s0, c0f); sincos_rev((POS) * iv1, s1, c1f); \
                    { const float v0 = acc[i][JA][4 * q + 0], v1 = acc[i][JA][4 * q + 1], v2 = acc[i][JA][4 * q + 2], v3 = acc[i][JA][4 * q + 3]; \
                      acc[i][JA][4 * q + 0] = v0 * c0f - v1 * s0; acc[i][JA][4 * q + 1] = v0 * s0 + v1 * c0f; acc[i][JA][4 * q + 2] = v2 * c1f - v3 * s1; acc[i][JA][4 * q + 3] = v2 * s1 + v3 * c1f; } \
                    { const float v0 = acc[i][JB][4 * q + 0], v1 = acc[i][JB][4 * q + 1], v2 = acc[i][JB][4 * q + 2], v3 = acc[i][JB][4 * q + 3]; \
                      acc[i][JB][4 * q + 0] = v0 * c0f - v1 * s0; acc[i][JB][4 * q + 1] = v0 * s0 + v1 * c0f; acc[i][JB][4 * q + 2] = v2 * c1f - v3 * s1; acc[i][JB][4 * q + 3] = v2 * s1 + v3 * c1f; } }
                if (rowpart) { ROPE_APPLY(posA, 0, 1) ROPE_APPLY(posB, 2, 3) }
                else { ROPE_APPLY(posA, 0, 2) ROPE_APPLY(posB, 1, 3) }
#undef ROPE_APPLY
            }
        }
    }
    if (kind != 1 && kind != 3) {
        if (cls <= 1) { PZ_STAGE(0, XF_PLAIN) }
        else if (cls == 2) { PZ_STAGE(0, XF_SIG) }
        else { PZ_STAGE(0, XF_SILU) }
        __syncthreads();
        bf16_t* dst; size_t ld;
        if (kind >= 11) { dst = (bf16_t*)(c.ws + OFF_MLOG) + (size_t)(ct - 44) * 128; ld = 3072; }
        else {
            size_t off;
            switch (kind) { case 0: off = OFF_RK; break; case 2: off = OFF_DK; break; case 4: off = OFF_RQ; break; case 5: off = OFF_RG; break;
                            case 6: off = OFF_DQ; break; case 7: off = OFF_DG; break; case 8: off = OFF_MU; break; case 9: off = OFF_MV; break; default: off = OFF_MG; break; }
            dst = (bf16_t*)(c.ws + off) + h * 128; ld = 512;
        }
        dst += (size_t)rt2 * 256 * ld;
#pragma unroll 4
        for (int it = 0; it < 16; ++it) {
            const int id = c.tid + 256 * it, row = id >> 4, seg = id & 15;
            *(u32x4*)(dst + (size_t)row * ld + seg * 8) = *(const u32x4*)(E + row * ES + seg * 8);
        }
    }
    if (kind == 0 || kind == 1 || kind == 3) {
        if (kind == 0) __syncthreads();
        PZ_STAGE(1, XF_PLAIN)
        __syncthreads();
        const size_t off = kind == 0 ? OFF_RKT : (kind == 1 ? OFF_RVT : OFF_DVT);
        bf16_t* dst = (bf16_t*)(c.ws + off) + (size_t)(bl * 4 + h) * 128 * PP + pt2 * 256;
#pragma unroll 4
        for (int it = 0; it < 16; ++it) {
            const int id = c.tid + 256 * it, n = id >> 5, seg = id & 31;
            *(u32x4*)(dst + (size_t)n * PP + seg * 8) = *(const u32x4*)(E + n * ETS + seg * 8);
        }
    }
    __builtin_amdgcn_s_setprio(0);
#undef PZ_STAGE
#undef XF_PLAIN
#undef XF_SIG
#undef XF_SILU
}

DI void attn_item(const Ctx& c, int l, int bl, int h, int q0, int nk) {
    bf16_t* Ks = (bf16_t*)c.smem;
    bf16_t* Vs = Ks + 64 * 136;
    const int mp = c.w >> 1, qs = c.w & 1;
    const int qpos = q0 + qs * 32 + c.l31;
    const size_t qtok = (size_t)bl * PP + qpos;
    const bf16_t* DQ = (const bf16_t*)(c.ws + OFF_DQ);
    const bf16_t* DK = (const bf16_t*)(c.ws + OFF_DK) + (size_t)bl * PP * 512 + h * 128;
    const bf16_t* DVT = (const bf16_t*)(c.ws + OFF_DVT) + (size_t)(bl * 4 + h) * 128 * PP;
    bf16x8 qf[4];
#pragma unroll
    for (int ks = 0; ks < 4; ++ks) qf[ks] = *(const bf16x8*)(DQ + qtok * 512 + h * 128 + mp * 64 + ks * 16 + c.hl * 8);
    f32x16 o[4];
#pragma unroll
    for (int et = 0; et < 4; ++et)
#pragma unroll
        for (int r = 0; r < 16; ++r) o[et][r] = 0.f;
    float mrun = -1e30f, lrun = 0.f;
    u32x4 rk[4], rv[4];
    constexpr int BUF = 64 * 136 + 128 * 68;
#define AT_LOAD(KT0) { _Pragma("unroll") for (int it = 0; it < 4; ++it) { const int idx = c.tid + 256 * it; \
        rk[it] = *(const u32x4*)(DK + (size_t)((KT0) + (idx >> 4)) * 512 + (idx & 15) * 8); \
        rv[it] = *(const u32x4*)(DVT + (size_t)(idx >> 3) * PP + (KT0) + (idx & 7) * 8); } }
#define AT_STORE(BP) { _Pragma("unroll") for (int it = 0; it < 4; ++it) { const int idx = c.tid + 256 * it; \
        *(u32x4*)((BP) + (idx >> 4) * 136 + (idx & 15) * 8) = rk[it]; \
        u32x2 lo2, hi2; lo2[0] = rv[it][0]; lo2[1] = rv[it][1]; hi2[0] = rv[it][2]; hi2[1] = rv[it][3]; \
        *(u32x2*)((BP) + 64 * 136 + (idx >> 3) * 68 + (idx & 7) * 8) = lo2; *(u32x2*)((BP) + 64 * 136 + (idx >> 3) * 68 + (idx & 7) * 8 + 4) = hi2; } }
    AT_LOAD(0)
    __syncthreads();
    AT_STORE(Ks)
    if (64 < nk) AT_LOAD(64)
    __syncthreads();
    for (int kt0 = 0; kt0 < nk; kt0 += 64) {
        const int cb = (kt0 >> 6) & 1;
        const bf16_t* Kc = Ks + cb * BUF;
        const bf16_t* Vc = Kc + 64 * 136;
        if (kt0 + 64 < nk) {
            AT_STORE(Ks + (cb ^ 1) * BUF)
            if (kt0 + 128 < nk) AT_LOAD(kt0 + 128)
        }
        f32x16 s[2];
#pragma unroll
        for (int kt = 0; kt < 2; ++kt) {
#pragma unroll
            for (int r = 0; r < 16; ++r) s[kt][r] = 0.f;
#pragma unroll
            for (int ks = 0; ks < 4; ++ks) {
                const bf16x8 a = *(const bf16x8*)(Kc + (kt * 32 + c.l31) * 136 + mp * 64 + ks * 16 + c.hl * 8);
                s[kt] = MFMA(a, qf[ks], s[kt]);
            }
        }
        float mx = s[0][0];
#pragma unroll
        for (int r = 0; r < 16; ++r) { mx = fmaxf(mx, s[0][r]); mx = fmaxf(mx, s[1][r]); }
        mx = fmaxf(mx, __shfl_xor(mx, 32));
        const float mold = mrun;
        const float mnew = fmaxf(mrun, mx);
        const float alpha = __builtin_amdgcn_exp2f(mrun - mnew);
        mrun = mnew;
        float lsum = 0.f;
#pragma unroll
        for (int kt = 0; kt < 2; ++kt)
#pragma unroll
            for (int r = 0; r < 16; ++r) { const float pv = __builtin_amdgcn_exp2f(s[kt][r] - mnew); s[kt][r] = pv; lsum += pv; }
        lrun = lrun * alpha + lsum;
        if (__any(mx > mold)) {
#pragma unroll
            for (int et = 0; et < 4; ++et)
#pragma unroll
                for (int r = 0; r < 16; ++r) o[et][r] *= alpha;
        }
#pragma unroll
        for (int kt = 0; kt < 2; ++kt) {
#pragma unroll
            for (int st = 0; st < 2; ++st) {
                u32x4 pp;
                pp[0] = pk2(s[kt][8 * st + 0], s[kt][8 * st + 1]); pp[1] = pk2(s[kt][8 * st + 2], s[kt][8 * st + 3]);
                pp[2] = pk2(s[kt][8 * st + 4], s[kt][8 * st + 5]); pp[3] = pk2(s[kt][8 * st + 6], s[kt][8 * st + 7]);
                const bf16x8 pf = __builtin_bit_cast(bf16x8, pp);
#pragma unroll
                for (int et = 0; et < 4; ++et) {
                    const bf16_t* vp = Vc + (et * 32 + c.l31) * 68 + kt * 32 + 16 * st + 4 * c.hl;
                    const u32x2 lo = *(const u32x2*)vp, hi = *(const u32x2*)(vp + 8);
                    u32x4 av; av[0] = lo[0]; av[1] = lo[1]; av[2] = hi[0]; av[3] = hi[1];
                    o[et] = MFMA(__builtin_bit_cast(bf16x8, av), pf, o[et]);
                }
            }
        }
        __syncthreads();
    }
#undef AT_LOAD
#undef AT_STORE
    const float ltot = lrun + __shfl_xor(lrun, 32);
    const float linv = 1.f / ltot;
    float* Oc = (float*)c.smem;
    if (mp == 1) {
#pragma unroll
        for (int et = 0; et < 4; ++et)
#pragma unroll
            for (int r = 0; r < 16; ++r) Oc[(qs * 128 + et * 32 + crow(r, c.hl)) * 32 + c.l31] = o[et][r] * linv;
    }
    __syncthreads();
    if (mp == 0) {
        const float lam = c.cst[l], lam_init = c.cst[2 + l];
        float ss = 0.f;
#pragma unroll
        for (int et = 0; et < 4; ++et)
#pragma unroll
            for (int r = 0; r < 16; ++r) {
                const float d = o[et][r] * linv - lam * Oc[(qs * 128 + et * 32 + crow(r, c.hl)) * 32 + c.l31];
                o[et][r] = d; ss += d * d;
            }
        ss += __shfl_xor(ss, 32);
        const float rn = rsqrtf(ss * (1.f / 128.f) + EPS) * (1.f - lam_init);
        const bf16_t* DG = (const bf16_t*)(c.ws + OFF_DG) + qtok * 512 + h * 128;
        bf16_t* OD = (bf16_t*)(c.ws + OFF_ODIFF) + qtok * 512 + h * 128;
#pragma unroll
        for (int et = 0; et < 4; ++et)
#pragma unroll
            for (int q = 0; q < 4; ++q) {
                const int e0 = et * 32 + 8 * q + 4 * c.hl;
                const u32x2 g = *(const u32x2*)(DG + e0);
                u32x2 ov;
                ov[0] = pk2(o[et][4 * q + 0] * rn * bflo(g[0]), o[et][4 * q + 1] * rn * bfhi(g[0]));
                ov[1] = pk2(o[et][4 * q + 2] * rn * bflo(g[1]), o[et][4 * q + 3] * rn * bfhi(g[1]));
                *(u32x2*)(OD + e0) = ov;
            }
    }
}

DI void scan_item(const Ctx& c, int l, int bl, int h, int dir, int es) {
    const float lg2 = c.cst[4 + l * 8 + dir * 4 + h];
    const float decayC = __builtin_amdgcn_exp2f(lg2 * 128.f);
    f32x16 st;
#pragma unroll
    for (int r = 0; r < 16; ++r) st[r] = 0.f;
    const bf16_t* vt = (const bf16_t*)(c.ws + OFF_RVT) + ((size_t)(bl * 4 + h) * 128 + es * 32 + c.l31) * PP;
    const bf16_t* kt = (const bf16_t*)(c.ws + OFF_RKT) + ((size_t)(bl * 4 + h) * 128 + c.w * 32 + c.l31) * PP;
    bf16_t* stbase = (bf16_t*)(c.ws + OFF_ST) + (size_t)(((bl * 4 + h) * 2 + dir) * NCH) * 16384;
#pragma unroll 1
    for (int step = 0; step < NCH; ++step) {
        const int m = dir == 0 ? step : (step < 2 ? 1 - step : 19 - step);
        bf16_t* sp = stbase + (size_t)m * 16384;
#pragma unroll
        for (int r = 0; r < 16; ++r) sp[(es * 32 + crow(r, c.hl)) * 128 + c.w * 32 + c.l31] = f2bf(st[r]);
        if (step == NCH - 1) break;
#pragma unroll
        for (int r = 0; r < 16; ++r) st[r] *= decayC;
#pragma unroll
        for (int ks = 0; ks < 8; ++ks) {
            const int j0 = ks * 16 + c.hl * 8;
            const u32x4 av = *(const u32x4*)(vt + m * 128 + j0);
            const u32x4 bv = *(const u32x4*)(kt + m * 128 + j0);
            u32x4 as;
#pragma unroll
            for (int e = 0; e < 4; ++e) {
                const int ja = j0 + 2 * e;
                const float e0 = dir == 0 ? (float)(127 - ja) : (float)ja;
                const float e1 = dir == 0 ? (float)(126 - ja) : (float)(ja + 1);
                const float w0 = __builtin_amdgcn_exp2f(lg2 * e0), w1 = __builtin_amdgcn_exp2f(lg2 * e1);
                as[e] = pk2(bflo(av[e]) * w0, bfhi(av[e]) * w1);
            }
            st = MFMA(__builtin_bit_cast(bf16x8, as), __builtin_bit_cast(bf16x8, bv), st);
        }
    }
}

DI void mlp_item(const Ctx& c, int l, int bl, int m, int g) {
    bf16_t* Vn = (bf16_t*)c.smem;
    bf16_t* Wsm = Vn + 128 * 136;
    float* stat = (float*)(Wsm + 128 * 136);
    const size_t tok0 = (size_t)bl * PP + m * 128;
    const bf16_t* MV = (const bf16_t*)(c.ws + OFF_MV);
    __syncthreads();
#pragma unroll 1
    for (int rb = 0; rb < 4; ++rb) {
        u32x4 vv[8];
#pragma unroll
        for (int r8 = 0; r8 < 8; ++r8) vv[r8] = *(const u32x4*)(MV + (tok0 + c.w * 32 + rb * 8 + r8) * 512 + c.lane * 8);
#pragma unroll
        for (int r8 = 0; r8 < 8; ++r8) {
            const int row = c.w * 32 + rb * 8 + r8;
            float xv[8];
#pragma unroll
            for (int e = 0; e < 4; ++e) { xv[2 * e] = bflo(vv[r8][e]); xv[2 * e + 1] = bfhi(vv[r8][e]); }
            float sm = 0.f;
#pragma unroll
            for (int e = 0; e < 8; ++e) sm += xv[e];
            sm = wave_sum(sm);
            const float mu = sm * (1.f / 512.f);
            float ss = 0.f;
#pragma unroll
            for (int e = 0; e < 8; ++e) { const float d = xv[e] - mu; ss += d * d; }
            ss = wave_sum(ss);
            if (c.lane == 0) { stat[row] = mu; stat[128 + row] = rsqrtf(ss * (1.f / 512.f) + EPS); }
        }
    }
    __syncthreads();
    {
        u32x4 tv[8];
#pragma unroll
        for (int it = 0; it < 8; ++it) { const int idx = c.tid + 256 * it; tv[it] = *(const u32x4*)(MV + (tok0 + (idx >> 4)) * 512 + g * 128 + (idx & 15) * 8); }
#pragma unroll
        for (int it = 0; it < 8; ++it) {
            const int idx = c.tid + 256 * it, j = idx >> 4, seg = idx & 15;
            const float mu = stat[j], rs = stat[128 + j];
#pragma unroll
            for (int e = 0; e < 4; ++e) {
                Vn[(seg * 8 + 2 * e) * 136 + j] = f2bf((bflo(tv[it][e]) - mu) * rs);
                Vn[(seg * 8 + 2 * e + 1) * 136 + j] = f2bf((bfhi(tv[it][e]) - mu) * rs);
            }
        }
    }
    {
        const float* wsrc = c.w_s + (size_t)(l * 4 + g) * 128 * 128;
#pragma unroll 1
        for (int hb = 0; hb < 2; ++hb) {
            f32x4 wv[8];
#pragma unroll
            for (int it = 0; it < 8; ++it) { const int idx = c.tid + 256 * (hb * 8 + it); wv[it] = *(const f32x4*)(wsrc + (idx >> 5) * 128 + (idx & 31) * 4); }
#pragma unroll
            for (int it = 0; it < 8; ++it) {
                const int idx = c.tid + 256 * (hb * 8 + it);
                u32x2 o; o[0] = pk2(wv[it][0], wv[it][1]); o[1] = pk2(wv[it][2], wv[it][3]);
                *(u32x2*)(Wsm + (idx >> 5) * 136 + (idx & 31) * 4) = o;
            }
        }
    }
    __syncthreads();
    const int wc = c.w >> 1, wi = c.w & 1;
    f32x16 acc[2][2];
    zero_acc(acc);
#pragma unroll
    for (int ks = 0; ks < 8; ++ks) {
        const bf16x8 a0 = *(const bf16x8*)(Vn + (wc * 64 + c.l31) * 136 + ks * 16 + c.hl * 8);
        const bf16x8 a1 = *(const bf16x8*)(Vn + (wc * 64 + 32 + c.l31) * 136 + ks * 16 + c.hl * 8);
        const bf16x8 b0 = *(const bf16x8*)(Wsm + (wi * 64 + c.l31) * 136 + ks * 16 + c.hl * 8);
        const bf16x8 b1 = *(const bf16x8*)(Wsm + (wi * 64 + 32 + c.l31) * 136 + ks * 16 + c.hl * 8);
        acc[0][0] = MFMA(a0, b0, acc[0][0]); acc[0][1] = MFMA(a0, b1, acc[0][1]);
        acc[1][0] = MFMA(a1, b0, acc[1][0]); acc[1][1] = MFMA(a1, b1, acc[1][1]);
    }
    const bf16_t* MU = (const bf16_t*)(c.ws + OFF_MU);
    const bf16_t* MG = (const bf16_t*)(c.ws + OFF_MG);
    bf16_t* OM = (bf16_t*)(c.ws + OFF_OMLP);
    u32x2 uq[2][2][4], gq[2][2][4];
    float bsq[2];
#pragma unroll
    for (int ii = 0; ii < 2; ++ii) {
        const int i = wi * 64 + ii * 32 + c.l31;
        const size_t tok = tok0 + i;
        bsq[ii] = c.b_s[(l * 4 + g) * 128 + i];
#pragma unroll
        for (int ci = 0; ci < 2; ++ci)
#pragma unroll
            for (int q = 0; q < 4; ++q) {
                const int c0 = g * 128 + wc * 64 + ci * 32 + 8 * q + 4 * c.hl;
                uq[ii][ci][q] = *(const u32x2*)(MU + tok * 512 + c0); gq[ii][ci][q] = *(const u32x2*)(MG + tok * 512 + c0);
            }
    }
#pragma unroll
    for (int ii = 0; ii < 2; ++ii) {
        const int i = wi * 64 + ii * 32 + c.l31;
        const size_t tok = tok0 + i;
        const float bs = bsq[ii];
#pragma unroll
        for (int ci = 0; ci < 2; ++ci)
#pragma unroll
            for (int q = 0; q < 4; ++q) {
                const int c0 = g * 128 + wc * 64 + ci * 32 + 8 * q + 4 * c.hl;
                const u32x2 u = uq[ii][ci][q], gg = gq[ii][ci][q];
                u32x2 ov;
                ov[0] = pk2(bflo(u[0]) * (acc[ci][ii][4 * q + 0] + bs) * bflo(gg[0]), bfhi(u[0]) * (acc[ci][ii][4 * q + 1] + bs) * bfhi(gg[0]));
                ov[1] = pk2(bflo(u[1]) * (acc[ci][ii][4 * q + 2] + bs) * bflo(gg[1]), bfhi(u[1]) * (acc[ci][ii][4 * q + 3] + bs) * bfhi(gg[1]));
                *(u32x2*)(OM + tok * 512 + c0) = ov;
            }
    }
}

DI void retout_item(const Ctx& c, int l, int bl, int h, int m) {
    bf16_t* Ks = (bf16_t*)c.smem;
    bf16_t* Vs = Ks + 128 * 136;
    const size_t tok0 = (size_t)bl * PP + m * 128;
    const bf16_t* RK = (const bf16_t*)(c.ws + OFF_RK) + tok0 * 512 + h * 128;
    const bf16_t* RVT = (const bf16_t*)(c.ws + OFF_RVT) + (size_t)(bl * 4 + h) * 128 * PP + m * 128;
    __syncthreads();
    {
        u32x4 tk[8], tv[8];
#pragma unroll
        for (int it = 0; it < 8; ++it) {
            const int idx = c.tid + 256 * it, row = idx >> 4, seg = idx & 15;
            tk[it] = *(const u32x4*)(RK + (size_t)row * 512 + seg * 8);
            tv[it] = *(const u32x4*)(RVT + (size_t)row * PP + seg * 8);
        }
#pragma unroll
        for (int it = 0; it < 8; ++it) {
            const int idx = c.tid + 256 * it, row = idx >> 4, seg = idx & 15;
            *(u32x4*)(Ks + row * 136 + seg * 8) = tk[it];
            u32x2 lo2, hi2; lo2[0] = tv[it][0]; lo2[1] = tv[it][1]; hi2[0] = tv[it][2]; hi2[1] = tv[it][3];
            *(u32x2*)(Vs + row * 132 + seg * 8) = lo2; *(u32x2*)(Vs + row * 132 + seg * 8 + 4) = hi2;
        }
    }
    __syncthreads();
    const int i = c.w * 32 + c.l31;
    const size_t tok = tok0 + i;
    const float lgf = c.cst[4 + l * 8 + h], lgb = c.cst[4 + l * 8 + 4 + h];
    bf16x8 qf[8];
    const bf16_t* RQ = (const bf16_t*)(c.ws + OFF_RQ) + tok * 512 + h * 128;
#pragma unroll
    for (int ks = 0; ks < 8; ++ks) qf[ks] = *(const bf16x8*)(RQ + ks * 16 + c.hl * 8);
    f32x16 o[4];
    const bf16_t* stf = (const bf16_t*)(c.ws + OFF_ST) + (size_t)(((bl * 4 + h) * 2 + 0) * NCH + m) * 16384;
    const bf16_t* stb = (const bf16_t*)(c.ws + OFF_ST) + (size_t)(((bl * 4 + h) * 2 + 1) * NCH + m) * 16384;
    const float qdf = __builtin_amdgcn_exp2f(lgf * (float)(i + 1)), qdb = __builtin_amdgcn_exp2f(lgb * (float)(128 - i));
#pragma unroll
    for (int et = 0; et < 4; ++et) {
        f32x16 tf, tb;
#pragma unroll
        for (int r = 0; r < 16; ++r) { tf[r] = 0.f; tb[r] = 0.f; }
        bf16x8 sa[8], sb[8];
#pragma unroll
        for (int ks = 0; ks < 8; ++ks) {
            sa[ks] = *(const bf16x8*)(stf + (et * 32 + c.l31) * 128 + ks * 16 + c.hl * 8);
            sb[ks] = *(const bf16x8*)(stb + (et * 32 + c.l31) * 128 + ks * 16 + c.hl * 8);
        }
#pragma unroll
        for (int ks = 0; ks < 8; ++ks) {
            tf = MFMA(sa[ks], qf[ks], tf);
            tb = MFMA(sb[ks], qf[ks], tb);
        }
#pragma unroll
        for (int r = 0; r < 16; ++r) o[et][r] = tf[r] * qdf + tb[r] * qdb;
        __builtin_amdgcn_sched_barrier(0);
    }
#pragma unroll
    for (int jt = 0; jt < 4; ++jt) {
        f32x16 sc;
#pragma unroll
        for (int r = 0; r < 16; ++r) sc[r] = 0.f;
#pragma unroll
        for (int ks = 0; ks < 8; ++ks) {
            const bf16x8 a = *(const bf16x8*)(Ks + (jt * 32 + c.l31) * 136 + ks * 16 + c.hl * 8);
            sc = MFMA(a, qf[ks], sc);
        }
#pragma unroll
        for (int r = 0; r < 16; ++r) {
            const int j = jt * 32 + crow(r, c.hl);
            const int dl = i - j;
            const float arg = dl > 0 ? lgf * (float)dl : -lgb * (float)dl;
            float f = __builtin_amdgcn_exp2f(arg);
            f = dl == 0 ? 2.f : f;
            sc[r] *= f;
        }
#pragma unroll
        for (int s2 = 0; s2 < 2; ++s2) {
            u32x4 pp;
            pp[0] = pk2(sc[8 * s2 + 0], sc[8 * s2 + 1]); pp[1] = pk2(sc[8 * s2 + 2], sc[8 * s2 + 3]);
            pp[2] = pk2(sc[8 * s2 + 4], sc[8 * s2 + 5]); pp[3] = pk2(sc[8 * s2 + 6], sc[8 * s2 + 7]);
            const bf16x8 pf = __builtin_bit_cast(bf16x8, pp);
#pragma unroll
            for (int et = 0; et < 4; ++et) {
                const bf16_t* vp = Vs + (et * 32 + c.l31) * 132 + jt * 32 + 16 * s2 + 4 * c.hl;
                const u32x2 lo = *(const u32x2*)vp, hi = *(const u32x2*)(vp + 8);
                u32x4 av; av[0] = lo[0]; av[1] = lo[1]; av[2] = hi[0]; av[3] = hi[1];
                o[et] = MFMA(__builtin_bit_cast(bf16x8, av), pf, o[et]);
            }
        }
        __builtin_amdgcn_sched_barrier(0);
    }
    float ss = 0.f;
#pragma unroll
    for (int et = 0; et < 4; ++et)
#pragma unroll
        for (int r = 0; r < 16; ++r) ss += o[et][r] * o[et][r];
    ss += __shfl_xor(ss, 32);
    const float rn = rsqrtf(ss * (1.f / 128.f) + EPS);
    const bf16_t* RG = (const bf16_t*)(c.ws + OFF_RG) + tok * 512 + h * 128;
    bf16_t* OR = (bf16_t*)(c.ws + OFF_ORET) + tok * 512 + h * 128;
#pragma unroll
    for (int et = 0; et < 4; ++et)
#pragma unroll
        for (int q = 0; q < 4; ++q) {
            const int e0 = et * 32 + 8 * q + 4 * c.hl;
            const u32x2 g = *(const u32x2*)(RG + e0);
            u32x2 ov;
            ov[0] = pk2(o[et][4 * q + 0] * rn * bflo(g[0]), o[et][4 * q + 1] * rn * bfhi(g[0]));
            ov[1] = pk2(o[et][4 * q + 2] * rn * bflo(g[1]), o[et][4 * q + 3] * rn * bfhi(g[1]));
            *(u32x2*)(OR + e0) = ov;
        }
}

DI void pm_item(const Ctx& c, int l, int rt, int nt) {
    f32x16 y[2][2], acc[2][2];
    zero_acc(y);
    const int wn = c.w >> 1, wm = c.w & 1;
    const bf16_t* MLOG = (const bf16_t*)(c.ws + OFF_MLOG);
#pragma unroll 1
    for (int br = 0; br < 3; ++br) {
        const size_t ooff = br == 0 ? OFF_ORET : (br == 1 ? OFF_OMLP : OFF_ODIFF);
        zero_acc(acc);
        gemm_core(c, (const bf16_t*)(c.ws + OFF_WBO) + ((size_t)(l * 3 + br) * 1024 + (size_t)nt * 128) * 512, 512,
                  (const bf16_t*)(c.ws + ooff) + (size_t)rt * 128 * 512, 512, 512, acc);
#pragma unroll
        for (int j = 0; j < 2; ++j) {
            const size_t tok = (size_t)rt * 128 + wm * 64 + j * 32 + c.l31;
#pragma unroll
            for (int i = 0; i < 2; ++i)
#pragma unroll
                for (int q = 0; q < 4; ++q) {
                    const int n0 = nt * 128 + wn * 64 + i * 32 + 8 * q + 4 * c.hl;
                    const u32x2 g = *(const u32x2*)(MLOG + tok * 3072 + br * 1024 + n0);
                    y[i][j][4 * q + 0] += bflo(g[0]) * acc[i][j][4 * q + 0];
                    y[i][j][4 * q + 1] += bfhi(g[0]) * acc[i][j][4 * q + 1];
                    y[i][j][4 * q + 2] += bflo(g[1]) * acc[i][j][4 * q + 2];
                    y[i][j][4 * q + 3] += bfhi(g[1]) * acc[i][j][4 * q + 3];
                }
        }
    }
    bf16_t* Y = (bf16_t*)(c.ws + OFF_Y);
#pragma unroll
    for (int j = 0; j < 2; ++j) {
        const size_t tok = (size_t)rt * 128 + wm * 64 + j * 32 + c.l31;
#pragma unroll
        for (int i = 0; i < 2; ++i)
#pragma unroll
            for (int q = 0; q < 4; ++q) {
                const int n0 = nt * 128 + wn * 64 + i * 32 + 8 * q + 4 * c.hl;
                u32x2 ov; ov[0] = pk2(y[i][j][4 * q + 0], y[i][j][4 * q + 1]); ov[1] = pk2(y[i][j][4 * q + 2], y[i][j][4 * q + 3]);
                *(u32x2*)(Y + tok * 1024 + n0) = ov;
            }
    }
}
DI void po_item(const Ctx& c, int l, int rt2, int nt) {
    f32x16 acc[2][4];
    zero_acc2(acc);
    gemm_core2(c, (const bf16_t*)(c.ws + OFF_WO) + ((size_t)l * 1024 + (size_t)nt * 128) * 1024, 1024,
               (const bf16_t*)(c.ws + OFF_Y) + (size_t)rt2 * 256 * 1024, 1024, 1024, acc);
    const int wn = c.w >> 1, wm = c.w & 1;
    float* OUT = (float*)(c.ws + OFF_OUT);
#pragma unroll
    for (int j = 0; j < 4; ++j) {
        const size_t tok = (size_t)rt2 * 256 + wm * 128 + j * 32 + c.l31;
#pragma unroll
        for (int i = 0; i < 2; ++i)
#pragma unroll
            for (int q = 0; q < 4; ++q) {
                const int n0 = nt * 128 + wn * 64 + i * 32 + 8 * q + 4 * c.hl;
                f32x4 ov; ov[0] = acc[i][j][4 * q + 0]; ov[1] = acc[i][j][4 * q + 1]; ov[2] = acc[i][j][4 * q + 2]; ov[3] = acc[i][j][4 * q + 3];
                *(f32x4*)(OUT + tok * 1024 + n0) = ov;
            }
    }
}

extern __shared__ __attribute__((aligned(16))) unsigned char dynsmem[];
constexpr int LDS_BYTES = 72 * 1024;

DI Ctx mk_ctx(const Params& p, const float* cst, int wv) {
    Ctx c;
    c.x = p.in[0]; c.c = p.in[1]; c.ctx = p.in[2]; c.c_ctx = p.in[3]; c.w_mod = p.in[4]; c.b_mod = p.in[5]; c.g_pre = p.in[6]; c.g_post = p.in[7];
    c.w_in = p.in[8]; c.decay = p.in[9]; c.w_s = p.in[10]; c.b_s = p.in[11]; c.lq = p.in[12]; c.lk = p.in[13]; c.w_bo = p.in[14]; c.w_out = p.in[15];
    c.out = p.out; c.ws = p.ws; c.smem = dynsmem; c.cst = cst;
    unsigned zl = 0u;
    asm volatile("" : "+v"(zl));
    int tid = wv * 64 + (int)__builtin_amdgcn_mbcnt_hi(~0u, __builtin_amdgcn_mbcnt_lo(~0u, zl));
    asm volatile("" : "+v"(tid));
    size_t zoff = 0;
    asm volatile("" : "+s"(zoff));
    c.ws = p.ws + zoff;
    c.tid = tid; c.lane = tid & 63; c.w = tid >> 6; c.l31 = c.lane & 31; c.hl = c.lane >> 5;
    return c;
}
DI void relaunder(Ctx& c) {
    int t = c.tid;
    asm volatile("" : "+v"(t));
    c.tid = t; c.lane = t & 63; c.w = t >> 6; c.l31 = c.lane & 31; c.hl = c.lane >> 5;
}

__global__ void __launch_bounds__(256, 2) mega(Params p) {
    __shared__ uint4 xbw;
    __shared__ float cst[32];
    const int wv = __builtin_amdgcn_readfirstlane((int)threadIdx.x >> 6);
    Ctx c = mk_ctx(p, cst, wv);
    if (c.tid == 0) xbw = make_uint4(0u, 0u, 0u, 0u);
    if (c.tid < 64) {
        for (int l = 0; l < 2; ++l) {
            float a = c.lq[(l * 2 + 0) * 64 + c.tid] * c.lk[(l * 2 + 0) * 64 + c.tid];
            float b = c.lq[(l * 2 + 1) * 64 + c.tid] * c.lk[(l * 2 + 1) * 64 + c.tid];
            a = wave_sum(a); b = wave_sum(b);
            const float lam_init = 0.8f - 0.6f * expf(-0.3f * (float)l);
            if (c.tid == 0) { cst[l] = expf(a) - expf(b) + lam_init; cst[2 + l] = lam_init; }
        }
        if (c.tid < 16) {
            const float z = c.decay[c.tid];
            cst[4 + c.tid] = -log1pf(expf(-z)) * LOG2E;
        }
    }
    __syncthreads();
    XcdBarrier bar = xcd_barrier_post((unsigned*)(p.ws + OFF_BAR), (volatile LAS unsigned*)&xbw, c.tid == 0);
    const int G = gridDim.x, bid = blockIdx.x;
    constexpr int NPH = 2 + NGRP * 12;
#pragma unroll 1
    for (int ph = 0; ph < NPH; ++ph) {
        c = mk_ctx(p, cst, wv);
        int kind, g = 0, l = 0;
        if (ph == 0) kind = 0;
        else if (ph == 1) kind = 1;
        else { const int q = ph - 2; g = q / 12; const int r = q % 12; l = r / 6; kind = 2 + r % 6; }
#ifndef ECHO_KIND
#define ECHO_KIND -1
#endif
        const unsigned long long tph0 = (ECHO_KIND >= 0) ? __builtin_amdgcn_s_memrealtime() : 0ull;
        switch (kind) {
        case 0:
#pragma unroll 1
            for (int it = bid; it < 2 * 1408 + 192; it += G) { relaunder(c); p0_item(c, it); }
            break;
        case 1:
#pragma unroll 1
            for (int it = bid; it < NT / 4; it += G) { relaunder(c); ph_item(c, g, it); }
            break;
        case 2:
            if ((G & 7) == 0) {
                const int x = bid & 7, jl = bid >> 3, GL = G >> 3;
#pragma unroll 1
                for (int k = jl; k < 306; k += GL) {
                    int ct, rt2;
                    if (k < 288) { ct = 8 * (k & 7) + x; rt2 = k >> 3; }
                    else { ct = 64 + (x >> 1); rt2 = (x & 1) * 18 + (k - 288); }
                    if (l == 1 && (rt2 % 9) == 0 && ct >= 16) continue;
                    relaunder(c);
                    pz_item(c, l, rt2, ct);
                }
            } else {
#pragma unroll 1
                for (int it = bid; it < 36 * 68; it += G) {
                    const int ct = it % 68, rt2 = it / 68;
                    if (l == 1 && (rt2 % 9) == 0 && ct >= 16) continue;
                    relaunder(c);
                    pz_item(c, l, rt2, ct);
                }
            }
            break;
        case 3: {
            const int n_att = 512, n_catt = (l == 0) ? 64 : 0, n_scan = 128, n_mlp = (l == 0) ? 288 : 256;
            const int total = n_att + n_catt + n_scan + n_mlp;
#pragma unroll 1
            for (int it = bid; it < total; it += G) {
                int r = it;
                relaunder(c);
                if (r < n_att + n_catt) {
                    int bl, h, q0, nk;
                    if (r < n_att) {
                        int pr, qb;
                        if ((G & 7) == 0) { const int x = r & 7, k = r >> 3; pr = 2 * x + (k >> 5); qb = k & 31; } else { pr = r >> 5; qb = r & 31; }
                        bl = pr >> 2; h = pr & 3; q0 = CTXL + qb * 64; nk = PP;
                    }
                    else { r -= n_att; bl = r >> 4; h = (r >> 2) & 3; q0 = (r & 3) * 64; nk = CTXL; }
                    attn_item(c, l, bl, h, q0, nk);
                    continue;
                }
                r -= n_att + n_catt;
                if (r < n_scan) {
                    int pr, sub;
                    if ((G & 7) == 0) { const int x = r & 7, k = r >> 3; pr = 2 * x + (k >> 3); sub = k & 7; } else { pr = r >> 3; sub = r & 7; }
                    scan_item(c, l, pr >> 2, pr & 3, sub >> 2, sub & 3); continue;
                }
                r -= n_scan;
                int bl, m, gg;
                int grp;
                if ((G & 7) == 0) { const int x = r & 7, k = r >> 3; grp = x + 8 * (k >> 2); gg = k & 3; } else { grp = r >> 2; gg = r & 3; }
                if (l == 0) { bl = grp / 18; m = grp % 18; }
                else { bl = grp >> 4; m = 2 + (grp & 15); }
                mlp_item(c, l, bl, m, gg);
            }
            break; }
        case 4: {
            const int total = (l == 0) ? 288 : 256;
#pragma unroll 1
            for (int it = bid; it < total; it += G) {
                int bl, m, h;
                if (l == 0) { bl = it / 72; const int q = it % 72; h = q & 3; m = q >> 2; }
                else { bl = it >> 6; const int q = it & 63; h = q & 3; m = 2 + (q >> 2); }
                relaunder(c);
                retout_item(c, l, bl, h, m);
            }
            break; }
        case 5: {
            const int nrt = (l == 0) ? 72 : 64;
#pragma unroll 1
            for (int it = bid; it < nrt * 8; it += G) {
                const int nt = it & 7, rr = it >> 3;
                const int rt = (l == 0) ? rr : (rr >> 4) * NCH + 2 + (rr & 15);
                relaunder(c);
                pm_item(c, l, rt, nt);
            }
            break; }
        case 6: {
            const int nrt = (l == 0) ? 72 : 64;
#pragma unroll 1
            for (int it = bid; it < (nrt / 2) * 8; it += G) {
                const int nt = it & 7, rr = it >> 3;
                const int rt2 = (l == 0) ? rr : (rr >> 3) * 9 + 1 + (rr & 7);
                relaunder(c);
                po_item(c, l, rt2, nt);
            }
            break; }
        default:
#pragma unroll 1
            for (int it = bid; it < NT / 4; it += G) { relaunder(c); pr_item(c, l, g, it); }
            if (g + 1 < NGRP && l == 1) {
#pragma unroll 1
                for (int it = bid; it < NT / 4; it += G) { relaunder(c); ph_item(c, g + 1, it); }
            }
            break;
        }
        if (ECHO_KIND >= 0 && kind == ECHO_KIND) { __syncthreads(); const unsigned long long tb = __builtin_amdgcn_s_memrealtime(), dt = tb - tph0; while (__builtin_amdgcn_s_memrealtime() - tb < dt) __builtin_amdgcn_s_sleep(8); }
        if (ph + 1 < NPH) xcd_barrier(bar, c.tid == 0);
    }
}

extern "C" void kernel_launch(void* const* d_in, const int* in_sizes, int n_in, void* d_out, int out_size, void* d_ws, size_t ws_size, hipStream_t stream) {
    static int grid = 0;
    if (grid == 0) {
        int dev = 0, cus = 0, per_cu = 0;
        hipGetDevice(&dev);
        hipDeviceGetAttribute(&cus, hipDeviceAttributeMultiprocessorCount, dev);
        hipFuncSetAttribute((const void*)mega, hipFuncAttributeMaxDynamicSharedMemorySize, LDS_BYTES);
        hipOccupancyMaxActiveBlocksPerMultiprocessor(&per_cu, (const void*)mega, 256, LDS_BYTES);
        if (per_cu > 2) per_cu = 2;
        if (per_cu < 1) per_cu = 1;
        grid = cus * per_cu;
        if (ws_size < WS_END) { fprintf(stderr, "workspace too small: %zu < %zu\n", ws_size, (size_t)WS_END); grid = -1; }
    }
    if (grid < 0) return;
    hipMemsetAsync((unsigned char*)d_ws + OFF_BAR, 0, XCD_BAR_WORDS * 4, stream);
    Params p{};
    for (int i = 0; i < 16; ++i) p.in[i] = (const float*)d_in[i];
    p.out = (float*)d_out; p.ws = (unsigned char*)d_ws;
    void* args[] = {&p};
    hipError_t e = hipLaunchCooperativeKernel((const void*)mega, dim3(grid), dim3(256), args, LDS_BYTES, stream);
    if (e != hipSuccess) fprintf(stderr, "cooperative launch failed: %s (grid %d)\n", hipGetErrorString(e), grid);
}
```

```cpp
#include <hip/hip_runtime.h>
#include <cstdio>
#include <cstdint>

#define DI __device__ __forceinline__
#define LAS __attribute__((address_space(3)))
typedef unsigned short bf16_t;
typedef short bf16x8 __attribute__((ext_vector_type(8)));
typedef float f32x16 __attribute__((ext_vector_type(16)));
typedef float f32x4 __attribute__((ext_vector_type(4)));
typedef float f32x2 __attribute__((ext_vector_type(2)));
typedef unsigned u32x4 __attribute__((ext_vector_type(4)));
typedef unsigned u32x2 __attribute__((ext_vector_type(2)));
#define MFMA(a, b, c) __builtin_amdgcn_mfma_f32_32x32x16_bf16((a), (b), (c), 0, 0, 0)

#define XB_TMO      128
#define XB_XCNT(j)  (256  + 64 * (j))
#define XB_XSUB(j)  (1280 + 64 * (j))
#define XB_XGEN(j)  (2304 + 64 * (j))
#define XB_TOP      3328
#define XB_TOPGEN   3392
#define XCD_BAR_WORDS 3456
#define XB_SPIN_CAP (1u << 22)
DI unsigned xb_ld(unsigned* p)              { return __hip_atomic_load(p, __ATOMIC_RELAXED, __HIP_MEMORY_SCOPE_AGENT); }
DI unsigned xb_add(unsigned* p, unsigned v) { return __hip_atomic_fetch_add(p, v, __ATOMIC_RELAXED, __HIP_MEMORY_SCOPE_AGENT); }
DI unsigned xb_xcc_id() { return (unsigned)__builtin_amdgcn_s_getreg((3 << 11) | 20) & 0xFu; }
#define XB_SPIN(cond, bar) do { unsigned _sp = 0; while (cond) { __builtin_amdgcn_s_sleep(1); \
    if ((++_sp & 255u) == 0u) { if (xb_ld(&(bar)[XB_TMO])) break; if (_sp > XB_SPIN_CAP) { atomicAdd(&(bar)[XB_TMO], 1u); break; } } } } while (0)
struct XcdBarrier { unsigned* bar; unsigned x; volatile LAS unsigned* st; };
DI XcdBarrier xcd_barrier_post(unsigned* bar, volatile LAS unsigned* st, bool t0) {
    XcdBarrier b; b.bar = bar; b.x = xb_xcc_id(); b.st = st;
    if (t0) (void)xb_add(&bar[XB_XCNT(b.x)], 1u);
    return b;
}
DI void xcd_barrier_complete(unsigned* bar, unsigned x, unsigned& nloc, unsigned& nx) {
    const unsigned G = gridDim.x * gridDim.y * gridDim.z;
    unsigned sum, cnt, mine, sp = 0u;
    for (;;) {
        sum = 0u; cnt = 0u; mine = 0u;
#pragma unroll
        for (unsigned j = 0; j < 16; ++j) { const unsigned c = xb_ld(&bar[XB_XCNT(j)]); sum += c; cnt += (c > 0u) ? 1u : 0u; mine = (j == x) ? c : mine; }
        if (sum == G) break;
        __builtin_amdgcn_s_sleep(1);
        if ((++sp & 255u) == 0u) { if (xb_ld(&bar[XB_TMO])) break; if (sp > XB_SPIN_CAP) { atomicAdd(&bar[XB_TMO], 1u); break; } }
    }
    nloc = mine > 0u ? mine : 1u; nx = cnt > 0u ? cnt : 1u;
}
DI void xcd_barrier(const XcdBarrier& b, bool t0) {
    asm volatile("s_waitcnt vmcnt(0)" ::: "memory");
    __syncthreads();
    if (t0) {
        unsigned* bar = b.bar;
        __builtin_amdgcn_s_waitcnt(0);
        unsigned nloc = b.st[0], nx = b.st[1];
        if (nloc == 0u) { xcd_barrier_complete(bar, b.x, nloc, nx); b.st[0] = nloc; b.st[1] = nx; }
        const unsigned old = xb_add(&bar[XB_XSUB(b.x)], 1u);
        const unsigned gen = old / nloc;
        if (old + 1u == (gen + 1u) * nloc) {
            __builtin_amdgcn_fence(__ATOMIC_RELEASE, "agent");
            asm volatile("s_waitcnt vmcnt(0)" ::: "memory");
            const unsigned og = xb_add(&bar[XB_TOP], 1u);
            const unsigned tg = og / nx;
            if (og + 1u == (tg + 1u) * nx) xb_add(&bar[XB_TOPGEN], 1u);
            else XB_SPIN(xb_ld(&bar[XB_TOPGEN]) == tg, bar);
            __builtin_amdgcn_fence(__ATOMIC_ACQUIRE, "agent");
            xb_add(&bar[XB_XGEN(b.x)], 1u);
            asm volatile("s_waitcnt vmcnt(0)" ::: "memory");
        } else {
            XB_SPIN(xb_ld(&bar[XB_XGEN(b.x)]) == gen, bar);
            __builtin_amdgcn_fence(__ATOMIC_ACQUIRE, "agent");
            asm volatile("s_waitcnt vmcnt(0)" ::: "memory");
        }
    }
    __syncthreads();
}

constexpr int DM = 1024, SEQL = 2048, CTXL = 256, PP = 2304  ;
constexpr int NBG = 4  , NGRP = 2, NT = NBG * PP  ;
constexpr int INC = 8704, NCH = 18  ;
constexpr int LDH = 1088, LDW = 1088;
constexpr float EPS = 1e-6f;
constexpr float LOG2E = 1.4426950408889634f;

constexpr size_t TB = (size_t)NT * 512 * 2;
constexpr size_t OFF_BAR = 0;
constexpr size_t OFF_MOD = 16384;
constexpr size_t OFF_WIN = OFF_MOD + 262144;
constexpr size_t OFF_WBO = OFF_WIN + (size_t)2 * INC * LDW * 2;
constexpr size_t OFF_WO  = OFF_WBO + (size_t)2 * 3 * 1024 * 512 * 2;
constexpr size_t OFF_H   = OFF_WO + (size_t)2 * 1024 * 1024 * 2;
constexpr size_t OFF_RK  = OFF_H + (size_t)NT * LDH * 2;
constexpr size_t OFF_RKT = OFF_RK + TB;
constexpr size_t OFF_RVT = OFF_RKT + TB;
constexpr size_t OFF_DK  = OFF_RVT + TB;
constexpr size_t OFF_DVT = OFF_DK + TB;
constexpr size_t OFF_RQ  = OFF_DVT + TB;
constexpr size_t OFF_RG  = OFF_RQ + TB;
constexpr size_t OFF_DQ  = OFF_RG + TB;
constexpr size_t OFF_DG  = OFF_DQ + TB;
constexpr size_t OFF_MU  = OFF_DG + TB;
constexpr size_t OFF_MV  = OFF_MU + TB;
constexpr size_t OFF_MG  = OFF_MV + TB;
constexpr size_t OFF_MLOG = OFF_MG + TB;
constexpr size_t OFF_OMLP = OFF_MLOG + 6 * TB;
constexpr size_t OFF_ODIFF = OFF_OMLP + TB;
constexpr size_t OFF_ROPE = OFF_ODIFF + TB;
constexpr size_t WS_END = OFF_ROPE + (size_t)2048 * 96 * 8;
constexpr size_t OFF_ST = OFF_H;
constexpr size_t OFF_ORET = OFF_DK;
constexpr size_t OFF_Y = OFF_RK;
constexpr size_t OFF_OUT = OFF_MLOG;

struct Params {
    const float* in[16];
    float* out;
    unsigned char* ws;
};

struct Ctx {
    const float *x, *c, *ctx, *c_ctx, *w_mod, *b_mod, *g_pre, *g_post, *w_in, *decay, *w_s, *b_s, *lq, *lk, *w_bo, *w_out;
    float* out;
    unsigned char* ws;
    unsigned char* smem;
    const float* cst;
    int tid, lane, w, l31, hl;
};

DI unsigned pk2(float lo, float hi) {
    typedef __bf16 b2 __attribute__((ext_vector_type(2)));
    f32x2 v = {lo, hi};
    b2 r = __builtin_convertvector(v, b2);
    return __builtin_bit_cast(unsigned, r);
}
DI bf16_t f2bf(float x) { return (bf16_t)(pk2(x, 0.f) & 0xffffu); }
DI float bflo(unsigned u) { return __uint_as_float(u << 16); }
DI float bfhi(unsigned u) { return __uint_as_float(u & 0xffff0000u); }
DI int crow(int r, int hl) { return (r & 3) + 8 * (r >> 2) + 4 * hl; }
DI float wave_sum(float v) {
#pragma unroll
    for (int o = 1; o < 64; o <<= 1) v += __shfl_xor(v, o);
    return v;
}
DI float fsig(float x) { return __builtin_amdgcn_rcpf(1.f + __builtin_amdgcn_exp2f(-LOG2E * x)); }
DI void sincos_rev(float rev, float& sn, float& cs) {
    const float g = __builtin_amdgcn_fractf(rev) - 0.5f;
    const bool fold = fabsf(g) > 0.25f;
    const float h = fold ? (copysignf(0.5f, g) - g) : g;
    const float x = h * 6.283185307179586f;
    const float x2 = x * x;
    const float sp = x * (1.f + x2 * (-1.6666667e-1f + x2 * (8.3333333e-3f + x2 * (-1.9841270e-4f + x2 * (2.7557319e-6f - x2 * 2.5052108e-8f)))));
    const float cp = 1.f + x2 * (-0.5f + x2 * (4.1666667e-2f + x2 * (-1.3888889e-3f + x2 * (2.4801587e-5f + x2 * (-2.7557319e-7f + x2 * 2.0876757e-9f)))));
    sn = -sp;
    cs = fold ? cp : -cp;
}
DI float silu_f(float x) { return x / (1.f + __expf(-x)); }
DI float sigmoid_f(float x) { return 1.f / (1.f + __expf(-x)); }

DI void gemm_core(const Ctx& c, const bf16_t* __restrict__ Wt, int ldw, const bf16_t* __restrict__ Act, int lda, int K, f32x16 (&acc)[2][2]) {
    bf16_t* Ws = (bf16_t*)c.smem;
    bf16_t* As = Ws + 128 * 72;
    const int wn = c.w >> 1, wm = c.w & 1;
    const int lrow = c.tid >> 3, lseg = c.tid & 7;
    u32x4 rw[4], ra[4];
#pragma unroll
    for (int it = 0; it < 4; ++it) {
        rw[it] = *(const u32x4*)(Wt + (size_t)(lrow + 32 * it) * ldw + lseg * 8);
        ra[it] = *(const u32x4*)(Act + (size_t)(lrow + 32 * it) * lda + lseg * 8);
    }
    for (int k0 = 0; k0 < K; k0 += 64) {
        __syncthreads();
#pragma unroll
        for (int it = 0; it < 4; ++it) {
            *(u32x4*)(Ws + (lrow + 32 * it) * 72 + lseg * 8) = rw[it];
            *(u32x4*)(As + (lrow + 32 * it) * 72 + lseg * 8) = ra[it];
        }
        __syncthreads();
        if (k0 + 64 < K) {
#pragma unroll
            for (int it = 0; it < 4; ++it) {
                rw[it] = *(const u32x4*)(Wt + (size_t)(lrow + 32 * it) * ldw + k0 + 64 + lseg * 8);
                ra[it] = *(const u32x4*)(Act + (size_t)(lrow + 32 * it) * lda + k0 + 64 + lseg * 8);
            }
        }
#pragma unroll
        for (int ks = 0; ks < 4; ++ks) {
            const bf16x8 a0 = *(const bf16x8*)(Ws + (wn * 64 + c.l31) * 72 + ks * 16 + c.hl * 8);
            const bf16x8 a1 = *(const bf16x8*)(Ws + (wn * 64 + 32 + c.l31) * 72 + ks * 16 + c.hl * 8);
            const bf16x8 b0 = *(const bf16x8*)(As + (wm * 64 + c.l31) * 72 + ks * 16 + c.hl * 8);
            const bf16x8 b1 = *(const bf16x8*)(As + (wm * 64 + 32 + c.l31) * 72 + ks * 16 + c.hl * 8);
            acc[0][0] = MFMA(a0, b0, acc[0][0]);
            acc[0][1] = MFMA(a0, b1, acc[0][1]);
            acc[1][0] = MFMA(a1, b0, acc[1][0]);
            acc[1][1] = MFMA(a1, b1, acc[1][1]);
        }
    }
}
DI void zero_acc(f32x16 (&acc)[2][2]) {
#pragma unroll
    for (int i = 0; i < 2; ++i)
#pragma unroll
        for (int j = 0; j < 2; ++j)
#pragma unroll
            for (int r = 0; r < 16; ++r) acc[i][j][r] = 0.f;
}


DI void gemm_core2(const Ctx& c, const bf16_t* __restrict__ Wt, int ldw, const bf16_t* __restrict__ Act, int lda, int K, f32x16 (&acc)[2][4]) {
    constexpr int RS = 32;
    constexpr int STG = 384 * RS;
    bf16_t* S = (bf16_t*)c.smem;
    const int wn = c.w >> 1, wm = c.w & 1;
    const int rsw = (c.l31 >> 2) & 3;
    const int ro = c.lane >> 2, lc = (c.lane & 3) ^ ((c.lane >> 4) & 3);
    const bf16_t* wsrc = Wt + (size_t)(c.w * 16 + ro) * ldw + lc * 8;
    const bf16_t* asrc = Act + (size_t)(c.w * 16 + ro) * lda + lc * 8;
#define G2_GLDS(SP, KOFF) { \
        _Pragma("unroll") for (int i = 0; i < 2; ++i) __builtin_amdgcn_global_load_lds((const unsigned*)(wsrc + (size_t)(64 * i) * ldw + (KOFF)), (unsigned*)((SP) + (c.w + 4 * i) * 512), 16, 0, 0); \
        _Pragma("unroll") for (int i = 0; i < 4; ++i) __builtin_amdgcn_global_load_lds((const unsigned*)(asrc + (size_t)(64 * i) * lda + (KOFF)), (unsigned*)((SP) + (8 + c.w + 4 * i) * 512), 16, 0, 0); }
    __syncthreads();
    G2_GLDS(S, 0)
    asm volatile("s_waitcnt vmcnt(0)" ::: "memory");
    __syncthreads();
    for (int k0 = 0; k0 < K; k0 += 32) {
        const int s = (k0 >> 5) & 1;
        bf16_t* Sc = S + s * STG;
        bf16_t* Sn = S + (s ^ 1) * STG;
        if (k0 + 32 < K) G2_GLDS(Sn, k0 + 32)
#pragma unroll
        for (int ks = 0; ks < 2; ++ks) {
            const int rcol = ((ks * 2 + c.hl) ^ rsw) * 8;
            bf16x8 a[2], b[4];
#pragma unroll
            for (int i = 0; i < 2; ++i) a[i] = *(const bf16x8*)(Sc + (wn * 64 + i * 32 + c.l31) * RS + rcol);
#pragma unroll
            for (int j = 0; j < 4; ++j) b[j] = *(const bf16x8*)(Sc + (128 + wm * 128 + j * 32 + c.l31) * RS + rcol);
#pragma unroll
            for (int i = 0; i < 2; ++i)
#pragma unroll
                for (int j = 0; j < 4; ++j) acc[i][j] = MFMA(a[i], b[j], acc[i][j]);
        }
        asm volatile("s_waitcnt vmcnt(0)" ::: "memory");
        __syncthreads();
    }
#undef G2_GLDS
}
DI void zero_acc2(f32x16 (&acc)[2][4]) {
#pragma unroll
    for (int i = 0; i < 2; ++i)
#pragma unroll
        for (int j = 0; j < 4; ++j)
#pragma unroll
            for (int r = 0; r < 16; ++r) acc[i][j][r] = 0.f;
}

DI void transpose_item(const Ctx& c, const float* __restrict__ src, int N, int k0, int n0, int mapk, bf16_t* __restrict__ dst, int ldk) {
    float* T = (float*)c.smem;
    __syncthreads();
    {
        f32x4 tv[8];
#pragma unroll
        for (int it = 0; it < 8; ++it) { const int idx = c.tid + 256 * it; tv[it] = *(const f32x4*)(src + (size_t)(k0 + (idx >> 5)) * N + n0 + (idx & 31) * 4); }
#pragma unroll
        for (int it = 0; it < 8; ++it) {
            const int idx = c.tid + 256 * it, r = idx >> 5, c4 = idx & 31;
            float* t = T + r * 129 + c4 * 4;
            t[0] = tv[it][0]; t[1] = tv[it][1]; t[2] = tv[it][2]; t[3] = tv[it][3];
        }
    }
    __syncthreads();
#pragma unroll
    for (int it = 0; it < 4; ++it) {
        const int idx = c.tid + 256 * it, np = idx >> 3, ch = idx & 7;
        int cs = np;
        if (mapk == 1) cs = (np >> 1) + 64 * (np & 1);
        else if (mapk == 2) { const int r = np & 63; cs = (np & 64) + (r >> 1) + 32 * (r & 1); }
        const float* t = T + (ch * 8) * 129 + cs;
        u32x4 o;
        o[0] = pk2(t[0], t[129]); o[1] = pk2(t[2 * 129], t[3 * 129]); o[2] = pk2(t[4 * 129], t[5 * 129]); o[3] = pk2(t[6 * 129], t[7 * 129]);
        *(u32x4*)(dst + (size_t)(n0 + np) * ldk + k0 + ch * 8) = o;
    }
}
DI void mod_item(const Ctx& c, int l, int jb) {
    float* sv = (float*)c.smem;
    float* red = sv + 9 * 1024;
    __syncthreads();
    for (int idx = c.tid; idx < 9216; idx += 256) {
        const int v = idx >> 10, k = idx & 1023;
        const float x = v < 8 ? c.c[v * 1024 + k] : c.c_ctx[k];
        sv[idx] = x / (1.f + expf(-x));
    }
    __syncthreads();
    const int kk = c.tid >> 5, jj = c.tid & 31, j = jb * 32 + jj;
    float a[9];
#pragma unroll
    for (int v = 0; v < 9; ++v) a[v] = 0.f;
    const float* wp = c.w_mod + (size_t)l * 1024 * 3072 + j;
#pragma unroll 4
    for (int i = 0; i < 128; ++i) {
        const int k = kk + 8 * i;
        const float wv = wp[(size_t)k * 3072];
#pragma unroll
        for (int v = 0; v < 9; ++v) a[v] += sv[v * 1024 + k] * wv;
    }
#pragma unroll
    for (int v = 0; v < 9; ++v) red[(kk * 9 + v) * 32 + jj] = a[v];
    __syncthreads();
    float* MOD = (float*)(c.ws + OFF_MOD);
    for (int idx = c.tid; idx < 288; idx += 256) {
        const int v = idx >> 5, j2 = idx & 31;
        float s = 0.f;
#pragma unroll
        for (int k2 = 0; k2 < 8; ++k2) s += red[(k2 * 9 + v) * 32 + j2];
        MOD[(size_t)(l * 9 + v) * 3072 + jb * 32 + j2] = s + c.b_mod[l * 3072 + jb * 32 + j2];
    }
}

DI void rope_item(const Ctx& c, int it) {
    constexpr float L2B = 13.287712379549449f;
    f32x2* T = (f32x2*)(c.ws + OFF_ROPE);
#pragma unroll 1
    for (int e = 0; e < 8; ++e) {
        const int idx = (it * 8 + e) * 256 + c.tid;
        const int lp = idx / 96, a = idx % 96;
        const float rowp = (float)(lp >> 6), colp = (float)(lp & 63);
        float ang;
        if (a < 64) { const int f = a & 31; ang = (a < 32 ? rowp : colp) * exp2f(-(float)f * (L2B / 32.f)); }
        else { const int a2 = a - 64, f = a2 & 15; ang = (a2 < 16 ? rowp : colp) * exp2f(-(float)f * (L2B / 16.f)); }
        f32x2 v; v[0] = cosf(ang); v[1] = sinf(ang);
        T[idx] = v;
    }
}
DI void p0_item(const Ctx& c, int it) {
    if (it < 2 * 1408) {
        const int l = it / 1408; int r = it % 1408;
        if (r < 1088) {
            const int ct = r % 68, kb = r / 68;
            const int kind = ct >> 2;
            const int mapk = (kind == 0 || kind == 4) ? 1 : ((kind == 2 || kind == 6) ? 2 : 0);
            transpose_item(c, c.w_in + (size_t)l * 1024 * INC, INC, kb * 64, ct * 128, mapk, (bf16_t*)(c.ws + OFF_WIN) + (size_t)l * INC * LDW, LDW);
            return;
        }
        r -= 1088;
        if (r < 192) {
            const int br = r / 64, q = r % 64, kb = q >> 3, nb = q & 7;
            transpose_item(c, c.w_bo + (size_t)(l * 3 + br) * 512 * 1024, 1024, kb * 64, nb * 128, 0,
                           (bf16_t*)(c.ws + OFF_WBO) + (size_t)(l * 3 + br) * 1024 * 512, 512);
            return;
        }
        r -= 192;
        { const int kb = r >> 3, nb = r & 7;
          transpose_item(c, c.w_out + (size_t)l * 1024 * 1024, 1024, kb * 64, nb * 128, 0, (bf16_t*)(c.ws + OFF_WO) + (size_t)l * 1024 * 1024, 1024); }
        return;
    }
    it -= 2 * 1408;
    mod_item(c, it / 96, it % 96);
}

DI void modulate_row(const f32x4 (&x)[4], const float* gpre, const float* mod  , bf16_t* hrow, int lane) {
    float ss = 0.f;
#pragma unroll
    for (int j = 0; j < 4; ++j) ss += x[j][0] * x[j][0] + x[j][1] * x[j][1] + x[j][2] * x[j][2] + x[j][3] * x[j][3];
    ss = wave_sum(ss);
    const float r = rsqrtf(ss * (1.f / 1024.f) + EPS);
    f32x4 gq[4], shq[4], scq[4];
#pragma unroll
    for (int j = 0; j < 4; ++j) { const int col = lane * 4 + 256 * j; gq[j] = *(const f32x4*)(gpre + col); shq[j] = *(const f32x4*)(mod + col); scq[j] = *(const f32x4*)(mod + 1024 + col); }
#pragma unroll
    for (int j = 0; j < 4; ++j) {
        const int col = lane * 4 + 256 * j;
        const f32x4 g = gq[j], sh = shq[j], sc = scq[j];
        f32x4 h;
#pragma unroll
        for (int e = 0; e < 4; ++e) h[e] = x[j][e] * r * g[e] * (1.f + sc[e]) + sh[e];
        u32x2 o; o[0] = pk2(h[0], h[1]); o[1] = pk2(h[2], h[3]);
        *(u32x2*)(hrow + col) = o;
    }
}
DI void ph_item(const Ctx& c, int g, int item) {
    const int tok = item * 4 + c.w, bl = tok / PP, p = tok % PP, b = g * NBG + bl;
    const float* src = p < CTXL ? c.ctx + ((size_t)b * CTXL + p) * DM : c.x + ((size_t)b * SEQL + (p - CTXL)) * DM;
    f32x4 x[4];
#pragma unroll
    for (int j = 0; j < 4; ++j) x[j] = *(const f32x4*)(src + c.lane * 4 + 256 * j);
    const float* mod = (const float*)(c.ws + OFF_MOD) + (size_t)(0 * 9 + (p < CTXL ? 8 : b)) * 3072;
    modulate_row(x, c.g_pre, mod, (bf16_t*)(c.ws + OFF_H) + (size_t)tok * LDH, c.lane);
}
DI void pr_item(const Ctx& c, int l, int g, int item) {
    const int tok = item * 4 + c.w, bl = tok / PP, p = tok % PP, b = g * NBG + bl;
    if (l == 1 && p < CTXL) return;
    const float* orow = (const float*)(c.ws + OFF_OUT) + (size_t)tok * DM;
    const int v = p < CTXL ? 8 : b;
    const float* mod = (const float*)(c.ws + OFF_MOD) + (size_t)(l * 9 + v) * 3072;
    float* xo_lat = c.out + ((size_t)b * SEQL + (p - CTXL)) * DM;
    const float* xold = p < CTXL ? c.ctx + ((size_t)b * CTXL + p) * DM : (l == 0 ? c.x + ((size_t)b * SEQL + (p - CTXL)) * DM : xo_lat);
    f32x4 o[4], gpq[4], gtq[4], xvq[4]; float ss = 0.f;
#pragma unroll
    for (int j = 0; j < 4; ++j) {
        const int col = c.lane * 4 + 256 * j;
        o[j] = *(const f32x4*)(orow + col); gpq[j] = *(const f32x4*)(c.g_post + l * 1024 + col); gtq[j] = *(const f32x4*)(mod + 2048 + col); xvq[j] = *(const f32x4*)(xold + col);
    }
#pragma unroll
    for (int j = 0; j < 4; ++j) ss += o[j][0] * o[j][0] + o[j][1] * o[j][1] + o[j][2] * o[j][2] + o[j][3] * o[j][3];
    ss = wave_sum(ss);
    const float r = rsqrtf(ss * (1.f / 1024.f) + EPS);
    f32x4 xn[4];
#pragma unroll
    for (int j = 0; j < 4; ++j) {
        const int col = c.lane * 4 + 256 * j;
        const f32x4 gp = gpq[j], gt = gtq[j], xv = xvq[j];
#pragma unroll
        for (int e = 0; e < 4; ++e) xn[j][e] = xv[e] + gt[e] * (o[j][e] * r * gp[e]);
        if (p >= CTXL) *(f32x4*)(xo_lat + col) = xn[j];
    }
    if (l == 0) {
        const float* mod1 = (const float*)(c.ws + OFF_MOD) + (size_t)(1 * 9 + v) * 3072;
        modulate_row(xn, c.g_pre + 1024, mod1, (bf16_t*)(c.ws + OFF_H) + (size_t)tok * LDH, c.lane);
    }
}

DI void pz_item(const Ctx& c, int l, int rt2, int ct) {
    f32x16 acc[2][4];
    zero_acc2(acc);
    gemm_core2(c, (const bf16_t*)(c.ws + OFF_WIN) + ((size_t)l * INC + (size_t)ct * 128) * LDW, LDW,
               (const bf16_t*)(c.ws + OFF_H) + (size_t)rt2 * 256 * LDH, LDH, 1024, acc);
    const int wn = c.w >> 1, wm = c.w & 1;
    const int bl = rt2 / 9, pt2 = rt2 % 9;
    const int kind = ct >> 2, h = ct & 3;
    const bool roped = (kind == 0 || kind == 4 || kind == 2 || kind == 6);
    const bool retk = (kind == 0 || kind == 4);
    bf16_t* E = (bf16_t*)c.smem;
    constexpr int ES = 136, ETS = 264;
    const float rsc = kind == 0 ? 0.08838834764831845f : (kind == 6 ? 0.125f * LOG2E : 1.f);
    const bool latent = pt2 > 0;
    const bool mulx = (kind == 5 || kind == 7 || kind == 10);
#define XF_PLAIN  { v0 *= rsc; v1 *= rsc; v2 *= rsc; v3 *= rsc; }
#define XF_SIG    { v0 = fsig(v0); v1 = fsig(v1); v2 = fsig(v2); v3 = fsig(v3); }
#define XF_SILU   { v0 *= fsig(v0); v1 *= fsig(v1); v2 *= fsig(v2); v3 *= fsig(v3); }
#define PZ_STAGE(PASS, XF) \
    _Pragma("unroll") for (int j = 0; j < 4; ++j) { \
        const int m = wm * 128 + j * 32 + c.l31; \
        _Pragma("unroll") for (int i = 0; i < 2; ++i) \
        _Pragma("unroll") for (int q = 0; q < 4; ++q) { \
            const int n0 = wn * 64 + i * 32 + 8 * q + 4 * c.hl; \
            float v0 = acc[i][j][4 * q + 0], v1 = acc[i][j][4 * q + 1], v2 = acc[i][j][4 * q + 2], v3 = acc[i][j][4 * q + 3]; \
            XF \
            if (PASS == 0) { \
                u32x2 o; o[0] = pk2(v0, v1); o[1] = pk2(v2, v3); \
                *(u32x2*)(E + m * ES + n0) = o; \
            } else { \
                E[(n0 + 0) * ETS + m] = f2bf(v0); E[(n0 + 1) * ETS + m] = f2bf(v1); E[(n0 + 2) * ETS + m] = f2bf(v2); E[(n0 + 3) * ETS + m] = f2bf(v3); \
            } \
        } \
    }
    const int cls = roped ? (latent ? 0 : 1) : (kind >= 11 ? 2 : (mulx ? 3 : 1));
    const int nfq = retk ? 32 : 16;
    const float fsc = retk ? (13.287712379549449f / 32.f) : (13.287712379549449f / 16.f);
    if (cls == 0) {
        const int lbase = pt2 * 256 + wm * 128 - CTXL;
        const float rowA = (float)(lbase >> 6), colA = (float)c.l31;
#pragma unroll
        for (int i = 0; i < 2; ++i) {
            const bool rowpart = retk ? (wn == 0) : (i == 0);
            const float posA = rowpart ? rowA : colA;
            const float posB = rowpart ? rowA + 1.f : colA + 32.f;
#pragma unroll
            for (int q = 0; q < 4; ++q) {
                const int n0 = wn * 64 + i * 32 + 8 * q + 4 * c.hl;
                const int c0 = retk ? (n0 >> 1) : ((n0 & 63) >> 1);
                const float iv0 = __builtin_amdgcn_exp2f(-(float)(c0 & (nfq - 1)) * fsc) * 0.15915494309189535f;
                const float iv1 = __builtin_amdgcn_exp2f(-(float)((c0 + 1) & (nfq - 1)) * fsc) * 0.15915494309189535f;
#define ROPE_APPLY(POS, JA, JB) { float s0, c0f, s1, c1f; sincos_rev((POS) * iv0, s0, c0f); sincos_rev((POS) * iv1, s1, c1f); \
                    { const float v0 = acc[i][JA][4 * q + 0], v1 = acc[i][JA][4 * q + 1], v2 = acc[i][JA][4 * q + 2], v3 = acc[i][JA][4 * q + 3]; \
                      acc[i][JA][4 * q + 0] = v0 * c0f - v1 * s0; acc[i][JA][4 * q + 1] = v0 * s0 + v1 * c0f; acc[i][JA][4 * q + 2] = v2 * c1f - v3 * s1; acc[i][JA][4 * q + 3] = v2 * s1 + v3 * c1f; } \
                    { const float v0 = acc[i][JB][4 * q + 0], v1 = acc[i][JB][4 * q + 1], v2 = acc[i][JB][4 * q + 2], v3 = acc[i][JB][4 * q + 3]; \
                      acc[i][JB][4 * q + 0] = v0 * c0f - v1 * s0; acc[i][JB][4 * q + 1] = v0 * s0 + v1 * c0f; acc[i][JB][4 * q + 2] = v2 * c1f - v3 * s1; acc[i][JB][4 * q + 3] = v2 * s1 + v3 * c1f; } }
                if (rowpart) { ROPE_APPLY(posA, 0, 1) ROPE_APPLY(posB, 2, 3) }
                else { ROPE_APPLY(posA, 0, 2) ROPE_APPLY(posB, 1, 3) }
#undef ROPE_APPLY
            }
        }
    }
    if (kind != 1 && kind != 3) {
        if (cls <= 1) { PZ_STAGE(0, XF_PLAIN) }
        else if (cls == 2) { PZ_STAGE(0, XF_SIG) }
        else { PZ_STAGE(0, XF_SILU) }
        __syncthreads();
        bf16_t* dst; size_t ld;
        if (kind >= 11) { dst = (bf16_t*)(c.ws + OFF_MLOG) + (size_t)(ct - 44) * 128; ld = 3072; }
        else {
            size_t off;
            switch (kind) { case 0: off = OFF_RK; break; case 2: off = OFF_DK; break; case 4: off = OFF_RQ; break; case 5: off = OFF_RG; break;
                            case 6: off = OFF_DQ; break; case 7: off = OFF_DG; break; case 8: off = OFF_MU; break; case 9: off = OFF_MV; break; default: off = OFF_MG; break; }
            dst = (bf16_t*)(c.ws + off) + h * 128; ld = 512;
        }
        dst += (size_t)rt2 * 256 * ld;
#pragma unroll 4
        for (int it = 0; it < 16; ++it) {
            const int id = c.tid + 256 * it, row = id >> 4, seg = id & 15;
            *(u32x4*)(dst + (size_t)row * ld + seg * 8) = *(const u32x4*)(E + row * ES + seg * 8);
        }
    }
    if (kind == 0 || kind == 1 || kind == 3) {
        if (kind == 0) __syncthreads();
        PZ_STAGE(1, XF_PLAIN)
        __syncthreads();
        const size_t off = kind == 0 ? OFF_RKT : (kind == 1 ? OFF_RVT : OFF_DVT);
        bf16_t* dst = (bf16_t*)(c.ws + off) + (size_t)(bl * 4 + h) * 128 * PP + pt2 * 256;
#pragma unroll 4
        for (int it = 0; it < 16; ++it) {
            const int id = c.tid + 256 * it, n = id >> 5, seg = id & 31;
            *(u32x4*)(dst + (size_t)n * PP + seg * 8) = *(const u32x4*)(E + n * ETS + seg * 8);
        }
    }
    __builtin_amdgcn_s_setprio(0);
#undef PZ_STAGE
#undef XF_PLAIN
#undef XF_SIG
#undef XF_SILU
}

DI void attn_item(const Ctx& c, int l, int bl, int h, int q0, int nk) {
    bf16_t* Ks = (bf16_t*)c.smem;
    bf16_t* Vs = Ks + 64 * 136;
    const int mp = c.w >> 1, qs = c.w & 1;
    const int qpos = q0 + qs * 32 + c.l31;
    const size_t qtok = (size_t)bl * PP + qpos;
    const bf16_t* DQ = (const bf16_t*)(c.ws + OFF_DQ);
    const bf16_t* DK = (const bf16_t*)(c.ws + OFF_DK) + (size_t)bl * PP * 512 + h * 128;
    const bf16_t* DVT = (const bf16_t*)(c.ws + OFF_DVT) + (size_t)(bl * 4 + h) * 128 * PP;
    bf16x8 qf[4];
#pragma unroll
    for (int ks = 0; ks < 4; ++ks) qf[ks] = *(const bf16x8*)(DQ + qtok * 512 + h * 128 + mp * 64 + ks * 16 + c.hl * 8);
    f32x16 o[4];
#pragma unroll
    for (int et = 0; et < 4; ++et)
#pragma unroll
        for (int r = 0; r < 16; ++r) o[et][r] = 0.f;
    float mrun = -1e30f, lrun = 0.f;
    u32x4 rk[4], rv[4];
    constexpr int BUF = 64 * 136 + 128 * 68;
#define AT_LOAD(KT0) { _Pragma("unroll") for (int it = 0; it < 4; ++it) { const int idx = c.tid + 256 * it; \
        rk[it] = *(const u32x4*)(DK + (size_t)((KT0) + (idx >> 4)) * 512 + (idx & 15) * 8); \
        rv[it] = *(const u32x4*)(DVT + (size_t)(idx >> 3) * PP + (KT0) + (idx & 7) * 8); } }
#define AT_STORE(BP) { _Pragma("unroll") for (int it = 0; it < 4; ++it) { const int idx = c.tid + 256 * it; \
        *(u32x4*)((BP) + (idx >> 4) * 136 + (idx & 15) * 8) = rk[it]; \
        u32x2 lo2, hi2; lo2[0] = rv[it][0]; lo2[1] = rv[it][1]; hi2[0] = rv[it][2]; hi2[1] = rv[it][3]; \
        *(u32x2*)((BP) + 64 * 136 + (idx >> 3) * 68 + (idx & 7) * 8) = lo2; *(u32x2*)((BP) + 64 * 136 + (idx >> 3) * 68 + (idx & 7) * 8 + 4) = hi2; } }
    AT_LOAD(0)
    __syncthreads();
    AT_STORE(Ks)
    if (64 < nk) AT_LOAD(64)
    __syncthreads();
    for (int kt0 = 0; kt0 < nk; kt0 += 64) {
        const int cb = (kt0 >> 6) & 1;
        const bf16_t* Kc = Ks + cb * BUF;
        const bf16_t* Vc = Kc + 64 * 136;
        if (kt0 + 64 < nk) {
            AT_STORE(Ks + (cb ^ 1) * BUF)
            if (kt0 + 128 < nk) AT_LOAD(kt0 + 128)
        }
        f32x16 s[2];
#pragma unroll
        for (int kt = 0; kt < 2; ++kt) {
#pragma unroll
            for (int r = 0; r < 16; ++r) s[kt][r] = 0.f;
#pragma unroll
            for (int ks = 0; ks < 4; ++ks) {
                const bf16x8 a = *(const bf16x8*)(Kc + (kt * 32 + c.l31) * 136 + mp * 64 + ks * 16 + c.hl * 8);
                s[kt] = MFMA(a, qf[ks], s[kt]);
            }
        }
        float mx = s[0][0];
#pragma unroll
        for (int r = 0; r < 16; ++r) { mx = fmaxf(mx, s[0][r]); mx = fmaxf(mx, s[1][r]); }
        mx = fmaxf(mx, __shfl_xor(mx, 32));
        const float mold = mrun;
        const float mnew = fmaxf(mrun, mx);
        const float alpha = __builtin_amdgcn_exp2f(mrun - mnew);
        mrun = mnew;
        float lsum = 0.f;
#pragma unroll
        for (int kt = 0; kt < 2; ++kt)
#pragma unroll
            for (int r = 0; r < 16; ++r) { const float pv = __builtin_amdgcn_exp2f(s[kt][r] - mnew); s[kt][r] = pv; lsum += pv; }
        lrun = lrun * alpha + lsum;
        if (__any(mx > mold)) {
#pragma unroll
            for (int et = 0; et < 4; ++et)
#pragma unroll
                for (int r = 0; r < 16; ++r) o[et][r] *= alpha;
        }
#pragma unroll
        for (int kt = 0; kt < 2; ++kt) {
#pragma unroll
            for (int st = 0; st < 2; ++st) {
                u32x4 pp;
                pp[0] = pk2(s[kt][8 * st + 0], s[kt][8 * st + 1]); pp[1] = pk2(s[kt][8 * st + 2], s[kt][8 * st + 3]);
                pp[2] = pk2(s[kt][8 * st + 4], s[kt][8 * st + 5]); pp[3] = pk2(s[kt][8 * st + 6], s[kt][8 * st + 7]);
                const bf16x8 pf = __builtin_bit_cast(bf16x8, pp);
#pragma unroll
                for (int et = 0; et < 4; ++et) {
                    const bf16_t* vp = Vc + (et * 32 + c.l31) * 68 + kt * 32 + 16 * st + 4 * c.hl;
                    const u32x2 lo = *(const u32x2*)vp, hi = *(const u32x2*)(vp + 8);
                    u32x4 av; av[0] = lo[0]; av[1] = lo[1]; av[2] = hi[0]; av[3] = hi[1];
                    o[et] = MFMA(__builtin_bit_cast(bf16x8, av), pf, o[et]);
                }
            }
        }
        __syncthreads();
    }
#undef AT_LOAD
#undef AT_STORE
    const float ltot = lrun + __shfl_xor(lrun, 32);
    const float linv = 1.f / ltot;
    float* Oc = (float*)c.smem;
    if (mp == 1) {
#pragma unroll
        for (int et = 0; et < 4; ++et)
#pragma unroll
            for (int r = 0; r < 16; ++r) Oc[(qs * 128 + et * 32 + crow(r, c.hl)) * 32 + c.l31] = o[et][r] * linv;
    }
    __syncthreads();
    if (mp == 0) {
        const float lam = c.cst[l], lam_init = c.cst[2 + l];
        float ss = 0.f;
#pragma unroll
        for (int et = 0; et < 4; ++et)
#pragma unroll
            for (int r = 0; r < 16; ++r) {
                const float d = o[et][r] * linv - lam * Oc[(qs * 128 + et * 32 + crow(r, c.hl)) * 32 + c.l31];
                o[et][r] = d; ss += d * d;
            }
        ss += __shfl_xor(ss, 32);
        const float rn = rsqrtf(ss * (1.f / 128.f) + EPS) * (1.f - lam_init);
        const bf16_t* DG = (const bf16_t*)(c.ws + OFF_DG) + qtok * 512 + h * 128;
        bf16_t* OD = (bf16_t*)(c.ws + OFF_ODIFF) + qtok * 512 + h * 128;
#pragma unroll
        for (int et = 0; et < 4; ++et)
#pragma unroll
            for (int q = 0; q < 4; ++q) {
                const int e0 = et * 32 + 8 * q + 4 * c.hl;
                const u32x2 g = *(const u32x2*)(DG + e0);
                u32x2 ov;
                ov[0] = pk2(o[et][4 * q + 0] * rn * bflo(g[0]), o[et][4 * q + 1] * rn * bfhi(g[0]));
                ov[1] = pk2(o[et][4 * q + 2] * rn * bflo(g[1]), o[et][4 * q + 3] * rn * bfhi(g[1]));
                *(u32x2*)(OD + e0) = ov;
            }
    }
}

DI void scan_item(const Ctx& c, int l, int bl, int h, int dir, int es) {
    const float lg2 = c.cst[4 + l * 8 + dir * 4 + h];
    const float decayC = __builtin_amdgcn_exp2f(lg2 * 128.f);
    f32x16 st;
#pragma unroll
    for (int r = 0; r < 16; ++r) st[r] = 0.f;
    const bf16_t* vt = (const bf16_t*)(c.ws + OFF_RVT) + ((size_t)(bl * 4 + h) * 128 + es * 32 + c.l31) * PP;
    const bf16_t* kt = (const bf16_t*)(c.ws + OFF_RKT) + ((size_t)(bl * 4 + h) * 128 + c.w * 32 + c.l31) * PP;
    bf16_t* stbase = (bf16_t*)(c.ws + OFF_ST) + (size_t)(((bl * 4 + h) * 2 + dir) * NCH) * 16384;
#pragma unroll 1
    for (int step = 0; step < NCH; ++step) {
        const int m = dir == 0 ? step : (step < 2 ? 1 - step : 19 - step);
        bf16_t* sp = stbase + (size_t)m * 16384;
#pragma unroll
        for (int r = 0; r < 16; ++r) sp[(es * 32 + crow(r, c.hl)) * 128 + c.w * 32 + c.l31] = f2bf(st[r]);
        if (step == NCH - 1) break;
#pragma unroll
        for (int r = 0; r < 16; ++r) st[r] *= decayC;
#pragma unroll
        for (int ks = 0; ks < 8; ++ks) {
            const int j0 = ks * 16 + c.hl * 8;
            const u32x4 av = *(const u32x4*)(vt + m * 128 + j0);
            const u32x4 bv = *(const u32x4*)(kt + m * 128 + j0);
            u32x4 as;
#pragma unroll
            for (int e = 0; e < 4; ++e) {
                const int ja = j0 + 2 * e;
                const float e0 = dir == 0 ? (float)(127 - ja) : (float)ja;
                const float e1 = dir == 0 ? (float)(126 - ja) : (float)(ja + 1);
                const float w0 = __builtin_amdgcn_exp2f(lg2 * e0), w1 = __builtin_amdgcn_exp2f(lg2 * e1);
                as[e] = pk2(bflo(av[e]) * w0, bfhi(av[e]) * w1);
            }
            st = MFMA(__builtin_bit_cast(bf16x8, as), __builtin_bit_cast(bf16x8, bv), st);
        }
    }
}

DI void mlp_item(const Ctx& c, int l, int bl, int m, int g) {
    bf16_t* Vn = (bf16_t*)c.smem;
    bf16_t* Wsm = Vn + 128 * 136;
    float* stat = (float*)(Wsm + 128 * 136);
    const size_t tok0 = (size_t)bl * PP + m * 128;
    const bf16_t* MV = (const bf16_t*)(c.ws + OFF_MV);
    __syncthreads();
#pragma unroll 1
    for (int rb = 0; rb < 4; ++rb) {
        u32x4 vv[8];
#pragma unroll
        for (int r8 = 0; r8 < 8; ++r8) vv[r8] = *(const u32x4*)(MV + (tok0 + c.w * 32 + rb * 8 + r8) * 512 + c.lane * 8);
#pragma unroll
        for (int r8 = 0; r8 < 8; ++r8) {
            const int row = c.w * 32 + rb * 8 + r8;
            float xv[8];
#pragma unroll
            for (int e = 0; e < 4; ++e) { xv[2 * e] = bflo(vv[r8][e]); xv[2 * e + 1] = bfhi(vv[r8][e]); }
            float sm = 0.f;
#pragma unroll
            for (int e = 0; e < 8; ++e) sm += xv[e];
            sm = wave_sum(sm);
            const float mu = sm * (1.f / 512.f);
            float ss = 0.f;
#pragma unroll
            for (int e = 0; e < 8; ++e) { const float d = xv[e] - mu; ss += d * d; }
            ss = wave_sum(ss);
            if (c.lane == 0) { stat[row] = mu; stat[128 + row] = rsqrtf(ss * (1.f / 512.f) + EPS); }
        }
    }
    __syncthreads();
    {
        u32x4 tv[8];
#pragma unroll
        for (int it = 0; it < 8; ++it) { const int idx = c.tid + 256 * it; tv[it] = *(const u32x4*)(MV + (tok0 + (idx >> 4)) * 512 + g * 128 + (idx & 15) * 8); }
#pragma unroll
        for (int it = 0; it < 8; ++it) {
            const int idx = c.tid + 256 * it, j = idx >> 4, seg = idx & 15;
            const float mu = stat[j], rs = stat[128 + j];
#pragma unroll
            for (int e = 0; e < 4; ++e) {
                Vn[(seg * 8 + 2 * e) * 136 + j] = f2bf((bflo(tv[it][e]) - mu) * rs);
                Vn[(seg * 8 + 2 * e + 1) * 136 + j] = f2bf((bfhi(tv[it][e]) - mu) * rs);
            }
        }
    }
    {
        const float* wsrc = c.w_s + (size_t)(l * 4 + g) * 128 * 128;
#pragma unroll 1
        for (int hb = 0; hb < 2; ++hb) {
            f32x4 wv[8];
#pragma unroll
            for (int it = 0; it < 8; ++it) { const int idx = c.tid + 256 * (hb * 8 + it); wv[it] = *(const f32x4*)(wsrc + (idx >> 5) * 128 + (idx & 31) * 4); }
#pragma unroll
            for (int it = 0; it < 8; ++it) {
                const int idx = c.tid + 256 * (hb * 8 + it);
                u32x2 o; o[0] = pk2(wv[it][0], wv[it][1]); o[1] = pk2(wv[it][2], wv[it][3]);
                *(u32x2*)(Wsm + (idx >> 5) * 136 + (idx & 31) * 4) = o;
            }
        }
    }
    __syncthreads();
    const int wc = c.w >> 1, wi = c.w & 1;
    f32x16 acc[2][2];
    zero_acc(acc);
#pragma unroll
    for (int ks = 0; ks < 8; ++ks) {
        const bf16x8 a0 = *(const bf16x8*)(Vn + (wc * 64 + c.l31) * 136 + ks * 16 + c.hl * 8);
        const bf16x8 a1 = *(const bf16x8*)(Vn + (wc * 64 + 32 + c.l31) * 136 + ks * 16 + c.hl * 8);
        const bf16x8 b0 = *(const bf16x8*)(Wsm + (wi * 64 + c.l31) * 136 + ks * 16 + c.hl * 8);
        const bf16x8 b1 = *(const bf16x8*)(Wsm + (wi * 64 + 32 + c.l31) * 136 + ks * 16 + c.hl * 8);
        acc[0][0] = MFMA(a0, b0, acc[0][0]); acc[0][1] = MFMA(a0, b1, acc[0][1]);
        acc[1][0] = MFMA(a1, b0, acc[1][0]); acc[1][1] = MFMA(a1, b1, acc[1][1]);
    }
    const bf16_t* MU = (const bf16_t*)(c.ws + OFF_MU);
    const bf16_t* MG = (const bf16_t*)(c.ws + OFF_MG);
    bf16_t* OM = (bf16_t*)(c.ws + OFF_OMLP);
    u32x2 uq[2][2][4], gq[2][2][4];
    float bsq[2];
#pragma unroll
    for (int ii = 0; ii < 2; ++ii) {
        const int i = wi * 64 + ii * 32 + c.l31;
        const size_t tok = tok0 + i;
        bsq[ii] = c.b_s[(l * 4 + g) * 128 + i];
#pragma unroll
        for (int ci = 0; ci < 2; ++ci)
#pragma unroll
            for (int q = 0; q < 4; ++q) {
                const int c0 = g * 128 + wc * 64 + ci * 32 + 8 * q + 4 * c.hl;
                uq[ii][ci][q] = *(const u32x2*)(MU + tok * 512 + c0); gq[ii][ci][q] = *(const u32x2*)(MG + tok * 512 + c0);
            }
    }
#pragma unroll
    for (int ii = 0; ii < 2; ++ii) {
        const int i = wi * 64 + ii * 32 + c.l31;
        const size_t tok = tok0 + i;
        const float bs = bsq[ii];
#pragma unroll
        for (int ci = 0; ci < 2; ++ci)
#pragma unroll
            for (int q = 0; q < 4; ++q) {
                const int c0 = g * 128 + wc * 64 + ci * 32 + 8 * q + 4 * c.hl;
                const u32x2 u = uq[ii][ci][q], gg = gq[ii][ci][q];
                u32x2 ov;
                ov[0] = pk2(bflo(u[0]) * (acc[ci][ii][4 * q + 0] + bs) * bflo(gg[0]), bfhi(u[0]) * (acc[ci][ii][4 * q + 1] + bs) * bfhi(gg[0]));
                ov[1] = pk2(bflo(u[1]) * (acc[ci][ii][4 * q + 2] + bs) * bflo(gg[1]), bfhi(u[1]) * (acc[ci][ii][4 * q + 3] + bs) * bfhi(gg[1]));
                *(u32x2*)(OM + tok * 512 + c0) = ov;
            }
    }
}

DI void retout_item(const Ctx& c, int l, int bl, int h, int m) {
    bf16_t* Ks = (bf16_t*)c.smem;
    bf16_t* Vs = Ks + 128 * 136;
    const size_t tok0 = (size_t)bl * PP + m * 128;
    const bf16_t* RK = (const bf16_t*)(c.ws + OFF_RK) + tok0 * 512 + h * 128;
    const bf16_t* RVT = (const bf16_t*)(c.ws + OFF_RVT) + (size_t)(bl * 4 + h) * 128 * PP + m * 128;
    __syncthreads();
    {
        u32x4 tk[8], tv[8];
#pragma unroll
        for (int it = 0; it < 8; ++it) {
            const int idx = c.tid + 256 * it, row = idx >> 4, seg = idx & 15;
            tk[it] = *(const u32x4*)(RK + (size_t)row * 512 + seg * 8);
            tv[it] = *(const u32x4*)(RVT + (size_t)row * PP + seg * 8);
        }
#pragma unroll
        for (int it = 0; it < 8; ++it) {
            const int idx = c.tid + 256 * it, row = idx >> 4, seg = idx & 15;
            *(u32x4*)(Ks + row * 136 + seg * 8) = tk[it];
            u32x2 lo2, hi2; lo2[0] = tv[it][0]; lo2[1] = tv[it][1]; hi2[0] = tv[it][2]; hi2[1] = tv[it][3];
            *(u32x2*)(Vs + row * 132 + seg * 8) = lo2; *(u32x2*)(Vs + row * 132 + seg * 8 + 4) = hi2;
        }
    }
    __syncthreads();
    const int i = c.w * 32 + c.l31;
    const size_t tok = tok0 + i;
    const float lgf = c.cst[4 + l * 8 + h], lgb = c.cst[4 + l * 8 + 4 + h];
    bf16x8 qf[8];
    const bf16_t* RQ = (const bf16_t*)(c.ws + OFF_RQ) + tok * 512 + h * 128;
#pragma unroll
    for (int ks = 0; ks < 8; ++ks) qf[ks] = *(const bf16x8*)(RQ + ks * 16 + c.hl * 8);
    f32x16 o[4];
    const bf16_t* stf = (const bf16_t*)(c.ws + OFF_ST) + (size_t)(((bl * 4 + h) * 2 + 0) * NCH + m) * 16384;
    const bf16_t* stb = (const bf16_t*)(c.ws + OFF_ST) + (size_t)(((bl * 4 + h) * 2 + 1) * NCH + m) * 16384;
    const float qdf = __builtin_amdgcn_exp2f(lgf * (float)(i + 1)), qdb = __builtin_amdgcn_exp2f(lgb * (float)(128 - i));
#pragma unroll
    for (int et = 0; et < 4; ++et) {
        f32x16 tf, tb;
#pragma unroll
        for (int r = 0; r < 16; ++r) { tf[r] = 0.f; tb[r] = 0.f; }
        bf16x8 sa[8], sb[8];
#pragma unroll
        for (int ks = 0; ks < 8; ++ks) {
            sa[ks] = *(const bf16x8*)(stf + (et * 32 + c.l31) * 128 + ks * 16 + c.hl * 8);
            sb[ks] = *(const bf16x8*)(stb + (et * 32 + c.l31) * 128 + ks * 16 + c.hl * 8);
        }
#pragma unroll
        for (int ks = 0; ks < 8; ++ks) {
            tf = MFMA(sa[ks], qf[ks], tf);
            tb = MFMA(sb[ks], qf[ks], tb);
        }
#pragma unroll
        for (int r = 0; r < 16; ++r) o[et][r] = tf[r] * qdf + tb[r] * qdb;
        __builtin_amdgcn_sched_barrier(0);
    }
#pragma unroll
    for (int jt = 0; jt < 4; ++jt) {
        f32x16 sc;
#pragma unroll
        for (int r = 0; r < 16; ++r) sc[r] = 0.f;
#pragma unroll
        for (int ks = 0; ks < 8; ++ks) {
            const bf16x8 a = *(const bf16x8*)(Ks + (jt * 32 + c.l31) * 136 + ks * 16 + c.hl * 8);
            sc = MFMA(a, qf[ks], sc);
        }
#pragma unroll
        for (int r = 0; r < 16; ++r) {
            const int j = jt * 32 + crow(r, c.hl);
            const int dl = i - j;
            const float arg = dl > 0 ? lgf * (float)dl : -lgb * (float)dl;
            float f = __builtin_amdgcn_exp2f(arg);
            f = dl == 0 ? 2.f : f;
            sc[r] *= f;
        }
#pragma unroll
        for (int s2 = 0; s2 < 2; ++s2) {
            u32x4 pp;
            pp[0] = pk2(sc[8 * s2 + 0], sc[8 * s2 + 1]); pp[1] = pk2(sc[8 * s2 + 2], sc[8 * s2 + 3]);
            pp[2] = pk2(sc[8 * s2 + 4], sc[8 * s2 + 5]); pp[3] = pk2(sc[8 * s2 + 6], sc[8 * s2 + 7]);
            const bf16x8 pf = __builtin_bit_cast(bf16x8, pp);
#pragma unroll
            for (int et = 0; et < 4; ++et) {
                const bf16_t* vp = Vs + (et * 32 + c.l31) * 132 + jt * 32 + 16 * s2 + 4 * c.hl;
                const u32x2 lo = *(const u32x2*)vp, hi = *(const u32x2*)(vp + 8);
                u32x4 av; av[0] = lo[0]; av[1] = lo[1]; av[2] = hi[0]; av[3] = hi[1];
                o[et] = MFMA(__builtin_bit_cast(bf16x8, av), pf, o[et]);
            }
        }
        __builtin_amdgcn_sched_barrier(0);
    }
    float ss = 0.f;
#pragma unroll
    for (int et = 0; et < 4; ++et)
#pragma unroll
        for (int r = 0; r < 16; ++r) ss += o[et][r] * o[et][r];
    ss += __shfl_xor(ss, 32);
    const float rn = rsqrtf(ss * (1.f / 128.f) + EPS);
    const bf16_t* RG = (const bf16_t*)(c.ws + OFF_RG) + tok * 512 + h * 128;
    bf16_t* OR = (bf16_t*)(c.ws + OFF_ORET) + tok * 512 + h * 128;
#pragma unroll
    for (int et = 0; et < 4; ++et)
#pragma unroll
        for (int q = 0; q < 4; ++q) {
            const int e0 = et * 32 + 8 * q + 4 * c.hl;
            const u32x2 g = *(const u32x2*)(RG + e0);
            u32x2 ov;
            ov[0] = pk2(o[et][4 * q + 0] * rn * bflo(g[0]), o[et][4 * q + 1] * rn * bfhi(g[0]));
            ov[1] = pk2(o[et][4 * q + 2] * rn * bflo(g[1]), o[et][4 * q + 3] * rn * bfhi(g[1]));
            *(u32x2*)(OR + e0) = ov;
        }
}

DI void pm_item(const Ctx& c, int l, int rt, int nt) {
    f32x16 y[2][2], acc[2][2];
    zero_acc(y);
    const int wn = c.w >> 1, wm = c.w & 1;
    const bf16_t* MLOG = (const bf16_t*)(c.ws + OFF_MLOG);
#pragma unroll 1
    for (int br = 0; br < 3; ++br) {
        const size_t ooff = br == 0 ? OFF_ORET : (br == 1 ? OFF_OMLP : OFF_ODIFF);
        zero_acc(acc);
        gemm_core(c, (const bf16_t*)(c.ws + OFF_WBO) + ((size_t)(l * 3 + br) * 1024 + (size_t)nt * 128) * 512, 512,
                  (const bf16_t*)(c.ws + ooff) + (size_t)rt * 128 * 512, 512, 512, acc);
#pragma unroll
        for (int j = 0; j < 2; ++j) {
            const size_t tok = (size_t)rt * 128 + wm * 64 + j * 32 + c.l31;
#pragma unroll
            for (int i = 0; i < 2; ++i)
#pragma unroll
                for (int q = 0; q < 4; ++q) {
                    const int n0 = nt * 128 + wn * 64 + i * 32 + 8 * q + 4 * c.hl;
                    const u32x2 g = *(const u32x2*)(MLOG + tok * 3072 + br * 1024 + n0);
                    y[i][j][4 * q + 0] += bflo(g[0]) * acc[i][j][4 * q + 0];
                    y[i][j][4 * q + 1] += bfhi(g[0]) * acc[i][j][4 * q + 1];
                    y[i][j][4 * q + 2] += bflo(g[1]) * acc[i][j][4 * q + 2];
                    y[i][j][4 * q + 3] += bfhi(g[1]) * acc[i][j][4 * q + 3];
                }
        }
    }
    bf16_t* Y = (bf16_t*)(c.ws + OFF_Y);
#pragma unroll
    for (int j = 0; j < 2; ++j) {
        const size_t tok = (size_t)rt * 128 + wm * 64 + j * 32 + c.l31;
#pragma unroll
        for (int i = 0; i < 2; ++i)
#pragma unroll
            for (int q = 0; q < 4; ++q) {
                const int n0 = nt * 128 + wn * 64 + i * 32 + 8 * q + 4 * c.hl;
                u32x2 ov; ov[0] = pk2(y[i][j][4 * q + 0], y[i][j][4 * q + 1]); ov[1] = pk2(y[i][j][4 * q + 2], y[i][j][4 * q + 3]);
                *(u32x2*)(Y + tok * 1024 + n0) = ov;
            }
    }
}
DI void po_item(const Ctx& c, int l, int rt2, int nt) {
    f32x16 acc[2][4];
    zero_acc2(acc);
    gemm_core2(c, (const bf16_t*)(c.ws + OFF_WO) + ((size_t)l * 1024 + (size_t)nt * 128) * 1024, 1024,
               (const bf16_t*)(c.ws + OFF_Y) + (size_t)rt2 * 256 * 1024, 1024, 1024, acc);
    const int wn = c.w >> 1, wm = c.w & 1;
    float* OUT = (float*)(c.ws + OFF_OUT);
#pragma unroll
    for (int j = 0; j < 4; ++j) {
        const size_t tok = (size_t)rt2 * 256 + wm * 128 + j * 32 + c.l31;
#pragma unroll
        for (int i = 0; i < 2; ++i)
#pragma unroll
            for (int q = 0; q < 4; ++q) {
                const int n0 = nt * 128 + wn * 64 + i * 32 + 8 * q + 4 * c.hl;
                f32x4 ov; ov[0] = acc[i][j][4 * q + 0]; ov[1] = acc[i][j][4 * q + 1]; ov[2] = acc[i][j][4 * q + 2]; ov[3] = acc[i][j][4 * q + 3];
                *(f32x4*)(OUT + tok * 1024 + n0) = ov;
            }
    }
}

extern __shared__ __attribute__((aligned(16))) unsigned char dynsmem[];
constexpr int LDS_BYTES = 72 * 1024;

DI Ctx mk_ctx(const Params& p, const float* cst, int wv) {
    Ctx c;
    c.x = p.in[0]; c.c = p.in[1]; c.ctx = p.in[2]; c.c_ctx = p.in[3]; c.w_mod = p.in[4]; c.b_mod = p.in[5]; c.g_pre = p.in[6]; c.g_post = p.in[7];
    c.w_in = p.in[8]; c.decay = p.in[9]; c.w_s = p.in[10]; c.b_s = p.in[11]; c.lq = p.in[12]; c.lk = p.in[13]; c.w_bo = p.in[14]; c.w_out = p.in[15];
    c.out = p.out; c.ws = p.ws; c.smem = dynsmem; c.cst = cst;
    unsigned zl = 0u;
    asm volatile("" : "+v"(zl));
    int tid = wv * 64 + (int)__builtin_amdgcn_mbcnt_hi(~0u, __builtin_amdgcn_mbcnt_lo(~0u, zl));
    asm volatile("" : "+v"(tid));
    size_t zoff = 0;
    asm volatile("" : "+s"(zoff));
    c.ws = p.ws + zoff;
    c.tid = tid; c.lane = tid & 63; c.w = tid >> 6; c.l31 = c.lane & 31; c.hl = c.lane >> 5;
    return c;
}
DI void relaunder(Ctx& c) {
    int t = c.tid;
    asm volatile("" : "+v"(t));
    c.tid = t; c.lane = t & 63; c.w = t >> 6; c.l31 = c.lane & 31; c.hl = c.lane >> 5;
}

__global__ void __launch_bounds__(256, 2) mega(Params p) {
    __shared__ uint4 xbw;
    __shared__ float cst[32];
    const int wv = __builtin_amdgcn_readfirstlane((int)threadIdx.x >> 6);
    Ctx c = mk_ctx(p, cst, wv);
    if (c.tid == 0) xbw = make_uint4(0u, 0u, 0u, 0u);
    if (c.tid < 64) {
        for (int l = 0; l < 2; ++l) {
            float a = c.lq[(l * 2 + 0) * 64 + c.tid] * c.lk[(l * 2 + 0) * 64 + c.tid];
            float b = c.lq[(l * 2 + 1) * 64 + c.tid] * c.lk[(l * 2 + 1) * 64 + c.tid];
            a = wave_sum(a); b = wave_sum(b);
            const float lam_init = 0.8f - 0.6f * expf(-0.3f * (float)l);
            if (c.tid == 0) { cst[l] = expf(a) - expf(b) + lam_init; cst[2 + l] = lam_init; }
        }
        if (c.tid < 16) {
            const float z = c.decay[c.tid];
            cst[4 + c.tid] = -log1pf(expf(-z)) * LOG2E;
        }
    }
    __syncthreads();
    XcdBarrier bar = xcd_barrier_post((unsigned*)(p.ws + OFF_BAR), (volatile LAS unsigned*)&xbw, c.tid == 0);
    const int G = gridDim.x, bid = blockIdx.x;
    constexpr int NPH = 2 + NGRP * 12;
#pragma unroll 1
    for (int ph = 0; ph < NPH; ++ph) {
        c = mk_ctx(p, cst, wv);
        int kind, g = 0, l = 0;
        if (ph == 0) kind = 0;
        else if (ph == 1) kind = 1;
        else { const int q = ph - 2; g = q / 12; const int r = q % 12; l = r / 6; kind = 2 + r % 6; }
#ifndef ECHO_KIND
#define ECHO_KIND -1
#endif
        const unsigned long long tph0 = (ECHO_KIND >= 0) ? __builtin_amdgcn_s_memrealtime() : 0ull;
        switch (kind) {
        case 0:
#pragma unroll 1
            for (int it = bid; it < 2 * 1408 + 192; it += G) { relaunder(c); p0_item(c, it); }
            break;
        case 1:
#pragma unroll 1
            for (int it = bid; it < NT / 4; it += G) { relaunder(c); ph_item(c, g, it); }
            break;
        case 2:
            if ((G & 7) == 0) {
                const int x = bid & 7, jl = bid >> 3, GL = G >> 3;
#pragma unroll 1
                for (int k = jl; k < 306; k += GL) {
                    int ct, rt2;
                    if (k < 288) { ct = 8 * (k & 7) + x; rt2 = k >> 3; }
                    else { ct = 64 + (x >> 1); rt2 = (x & 1) * 18 + (k - 288); }
                    if (l == 1 && (rt2 % 9) == 0 && ct >= 16) continue;
                    relaunder(c);
                    pz_item(c, l, rt2, ct);
                }
            } else {
#pragma unroll 1
                for (int it = bid; it < 36 * 68; it += G) {
                    const int ct = it % 68, rt2 = it / 68;
                    if (l == 1 && (rt2 % 9) == 0 && ct >= 16) continue;
                    relaunder(c);
                    pz_item(c, l, rt2, ct);
                }
            }
            break;
        case 3: {
            const int n_att = 512, n_catt = (l == 0) ? 64 : 0, n_scan = 128, n_mlp = (l == 0) ? 288 : 256;
            const int total = n_att + n_catt + n_scan + n_mlp;
#pragma unroll 1
            for (int it = bid; it < total; it += G) {
                int r = it;
                relaunder(c);
                if (r < n_att + n_catt) {
                    int bl, h, q0, nk;
                    if (r < n_att) {
                        int pr, qb;
                        if ((G & 7) == 0) { const int x = r & 7, k = r >> 3; pr = 2 * x + (k >> 5); qb = k & 31; } else { pr = r >> 5; qb = r & 31; }
                        bl = pr >> 2; h = pr & 3; q0 = CTXL + qb * 64; nk = PP;
                    }
                    else { r -= n_att; bl = r >> 4; h = (r >> 2) & 3; q0 = (r & 3) * 64; nk = CTXL; }
                    attn_item(c, l, bl, h, q0, nk);
                    continue;
                }
                r -= n_att + n_catt;
                if (r < n_scan) {
                    int pr, sub;
                    if ((G & 7) == 0) { const int x = r & 7, k = r >> 3; pr = 2 * x + (k >> 3); sub = k & 7; } else { pr = r >> 3; sub = r & 7; }
                    scan_item(c, l, pr >> 2, pr & 3, sub >> 2, sub & 3); continue;
                }
                r -= n_scan;
                int bl, m, gg;
                int grp;
                if ((G & 7) == 0) { const int x = r & 7, k = r >> 3; grp = x + 8 * (k >> 2); gg = k & 3; } else { grp = r >> 2; gg = r & 3; }
                if (l == 0) { bl = grp / 18; m = grp % 18; }
                else { bl = grp >> 4; m = 2 + (grp & 15); }
                mlp_item(c, l, bl, m, gg);
            }
            break; }
        case 4: {
            const int total = (l == 0) ? 288 : 256;
#pragma unroll 1
            for (int it = bid; it < total; it += G) {
                int bl, m, h;
                if (l == 0) { bl = it / 72; const int q = it % 72; h = q & 3; m = q >> 2; }
                else { bl = it >> 6; const int q = it & 63; h = q & 3; m = 2 + (q >> 2); }
                relaunder(c);
                retout_item(c, l, bl, h, m);
            }
            break; }
        case 5: {
            const int nrt = (l == 0) ? 72 : 64;
#pragma unroll 1
            for (int it = bid; it < nrt * 8; it += G) {
                const int nt = it & 7, rr = it >> 3;
                const int rt = (l == 0) ? rr : (rr >> 4) * NCH + 2 + (rr & 15);
                relaunder(c);
                pm_item(c, l, rt, nt);
            }
            break; }
        case 6: {
            const int nrt = (l == 0) ? 72 : 64;
#pragma unroll 1
            for (int it0 = bid; it0 < (nrt / 2) * 8; it0 += G) {
                int nt = it0 & 7, rr = it0 >> 3;
                if ((G & 7) == 0) {
                    const int x = it0 & 7, k = it0 >> 3;
                    if (k < 32) { rr = x + 8 * (k >> 3); nt = k & 7; }
                    else { rr = 32 + (x >> 1); nt = (x & 1) * 4 + (k - 32); }
                }
                const int rt2 = (l == 0) ? rr : (rr >> 3) * 9 + 1 + (rr & 7);
                relaunder(c);
                po_item(c, l, rt2, nt);
            }
            break; }
        default:
#pragma unroll 1
            for (int it = bid; it < NT / 4; it += G) { relaunder(c); pr_item(c, l, g, it); }
            if (g + 1 < NGRP && l == 1) {
#pragma unroll 1
                for (int it = bid; it < NT / 4; it += G) { relaunder(c); ph_item(c, g + 1, it); }
            }
            break;
        }
        if (ECHO_KIND >= 0 && kind == ECHO_KIND) { __syncthreads(); const unsigned long long tb = __builtin_amdgcn_s_memrealtime(), dt = tb - tph0; while (__builtin_amdgcn_s_memrealtime() - tb < dt) __builtin_amdgcn_s_sleep(8); }
        if (ph + 1 < NPH) xcd_barrier(bar, c.tid == 0);
    }
}

extern "C" void kernel_launch(void* const* d_in, const int* in_sizes, int n_in, void* d_out, int out_size, void* d_ws, size_t ws_size, hipStream_t stream) {
    static int grid = 0;
    if (grid == 0) {
        int dev = 0, cus = 0, per_cu = 0;
        hipGetDevice(&dev);
        hipDeviceGetAttribute(&cus, hipDeviceAttributeMultiprocessorCount, dev);
        hipFuncSetAttribute((const void*)mega, hipFuncAttributeMaxDynamicSharedMemorySize, LDS_BYTES);
        hipOccupancyMaxActiveBlocksPerMultiprocessor(&per_cu, (const void*)mega, 256, LDS_BYTES);
        if (per_cu > 2) per_cu = 2;
        if (per_cu < 1) per_cu = 1;
        grid = cus * per_cu;
        if (ws_size < WS_END) { fprintf(stderr, "workspace too small: %zu < %zu\n", ws_size, (size_t)WS_END); grid = -1; }
    }
    if (grid < 0) return;
    hipMemsetAsync((unsigned char*)d_ws + OFF_BAR, 0, XCD_BAR_WORDS * 4, stream);
    Params p{};
    for (int i = 0; i < 16; ++i) p.in[i] = (const float*)d_in[i];
    p.out = (float*)d_out; p.ws = (unsigned char*)d_ws;
    void* args[] = {&p};
    hipError_t e = hipLaunchCooperativeKernel((const void*)mega, dim3(grid), dim3(256), args, LDS_BYTES, stream);
    if (e != hipSuccess) fprintf(stderr, "cooperative launch failed: %s (grid %d)\n", hipGetErrorString(e), grid);
}
```

```cpp
#include <hip/hip_runtime.h>
#include <cstdio>
#include <cstdint>

#define DI __device__ __forceinline__
#define LAS __attribute__((address_space(3)))
typedef unsigned short bf16_t;
typedef short bf16x8 __attribute__((ext_vector_type(8)));
typedef float f32x16 __attribute__((ext_vector_type(16)));
typedef float f32x4 __attribute__((ext_vector_type(4)));
typedef float f32x2 __attribute__((ext_vector_type(2)));
typedef unsigned u32x4 __attribute__((ext_vector_type(4)));
typedef unsigned u32x2 __attribute__((ext_vector_type(2)));
#define MFMA(a, b, c) __builtin_amdgcn_mfma_f32_32x32x16_bf16((a), (b), (c), 0, 0, 0)

#define XB_TMO      128
#define XB_XCNT(j)  (256  + 64 * (j))
#define XB_XSUB(j)  (1280 + 64 * (j))
#define XB_XGEN(j)  (2304 + 64 * (j))
#define XB_TOP      3328
#define XB_TOPGEN   3392
#define XCD_BAR_WORDS 3456
#define XB_SPIN_CAP (1u << 22)
DI unsigned xb_ld(unsigned* p)              { return __hip_atomic_load(p, __ATOMIC_RELAXED, __HIP_MEMORY_SCOPE_AGENT); }
DI unsigned xb_add(unsigned* p, unsigned v) { return __hip_atomic_fetch_add(p, v, __ATOMIC_RELAXED, __HIP_MEMORY_SCOPE_AGENT); }
DI unsigned xb_xcc_id() { return (unsigned)__builtin_amdgcn_s_getreg((3 << 11) | 20) & 0xFu; }
#define XB_SPIN(cond, bar) do { unsigned _sp = 0; while (cond) { __builtin_amdgcn_s_sleep(1); \
    if ((++_sp & 255u) == 0u) { if (xb_ld(&(bar)[XB_TMO])) break; if (_sp > XB_SPIN_CAP) { atomicAdd(&(bar)[XB_TMO], 1u); break; } } } } while (0)
struct XcdBarrier { unsigned* bar; unsigned x; volatile LAS unsigned* st; };
DI XcdBarrier xcd_barrier_post(unsigned* bar, volatile LAS unsigned* st, bool t0) {
    XcdBarrier b; b.bar = bar; b.x = xb_xcc_id(); b.st = st;
    if (t0) (void)xb_add(&bar[XB_XCNT(b.x)], 1u);
    return b;
}
DI void xcd_barrier_complete(unsigned* bar, unsigned x, unsigned& nloc, unsigned& nx) {
    const unsigned G = gridDim.x * gridDim.y * gridDim.z;
    unsigned sum, cnt, mine, sp = 0u;
    for (;;) {
        sum = 0u; cnt = 0u; mine = 0u;
#pragma unroll
        for (unsigned j = 0; j < 16; ++j) { const unsigned c = xb_ld(&bar[XB_XCNT(j)]); sum += c; cnt += (c > 0u) ? 1u : 0u; mine = (j == x) ? c : mine; }
        if (sum == G) break;
        __builtin_amdgcn_s_sleep(1);
        if ((++sp & 255u) == 0u) { if (xb_ld(&bar[XB_TMO])) break; if (sp > XB_SPIN_CAP) { atomicAdd(&bar[XB_TMO], 1u); break; } }
    }
    nloc = mine > 0u ? mine : 1u; nx = cnt > 0u ? cnt : 1u;
}
DI void xcd_barrier(const XcdBarrier& b, bool t0) {
    asm volatile("s_waitcnt vmcnt(0)" ::: "memory");
    __syncthreads();
    if (t0) {
        unsigned* bar = b.bar;
        __builtin_amdgcn_s_waitcnt(0);
        unsigned nloc = b.st[0], nx = b.st[1];
        if (nloc == 0u) { xcd_barrier_complete(bar, b.x, nloc, nx); b.st[0] = nloc; b.st[1] = nx; }
        const unsigned old = xb_add(&bar[XB_XSUB(b.x)], 1u);
        const unsigned gen = old / nloc;
        if (old + 1u == (gen + 1u) * nloc) {
            __builtin_amdgcn_fence(__ATOMIC_RELEASE, "agent");
            asm volatile("s_waitcnt vmcnt(0)" ::: "memory");
            const unsigned og = xb_add(&bar[XB_TOP], 1u);
            const unsigned tg = og / nx;
            if (og + 1u == (tg + 1u) * nx) xb_add(&bar[XB_TOPGEN], 1u);
            else XB_SPIN(xb_ld(&bar[XB_TOPGEN]) == tg, bar);
            __builtin_amdgcn_fence(__ATOMIC_ACQUIRE, "agent");
            xb_add(&bar[XB_XGEN(b.x)], 1u);
            asm volatile("s_waitcnt vmcnt(0)" ::: "memory");
        } else {
            XB_SPIN(xb_ld(&bar[XB_XGEN(b.x)]) == gen, bar);
            __builtin_amdgcn_fence(__ATOMIC_ACQUIRE, "agent");
            asm volatile("s_waitcnt vmcnt(0)" ::: "memory");
        }
    }
    __syncthreads();
}

constexpr int DM = 1024, SEQL = 2048, CTXL = 256, PP = 2304  ;
constexpr int NBG = 4  , NGRP = 2, NT = NBG * PP  ;
constexpr int INC = 8704, NCH = 18  ;
constexpr int LDH = 1088, LDW = 1088;
constexpr float EPS = 1e-6f;
constexpr float LOG2E = 1.4426950408889634f;

constexpr size_t TB = (size_t)NT * 512 * 2;
constexpr size_t OFF_BAR = 0;
constexpr size_t OFF_MOD = 16384;
constexpr size_t OFF_WIN = OFF_MOD + 262144;
constexpr size_t OFF_WBO = OFF_WIN + (size_t)2 * INC * LDW * 2;
constexpr size_t OFF_WO  = OFF_WBO + (size_t)2 * 3 * 1024 * 512 * 2;
constexpr size_t OFF_H   = OFF_WO + (size_t)2 * 1024 * 1024 * 2;
constexpr size_t OFF_RK  = OFF_H + (size_t)NT * LDH * 2;
constexpr size_t OFF_RKT = OFF_RK + TB;
constexpr size_t OFF_RVT = OFF_RKT + TB;
constexpr size_t OFF_DK  = OFF_RVT + TB;
constexpr size_t OFF_DVT = OFF_DK + TB;
constexpr size_t OFF_RQ  = OFF_DVT + TB;
constexpr size_t OFF_RG  = OFF_RQ + TB;
constexpr size_t OFF_DQ  = OFF_RG + TB;
constexpr size_t OFF_DG  = OFF_DQ + TB;
constexpr size_t OFF_MU  = OFF_DG + TB;
constexpr size_t OFF_MV  = OFF_MU + TB;
constexpr size_t OFF_MG  = OFF_MV + TB;
constexpr size_t OFF_MLOG = OFF_MG + TB;
constexpr size_t OFF_OMLP = OFF_MLOG + 6 * TB;
constexpr size_t OFF_ODIFF = OFF_OMLP + TB;
constexpr size_t OFF_ROPE = OFF_ODIFF + TB;
constexpr size_t WS_END = OFF_ROPE + (size_t)2048 * 96 * 8;
constexpr size_t OFF_ST = OFF_H;
constexpr size_t OFF_ORET = OFF_DK;
constexpr size_t OFF_Y = OFF_RK;
constexpr size_t OFF_OUT = OFF_MLOG;

struct Params {
    const float* in[16];
    float* out;
    unsigned char* ws;
};

struct Ctx {
    const float *x, *c, *ctx, *c_ctx, *w_mod, *b_mod, *g_pre, *g_post, *w_in, *decay, *w_s, *b_s, *lq, *lk, *w_bo, *w_out;
    float* out;
    unsigned char* ws;
    unsigned char* smem;
    const float* cst;
    int tid, lane, w, l31, hl;
};

DI unsigned pk2(float lo, float hi) {
    typedef __bf16 b2 __attribute__((ext_vector_type(2)));
    f32x2 v = {lo, hi};
    b2 r = __builtin_convertvector(v, b2);
    return __builtin_bit_cast(unsigned, r);
}
DI bf16_t f2bf(float x) { return (bf16_t)(pk2(x, 0.f) & 0xffffu); }
DI float bflo(unsigned u) { return __uint_as_float(u << 16); }
DI float bfhi(unsigned u) { return __uint_as_float(u & 0xffff0000u); }
DI int crow(int r, int hl) { return (r & 3) + 8 * (r >> 2) + 4 * hl; }
DI float wave_sum(float v) {
#pragma unroll
    for (int o = 1; o < 64; o <<= 1) v += __shfl_xor(v, o);
    return v;
}
DI float fsig(float x) { return __builtin_amdgcn_rcpf(1.f + __builtin_amdgcn_exp2f(-LOG2E * x)); }
DI void sincos_rev(float rev, float& sn, float& cs) {
    const float g = __builtin_amdgcn_fractf(rev) - 0.5f;
    const bool fold = fabsf(g) > 0.25f;
    const float h = fold ? (copysignf(0.5f, g) - g) : g;
    const float x = h * 6.283185307179586f;
    const float x2 = x * x;
    const float sp = x * (1.f + x2 * (-1.6666667e-1f + x2 * (8.3333333e-3f + x2 * (-1.9841270e-4f + x2 * (2.7557319e-6f - x2 * 2.5052108e-8f)))));
    const float cp = 1.f + x2 * (-0.5f + x2 * (4.1666667e-2f + x2 * (-1.3888889e-3f + x2 * (2.4801587e-5f + x2 * (-2.7557319e-7f + x2 * 2.0876757e-9f)))));
    sn = -sp;
    cs = fold ? cp : -cp;
}
DI float silu_f(float x) { return x / (1.f + __expf(-x)); }
DI float sigmoid_f(float x) { return 1.f / (1.f + __expf(-x)); }

DI void gemm_core(const Ctx& c, const bf16_t* __restrict__ Wt, int ldw, const bf16_t* __restrict__ Act, int lda, int K, f32x16 (&acc)[2][2]) {
    bf16_t* Ws = (bf16_t*)c.smem;
    bf16_t* As = Ws + 128 * 72;
    const int wn = c.w >> 1, wm = c.w & 1;
    const int lrow = c.tid >> 3, lseg = c.tid & 7;
    u32x4 rw[4], ra[4];
#pragma unroll
    for (int it = 0; it < 4; ++it) {
        rw[it] = *(const u32x4*)(Wt + (size_t)(lrow + 32 * it) * ldw + lseg * 8);
        ra[it] = *(const u32x4*)(Act + (size_t)(lrow + 32 * it) * lda + lseg * 8);
    }
    for (int k0 = 0; k0 < K; k0 += 64) {
        __syncthreads();
#pragma unroll
        for (int it = 0; it < 4; ++it) {
            *(u32x4*)(Ws + (lrow + 32 * it) * 72 + lseg * 8) = rw[it];
            *(u32x4*)(As + (lrow + 32 * it) * 72 + lseg * 8) = ra[it];
        }
        __syncthreads();
        if (k0 + 64 < K) {
#pragma unroll
            for (int it = 0; it < 4; ++it) {
                rw[it] = *(const u32x4*)(Wt + (size_t)(lrow + 32 * it) * ldw + k0 + 64 + lseg * 8);
                ra[it] = *(const u32x4*)(Act + (size_t)(lrow + 32 * it) * lda + k0 + 64 + lseg * 8);
            }
        }
#pragma unroll
        for (int ks = 0; ks < 4; ++ks) {
            const bf16x8 a0 = *(const bf16x8*)(Ws + (wn * 64 + c.l31) * 72 + ks * 16 + c.hl * 8);
            const bf16x8 a1 = *(const bf16x8*)(Ws + (wn * 64 + 32 + c.l31) * 72 + ks * 16 + c.hl * 8);
            const bf16x8 b0 = *(const bf16x8*)(As + (wm * 64 + c.l31) * 72 + ks * 16 + c.hl * 8);
            const bf16x8 b1 = *(const bf16x8*)(As + (wm * 64 + 32 + c.l31) * 72 + ks * 16 + c.hl * 8);
            acc[0][0] = MFMA(a0, b0, acc[0][0]);
            acc[0][1] = MFMA(a0, b1, acc[0][1]);
            acc[1][0] = MFMA(a1, b0, acc[1][0]);
            acc[1][1] = MFMA(a1, b1, acc[1][1]);
        }
    }
}
DI void zero_acc(f32x16 (&acc)[2][2]) {
#pragma unroll
    for (int i = 0; i < 2; ++i)
#pragma unroll
        for (int j = 0; j < 2; ++j)
#pragma unroll
            for (int r = 0; r < 16; ++r) acc[i][j][r] = 0.f;
}


DI void gemm_core2(const Ctx& c, const bf16_t* __restrict__ Wt, int ldw, const bf16_t* __restrict__ Act, int lda, int K, f32x16 (&acc)[2][4]) {
    constexpr int RS = 32;
    constexpr int STG = 384 * RS;
    bf16_t* S = (bf16_t*)c.smem;
    const int wn = c.w >> 1, wm = c.w & 1;
    const int rsw = (c.l31 >> 2) & 3;
    const int ro = c.lane >> 2, lc = (c.lane & 3) ^ ((c.lane >> 4) & 3);
    const bf16_t* wsrc = Wt + (size_t)(c.w * 16 + ro) * ldw + lc * 8;
    const bf16_t* asrc = Act + (size_t)(c.w * 16 + ro) * lda + lc * 8;
#define G2_GLDS(SP, KOFF) { \
        _Pragma("unroll") for (int i = 0; i < 2; ++i) __builtin_amdgcn_global_load_lds((const unsigned*)(wsrc + (size_t)(64 * i) * ldw + (KOFF)), (unsigned*)((SP) + (c.w + 4 * i) * 512), 16, 0, 0); \
        _Pragma("unroll") for (int i = 0; i < 4; ++i) __builtin_amdgcn_global_load_lds((const unsigned*)(asrc + (size_t)(64 * i) * lda + (KOFF)), (unsigned*)((SP) + (8 + c.w + 4 * i) * 512), 16, 0, 0); }
    __syncthreads();
    G2_GLDS(S, 0)
    asm volatile("s_waitcnt vmcnt(0)" ::: "memory");
    __syncthreads();
    for (int k0 = 0; k0 < K; k0 += 32) {
        const int s = (k0 >> 5) & 1;
        bf16_t* Sc = S + s * STG;
        bf16_t* Sn = S + (s ^ 1) * STG;
        if (k0 + 32 < K) G2_GLDS(Sn, k0 + 32)
#pragma unroll
        for (int ks = 0; ks < 2; ++ks) {
            const int rcol = ((ks * 2 + c.hl) ^ rsw) * 8;
            bf16x8 a[2], b[4];
#pragma unroll
            for (int i = 0; i < 2; ++i) a[i] = *(const bf16x8*)(Sc + (wn * 64 + i * 32 + c.l31) * RS + rcol);
#pragma unroll
            for (int j = 0; j < 4; ++j) b[j] = *(const bf16x8*)(Sc + (128 + wm * 128 + j * 32 + c.l31) * RS + rcol);
#pragma unroll
            for (int i = 0; i < 2; ++i)
#pragma unroll
                for (int j = 0; j < 4; ++j) acc[i][j] = MFMA(a[i], b[j], acc[i][j]);
        }
        asm volatile("s_waitcnt vmcnt(0)" ::: "memory");
        __syncthreads();
    }
#undef G2_GLDS
}
DI void zero_acc2(f32x16 (&acc)[2][4]) {
#pragma unroll
    for (int i = 0; i < 2; ++i)
#pragma unroll
        for (int j = 0; j < 4; ++j)
#pragma unroll
            for (int r = 0; r < 16; ++r) acc[i][j][r] = 0.f;
}

DI void transpose_item(const Ctx& c, const float* __restrict__ src, int N, int k0, int n0, int mapk, bf16_t* __restrict__ dst, int ldk) {
    float* T = (float*)c.smem;
    __syncthreads();
    {
        f32x4 tv[8];
#pragma unroll
        for (int it = 0; it < 8; ++it) { const int idx = c.tid + 256 * it; tv[it] = __builtin_nontemporal_load((const f32x4*)(src + (size_t)(k0 + (idx >> 5)) * N + n0 + (idx & 31) * 4)); }
#pragma unroll
        for (int it = 0; it < 8; ++it) {
            const int idx = c.tid + 256 * it, r = idx >> 5, c4 = idx & 31;
            float* t = T + r * 129 + c4 * 4;
            t[0] = tv[it][0]; t[1] = tv[it][1]; t[2] = tv[it][2]; t[3] = tv[it][3];
        }
    }
    __syncthreads();
#pragma unroll
    for (int it = 0; it < 4; ++it) {
        const int idx = c.tid + 256 * it, np = idx >> 3, ch = idx & 7;
        int cs = np;
        if (mapk == 1) cs = (np >> 1) + 64 * (np & 1);
        else if (mapk == 2) { const int r = np & 63; cs = (np & 64) + (r >> 1) + 32 * (r & 1); }
        const float* t = T + (ch * 8) * 129 + cs;
        u32x4 o;
        o[0] = pk2(t[0], t[129]); o[1] = pk2(t[2 * 129], t[3 * 129]); o[2] = pk2(t[4 * 129], t[5 * 129]); o[3] = pk2(t[6 * 129], t[7 * 129]);
        *(u32x4*)(dst + (size_t)(n0 + np) * ldk + k0 + ch * 8) = o;
    }
}
DI void mod_item(const Ctx& c, int l, int jb) {
    float* sv = (float*)c.smem;
    float* red = sv + 9 * 1024;
    __syncthreads();
    for (int idx = c.tid; idx < 9216; idx += 256) {
        const int v = idx >> 10, k = idx & 1023;
        const float x = v < 8 ? c.c[v * 1024 + k] : c.c_ctx[k];
        sv[idx] = x / (1.f + expf(-x));
    }
    __syncthreads();
    const int kk = c.tid >> 5, jj = c.tid & 31, j = jb * 32 + jj;
    float a[9];
#pragma unroll
    for (int v = 0; v < 9; ++v) a[v] = 0.f;
    const float* wp = c.w_mod + (size_t)l * 1024 * 3072 + j;
#pragma unroll 4
    for (int i = 0; i < 128; ++i) {
        const int k = kk + 8 * i;
        const float wv = wp[(size_t)k * 3072];
#pragma unroll
        for (int v = 0; v < 9; ++v) a[v] += sv[v * 1024 + k] * wv;
    }
#pragma unroll
    for (int v = 0; v < 9; ++v) red[(kk * 9 + v) * 32 + jj] = a[v];
    __syncthreads();
    float* MOD = (float*)(c.ws + OFF_MOD);
    for (int idx = c.tid; idx < 288; idx += 256) {
        const int v = idx >> 5, j2 = idx & 31;
        float s = 0.f;
#pragma unroll
        for (int k2 = 0; k2 < 8; ++k2) s += red[(k2 * 9 + v) * 32 + j2];
        MOD[(size_t)(l * 9 + v) * 3072 + jb * 32 + j2] = s + c.b_mod[l * 3072 + jb * 32 + j2];
    }
}

DI void rope_item(const Ctx& c, int it) {
    constexpr float L2B = 13.287712379549449f;
    f32x2* T = (f32x2*)(c.ws + OFF_ROPE);
#pragma unroll 1
    for (int e = 0; e < 8; ++e) {
        const int idx = (it * 8 + e) * 256 + c.tid;
        const int lp = idx / 96, a = idx % 96;
        const float rowp = (float)(lp >> 6), colp = (float)(lp & 63);
        float ang;
        if (a < 64) { const int f = a & 31; ang = (a < 32 ? rowp : colp) * exp2f(-(float)f * (L2B / 32.f)); }
        else { const int a2 = a - 64, f = a2 & 15; ang = (a2 < 16 ? rowp : colp) * exp2f(-(float)f * (L2B / 16.f)); }
        f32x2 v; v[0] = cosf(ang); v[1] = sinf(ang);
        T[idx] = v;
    }
}
DI void p0_item(const Ctx& c, int it) {
    if (it < 2 * 1408) {
        const int l = it / 1408; int r = it % 1408;
        if (r < 1088) {
            const int ct = r % 68, kb = r / 68;
            const int kind = ct >> 2;
            const int mapk = (kind == 0 || kind == 4) ? 1 : ((kind == 2 || kind == 6) ? 2 : 0);
            transpose_item(c, c.w_in + (size_t)l * 1024 * INC, INC, kb * 64, ct * 128, mapk, (bf16_t*)(c.ws + OFF_WIN) + (size_t)l * INC * LDW, LDW);
            return;
        }
        r -= 1088;
        if (r < 192) {
            const int br = r / 64, q = r % 64, kb = q >> 3, nb = q & 7;
            transpose_item(c, c.w_bo + (size_t)(l * 3 + br) * 512 * 1024, 1024, kb * 64, nb * 128, 0,
                           (bf16_t*)(c.ws + OFF_WBO) + (size_t)(l * 3 + br) * 1024 * 512, 512);
            return;
        }
        r -= 192;
        { const int kb = r >> 3, nb = r & 7;
          transpose_item(c, c.w_out + (size_t)l * 1024 * 1024, 1024, kb * 64, nb * 128, 0, (bf16_t*)(c.ws + OFF_WO) + (size_t)l * 1024 * 1024, 1024); }
        return;
    }
    it -= 2 * 1408;
    mod_item(c, it / 96, it % 96);
}

DI void modulate_row(const f32x4 (&x)[4], const float* gpre, const float* mod  , bf16_t* hrow, int lane) {
    float ss = 0.f;
#pragma unroll
    for (int j = 0; j < 4; ++j) ss += x[j][0] * x[j][0] + x[j][1] * x[j][1] + x[j][2] * x[j][2] + x[j][3] * x[j][3];
    ss = wave_sum(ss);
    const float r = rsqrtf(ss * (1.f / 1024.f) + EPS);
    f32x4 gq[4], shq[4], scq[4];
#pragma unroll
    for (int j = 0; j < 4; ++j) { const int col = lane * 4 + 256 * j; gq[j] = *(const f32x4*)(gpre + col); shq[j] = *(const f32x4*)(mod + col); scq[j] = *(const f32x4*)(mod + 1024 + col); }
#pragma unroll
    for (int j = 0; j < 4; ++j) {
        const int col = lane * 4 + 256 * j;
        const f32x4 g = gq[j], sh = shq[j], sc = scq[j];
        f32x4 h;
#pragma unroll
        for (int e = 0; e < 4; ++e) h[e] = x[j][e] * r * g[e] * (1.f + sc[e]) + sh[e];
        u32x2 o; o[0] = pk2(h[0], h[1]); o[1] = pk2(h[2], h[3]);
        *(u32x2*)(hrow + col) = o;
    }
}
DI void ph_item(const Ctx& c, int g, int item) {
    const int tok = item * 4 + c.w, bl = tok / PP, p = tok % PP, b = g * NBG + bl;
    const float* src = p < CTXL ? c.ctx + ((size_t)b * CTXL + p) * DM : c.x + ((size_t)b * SEQL + (p - CTXL)) * DM;
    f32x4 x[4];
#pragma unroll
    for (int j = 0; j < 4; ++j) x[j] = __builtin_nontemporal_load((const f32x4*)(src + c.lane * 4 + 256 * j));
    const float* mod = (const float*)(c.ws + OFF_MOD) + (size_t)(0 * 9 + (p < CTXL ? 8 : b)) * 3072;
    modulate_row(x, c.g_pre, mod, (bf16_t*)(c.ws + OFF_H) + (size_t)tok * LDH, c.lane);
}
DI void pr_item(const Ctx& c, int l, int g, int item) {
    const int tok = item * 4 + c.w, bl = tok / PP, p = tok % PP, b = g * NBG + bl;
    if (l == 1 && p < CTXL) return;
    const float* orow = (const float*)(c.ws + OFF_OUT) + (size_t)tok * DM;
    const int v = p < CTXL ? 8 : b;
    const float* mod = (const float*)(c.ws + OFF_MOD) + (size_t)(l * 9 + v) * 3072;
    float* xo_lat = c.out + ((size_t)b * SEQL + (p - CTXL)) * DM;
    const float* xold = p < CTXL ? c.ctx + ((size_t)b * CTXL + p) * DM : (l == 0 ? c.x + ((size_t)b * SEQL + (p - CTXL)) * DM : xo_lat);
    f32x4 o[4], gpq[4], gtq[4], xvq[4]; float ss = 0.f;
#pragma unroll
    for (int j = 0; j < 4; ++j) {
        const int col = c.lane * 4 + 256 * j;
        o[j] = __builtin_nontemporal_load((const f32x4*)(orow + col)); gpq[j] = *(const f32x4*)(c.g_post + l * 1024 + col); gtq[j] = *(const f32x4*)(mod + 2048 + col); xvq[j] = *(const f32x4*)(xold + col);
    }
#pragma unroll
    for (int j = 0; j < 4; ++j) ss += o[j][0] * o[j][0] + o[j][1] * o[j][1] + o[j][2] * o[j][2] + o[j][3] * o[j][3];
    ss = wave_sum(ss);
    const float r = rsqrtf(ss * (1.f / 1024.f) + EPS);
    f32x4 xn[4];
#pragma unroll
    for (int j = 0; j < 4; ++j) {
        const int col = c.lane * 4 + 256 * j;
        const f32x4 gp = gpq[j], gt = gtq[j], xv = xvq[j];
#pragma unroll
        for (int e = 0; e < 4; ++e) xn[j][e] = xv[e] + gt[e] * (o[j][e] * r * gp[e]);
        if (p >= CTXL) *(f32x4*)(xo_lat + col) = xn[j];
    }
    if (l == 0) {
        const float* mod1 = (const float*)(c.ws + OFF_MOD) + (size_t)(1 * 9 + v) * 3072;
        modulate_row(xn, c.g_pre + 1024, mod1, (bf16_t*)(c.ws + OFF_H) + (size_t)tok * LDH, c.lane);
    }
}

DI void pz_item(const Ctx& c, int l, int rt2, int ct) {
    f32x16 acc[2][4];
    zero_acc2(acc);
    gemm_core2(c, (const bf16_t*)(c.ws + OFF_WIN) + ((size_t)l * INC + (size_t)ct * 128) * LDW, LDW,
               (const bf16_t*)(c.ws + OFF_H) + (size_t)rt2 * 256 * LDH, LDH, 1024, acc);
    const int wn = c.w >> 1, wm = c.w & 1;
    const int bl = rt2 / 9, pt2 = rt2 % 9;
    const int kind = ct >> 2, h = ct & 3;
    const bool roped = (kind == 0 || kind == 4 || kind == 2 || kind == 6);
    const bool retk = (kind == 0 || kind == 4);
    bf16_t* E = (bf16_t*)c.smem;
    constexpr int ES = 136, ETS = 264;
    const float rsc = kind == 0 ? 0.08838834764831845f : (kind == 6 ? 0.125f * LOG2E : 1.f);
    const bool latent = pt2 > 0;
    const bool mulx = (kind == 5 || kind == 7 || kind == 10);
#define XF_PLAIN  { v0 *= rsc; v1 *= rsc; v2 *= rsc; v3 *= rsc; }
#define XF_SIG    { v0 = fsig(v0); v1 = fsig(v1); v2 = fsig(v2); v3 = fsig(v3); }
#define XF_SILU   { v0 *= fsig(v0); v1 *= fsig(v1); v2 *= fsig(v2); v3 *= fsig(v3); }
#define PZ_STAGE(PASS, XF) \
    _Pragma("unroll") for (int j = 0; j < 4; ++j) { \
        const int m = wm * 128 + j * 32 + c.l31; \
        _Pragma("unroll") for (int i = 0; i < 2; ++i) \
        _Pragma("unroll") for (int q = 0; q < 4; ++q) { \
            const int n0 = wn * 64 + i * 32 + 8 * q + 4 * c.hl; \
            float v0 = acc[i][j][4 * q + 0], v1 = acc[i][j][4 * q + 1], v2 = acc[i][j][4 * q + 2], v3 = acc[i][j][4 * q + 3]; \
            XF \
            if (PASS == 0) { \
                u32x2 o; o[0] = pk2(v0, v1); o[1] = pk2(v2, v3); \
                *(u32x2*)(E + m * ES + n0) = o; \
            } else { \
                E[(n0 + 0) * ETS + m] = f2bf(v0); E[(n0 + 1) * ETS + m] = f2bf(v1); E[(n0 + 2) * ETS + m] = f2bf(v2); E[(n0 + 3) * ETS + m] = f2bf(v3); \
            } \
        } \
    }
    const int cls = roped ? (latent ? 0 : 1) : (kind >= 11 ? 2 : (mulx ? 3 : 1));
    const int nfq = retk ? 32 : 16;
    const float fsc = retk ? (13.287712379549449f / 32.f) : (13.287712379549449f / 16.f);
    if (cls == 0) {
        const int lbase = pt2 * 256 + wm * 128 - CTXL;
        const float rowA = (float)(lbase >> 6), colA = (float)c.l31;
#pragma unroll
        for (int i = 0; i < 2; ++i) {
            const bool rowpart = retk ? (wn == 0) : (i == 0);
            const float posA = rowpart ? rowA : colA;
            const float posB = rowpart ? rowA + 1.f : colA + 32.f;
#pragma unroll
            for (int q = 0; q < 4; ++q) {
                const int n0 = wn * 64 + i * 32 + 8 * q + 4 * c.hl;
                const int c0 = retk ? (n0 >> 1) : ((n0 & 63) >> 1);
                const float iv0 = __builtin_amdgcn_exp2f(-(float)(c0 & (nfq - 1)) * fsc) * 0.15915494309189535f;
                const float iv1 = __builtin_amdgcn_exp2f(-(float)((c0 + 1) & (nfq - 1)) * fsc) * 0.15915494309189535f;
#define ROPE_APPLY(POS, JA, JB) { float s0, c0f, s1, c1f; sincos_rev((POS) * iv0, s0, c0f); sincos_rev((POS) * iv1, s1, c1f); \
                    { const float v0 = acc[i][JA][4 * q + 0], v1 = acc[i][JA][4 * q + 1], v2 = acc[i][JA][4 * q + 2], v3 = acc[i][JA][4 * q + 3]; \
                      acc[i][JA][4 * q + 0] = v0 * c0f - v1 * s0; acc[i][JA][4 * q + 1] = v0 * s0 + v1 * c0f; acc[i][JA][4 * q + 2] = v2 * c1f - v3 * s1; acc[i][JA][4 * q + 3] = v2 * s1 + v3 * c1f; } \
                    { const float v0 = acc[i][JB][4 * q + 0], v1 = acc[i][JB][4 * q + 1], v2 = acc[i][JB][4 * q + 2], v3 = acc[i][JB][4 * q + 3]; \
                      acc[i][JB][4 * q + 0] = v0 * c0f - v1 * s0; acc[i][JB][4 * q + 1] = v0 * s0 + v1 * c0f; acc[i][JB][4 * q + 2] = v2 * c1f - v3 * s1; acc[i][JB][4 * q + 3] = v2 * s1 + v3 * c1f; } }
                if (rowpart) { ROPE_APPLY(posA, 0, 1) ROPE_APPLY(posB, 2, 3) }
                else { ROPE_APPLY(posA, 0, 2) ROPE_APPLY(posB, 1, 3) }
#undef ROPE_APPLY
            }
        }
    }
    if (kind != 1 && kind != 3) {
        if (cls <= 1) { PZ_STAGE(0, XF_PLAIN) }
        else if (cls == 2) { PZ_STAGE(0, XF_SIG) }
        else { PZ_STAGE(0, XF_SILU) }
        __syncthreads();
        bf16_t* dst; size_t ld;
        if (kind >= 11) { dst = (bf16_t*)(c.ws + OFF_MLOG) + (size_t)(ct - 44) * 128; ld = 3072; }
        else {
            size_t off;
            switch (kind) { case 0: off = OFF_RK; break; case 2: off = OFF_DK; break; case 4: off = OFF_RQ; break; case 5: off = OFF_RG; break;
                            case 6: off = OFF_DQ; break; case 7: off = OFF_DG; break; case 8: off = OFF_MU; break; case 9: off = OFF_MV; break; default: off = OFF_MG; break; }
            dst = (bf16_t*)(c.ws + off) + h * 128; ld = 512;
        }
        dst += (size_t)rt2 * 256 * ld;
#pragma unroll 4
        for (int it = 0; it < 16; ++it) {
            const int id = c.tid + 256 * it, row = id >> 4, seg = id & 15;
            *(u32x4*)(dst + (size_t)row * ld + seg * 8) = *(const u32x4*)(E + row * ES + seg * 8);
        }
    }
    if (kind == 0 || kind == 1 || kind == 3) {
        if (kind == 0) __syncthreads();
        PZ_STAGE(1, XF_PLAIN)
        __syncthreads();
        const size_t off = kind == 0 ? OFF_RKT : (kind == 1 ? OFF_RVT : OFF_DVT);
        bf16_t* dst = (bf16_t*)(c.ws + off) + (size_t)(bl * 4 + h) * 128 * PP + pt2 * 256;
#pragma unroll 4
        for (int it = 0; it < 16; ++it) {
            const int id = c.tid + 256 * it, n = id >> 5, seg = id & 31;
            *(u32x4*)(dst + (size_t)n * PP + seg * 8) = *(const u32x4*)(E + n * ETS + seg * 8);
        }
    }
    __builtin_amdgcn_s_setprio(0);
#undef PZ_STAGE
#undef XF_PLAIN
#undef XF_SIG
#undef XF_SILU
}

DI void attn_item(const Ctx& c, int l, int bl, int h, int q0, int nk) {
    bf16_t* Ks = (bf16_t*)c.smem;
    bf16_t* Vs = Ks + 64 * 136;
    const int mp = c.w >> 1, qs = c.w & 1;
    const int qpos = q0 + qs * 32 + c.l31;
    const size_t qtok = (size_t)bl * PP + qpos;
    const bf16_t* DQ = (const bf16_t*)(c.ws + OFF_DQ);
    const bf16_t* DK = (const bf16_t*)(c.ws + OFF_DK) + (size_t)bl * PP * 512 + h * 128;
    const bf16_t* DVT = (const bf16_t*)(c.ws + OFF_DVT) + (size_t)(bl * 4 + h) * 128 * PP;
    bf16x8 qf[4];
#pragma unroll
    for (int ks = 0; ks < 4; ++ks) qf[ks] = *(const bf16x8*)(DQ + qtok * 512 + h * 128 + mp * 64 + ks * 16 + c.hl * 8);
    f32x16 o[4];
#pragma unroll
    for (int et = 0; et < 4; ++et)
#pragma unroll
        for (int r = 0; r < 16; ++r) o[et][r] = 0.f;
    float mrun = -1e30f, lrun = 0.f;
    u32x4 rk[4], rv[4];
    constexpr int BUF = 64 * 136 + 128 * 68;
#define AT_LOAD(KT0) { _Pragma("unroll") for (int it = 0; it < 4; ++it) { const int idx = c.tid + 256 * it; \
        rk[it] = *(const u32x4*)(DK + (size_t)((KT0) + (idx >> 4)) * 512 + (idx & 15) * 8); \
        rv[it] = *(const u32x4*)(DVT + (size_t)(idx >> 3) * PP + (KT0) + (idx & 7) * 8); } }
#define AT_STORE(BP) { _Pragma("unroll") for (int it = 0; it < 4; ++it) { const int idx = c.tid + 256 * it; \
        *(u32x4*)((BP) + (idx >> 4) * 136 + (idx & 15) * 8) = rk[it]; \
        u32x2 lo2, hi2; lo2[0] = rv[it][0]; lo2[1] = rv[it][1]; hi2[0] = rv[it][2]; hi2[1] = rv[it][3]; \
        *(u32x2*)((BP) + 64 * 136 + (idx >> 3) * 68 + (idx & 7) * 8) = lo2; *(u32x2*)((BP) + 64 * 136 + (idx >> 3) * 68 + (idx & 7) * 8 + 4) = hi2; } }
    AT_LOAD(0)
    __syncthreads();
    AT_STORE(Ks)
    if (64 < nk) AT_LOAD(64)
    __syncthreads();
    for (int kt0 = 0; kt0 < nk; kt0 += 64) {
        const int cb = (kt0 >> 6) & 1;
        const bf16_t* Kc = Ks + cb * BUF;
        const bf16_t* Vc = Kc + 64 * 136;
        if (kt0 + 64 < nk) {
            AT_STORE(Ks + (cb ^ 1) * BUF)
            if (kt0 + 128 < nk) AT_LOAD(kt0 + 128)
        }
        f32x16 s[2];
#pragma unroll
        for (int kt = 0; kt < 2; ++kt) {
#pragma unroll
            for (int r = 0; r < 16; ++r) s[kt][r] = 0.f;
#pragma unroll
            for (int ks = 0; ks < 4; ++ks) {
                const bf16x8 a = *(const bf16x8*)(Kc + (kt * 32 + c.l31) * 136 + mp * 64 + ks * 16 + c.hl * 8);
                s[kt] = MFMA(a, qf[ks], s[kt]);
            }
        }
        float mx = s[0][0];
#pragma unroll
        for (int r = 0; r < 16; ++r) { mx = fmaxf(mx, s[0][r]); mx = fmaxf(mx, s[1][r]); }
        mx = fmaxf(mx, __shfl_xor(mx, 32));
        const float mold = mrun;
        const float mnew = fmaxf(mrun, mx);
        const float alpha = __builtin_amdgcn_exp2f(mrun - mnew);
        mrun = mnew;
        float lsum = 0.f;
#pragma unroll
        for (int kt = 0; kt < 2; ++kt)
#pragma unroll
            for (int r = 0; r < 16; ++r) { const float pv = __builtin_amdgcn_exp2f(s[kt][r] - mnew); s[kt][r] = pv; lsum += pv; }
        lrun = lrun * alpha + lsum;
        if (__any(mx > mold)) {
#pragma unroll
            for (int et = 0; et < 4; ++et)
#pragma unroll
                for (int r = 0; r < 16; ++r) o[et][r] *= alpha;
        }
#pragma unroll
        for (int kt = 0; kt < 2; ++kt) {
#pragma unroll
            for (int st = 0; st < 2; ++st) {
                u32x4 pp;
                pp[0] = pk2(s[kt][8 * st + 0], s[kt][8 * st + 1]); pp[1] = pk2(s[kt][8 * st + 2], s[kt][8 * st + 3]);
                pp[2] = pk2(s[kt][8 * st + 4], s[kt][8 * st + 5]); pp[3] = pk2(s[kt][8 * st + 6], s[kt][8 * st + 7]);
                const bf16x8 pf = __builtin_bit_cast(bf16x8, pp);
#pragma unroll
                for (int et = 0; et < 4; ++et) {
                    const bf16_t* vp = Vc + (et * 32 + c.l31) * 68 + kt * 32 + 16 * st + 4 * c.hl;
                    const u32x2 lo = *(const u32x2*)vp, hi = *(const u32x2*)(vp + 8);
                    u32x4 av; av[0] = lo[0]; av[1] = lo[1]; av[2] = hi[0]; av[3] = hi[1];
                    o[et] = MFMA(__builtin_bit_cast(bf16x8, av), pf, o[et]);
                }
            }
        }
        __syncthreads();
    }
#undef AT_LOAD
#undef AT_STORE
    const float ltot = lrun + __shfl_xor(lrun, 32);
    const float linv = 1.f / ltot;
    float* Oc = (float*)c.smem;
    if (mp == 1) {
#pragma unroll
        for (int et = 0; et < 4; ++et)
#pragma unroll
            for (int r = 0; r < 16; ++r) Oc[(qs * 128 + et * 32 + crow(r, c.hl)) * 32 + c.l31] = o[et][r] * linv;
    }
    __syncthreads();
    if (mp == 0) {
        const float lam = c.cst[l], lam_init = c.cst[2 + l];
        float ss = 0.f;
#pragma unroll
        for (int et = 0; et < 4; ++et)
#pragma unroll
            for (int r = 0; r < 16; ++r) {
                const float d = o[et][r] * linv - lam * Oc[(qs * 128 + et * 32 + crow(r, c.hl)) * 32 + c.l31];
                o[et][r] = d; ss += d * d;
            }
        ss += __shfl_xor(ss, 32);
        const float rn = rsqrtf(ss * (1.f / 128.f) + EPS) * (1.f - lam_init);
        const bf16_t* DG = (const bf16_t*)(c.ws + OFF_DG) + qtok * 512 + h * 128;
        bf16_t* OD = (bf16_t*)(c.ws + OFF_ODIFF) + qtok * 512 + h * 128;
#pragma unroll
        for (int et = 0; et < 4; ++et)
#pragma unroll
            for (int q = 0; q < 4; ++q) {
                const int e0 = et * 32 + 8 * q + 4 * c.hl;
                const u32x2 g = *(const u32x2*)(DG + e0);
                u32x2 ov;
                ov[0] = pk2(o[et][4 * q + 0] * rn * bflo(g[0]), o[et][4 * q + 1] * rn * bfhi(g[0]));
                ov[1] = pk2(o[et][4 * q + 2] * rn * bflo(g[1]), o[et][4 * q + 3] * rn * bfhi(g[1]));
                *(u32x2*)(OD + e0) = ov;
            }
    }
}

DI void scan_item(const Ctx& c, int l, int bl, int h, int dir, int es) {
    const float lg2 = c.cst[4 + l * 8 + dir * 4 + h];
    const float decayC = __builtin_amdgcn_exp2f(lg2 * 128.f);
    f32x16 st;
#pragma unroll
    for (int r = 0; r < 16; ++r) st[r] = 0.f;
    const bf16_t* vt = (const bf16_t*)(c.ws + OFF_RVT) + ((size_t)(bl * 4 + h) * 128 + es * 32 + c.l31) * PP;
    const bf16_t* kt = (const bf16_t*)(c.ws + OFF_RKT) + ((size_t)(bl * 4 + h) * 128 + c.w * 32 + c.l31) * PP;
    bf16_t* stbase = (bf16_t*)(c.ws + OFF_ST) + (size_t)(((bl * 4 + h) * 2 + dir) * NCH) * 16384;
#pragma unroll 1
    for (int step = 0; step < NCH; ++step) {
        const int m = dir == 0 ? step : (step < 2 ? 1 - step : 19 - step);
        bf16_t* sp = stbase + (size_t)m * 16384;
#pragma unroll
        for (int r = 0; r < 16; ++r) sp[(es * 32 + crow(r, c.hl)) * 128 + c.w * 32 + c.l31] = f2bf(st[r]);
        if (step == NCH - 1) break;
#pragma unroll
        for (int r = 0; r < 16; ++r) st[r] *= decayC;
#pragma unroll
        for (int ks = 0; ks < 8; ++ks) {
            const int j0 = ks * 16 + c.hl * 8;
            const u32x4 av = *(const u32x4*)(vt + m * 128 + j0);
            const u32x4 bv = *(const u32x4*)(kt + m * 128 + j0);
            u32x4 as;
#pragma unroll
            for (int e = 0; e < 4; ++e) {
                const int ja = j0 + 2 * e;
                const float e0 = dir == 0 ? (float)(127 - ja) : (float)ja;
                const float e1 = dir == 0 ? (float)(126 - ja) : (float)(ja + 1);
                const float w0 = __builtin_amdgcn_exp2f(lg2 * e0), w1 = __builtin_amdgcn_exp2f(lg2 * e1);
                as[e] = pk2(bflo(av[e]) * w0, bfhi(av[e]) * w1);
            }
            st = MFMA(__builtin_bit_cast(bf16x8, as), __builtin_bit_cast(bf16x8, bv), st);
        }
    }
}

DI void mlp_item(const Ctx& c, int l, int bl, int m, int g) {
    bf16_t* Vn = (bf16_t*)c.smem;
    bf16_t* Wsm = Vn + 128 * 136;
    float* stat = (float*)(Wsm + 128 * 136);
    const size_t tok0 = (size_t)bl * PP + m * 128;
    const bf16_t* MV = (const bf16_t*)(c.ws + OFF_MV);
    __syncthreads();
#pragma unroll 1
    for (int rb = 0; rb < 4; ++rb) {
        u32x4 vv[8];
#pragma unroll
        for (int r8 = 0; r8 < 8; ++r8) vv[r8] = *(const u32x4*)(MV + (tok0 + c.w * 32 + rb * 8 + r8) * 512 + c.lane * 8);
#pragma unroll
        for (int r8 = 0; r8 < 8; ++r8) {
            const int row = c.w * 32 + rb * 8 + r8;
            float xv[8];
#pragma unroll
            for (int e = 0; e < 4; ++e) { xv[2 * e] = bflo(vv[r8][e]); xv[2 * e + 1] = bfhi(vv[r8][e]); }
            float sm = 0.f;
#pragma unroll
            for (int e = 0; e < 8; ++e) sm += xv[e];
            sm = wave_sum(sm);
            const float mu = sm * (1.f / 512.f);
            float ss = 0.f;
#pragma unroll
            for (int e = 0; e < 8; ++e) { const float d = xv[e] - mu; ss += d * d; }
            ss = wave_sum(ss);
            if (c.lane == 0) { stat[row] = mu; stat[128 + row] = rsqrtf(ss * (1.f / 512.f) + EPS); }
        }
    }
    __syncthreads();
    {
        u32x4 tv[8];
#pragma unroll
        for (int it = 0; it < 8; ++it) { const int idx = c.tid + 256 * it; tv[it] = *(const u32x4*)(MV + (tok0 + (idx >> 4)) * 512 + g * 128 + (idx & 15) * 8); }
#pragma unroll
        for (int it = 0; it < 8; ++it) {
            const int idx = c.tid + 256 * it, j = idx >> 4, seg = idx & 15;
            const float mu = stat[j], rs = stat[128 + j];
#pragma unroll
            for (int e = 0; e < 4; ++e) {
                Vn[(seg * 8 + 2 * e) * 136 + j] = f2bf((bflo(tv[it][e]) - mu) * rs);
                Vn[(seg * 8 + 2 * e + 1) * 136 + j] = f2bf((bfhi(tv[it][e]) - mu) * rs);
            }
        }
    }
    {
        const float* wsrc = c.w_s + (size_t)(l * 4 + g) * 128 * 128;
#pragma unroll 1
        for (int hb = 0; hb < 2; ++hb) {
            f32x4 wv[8];
#pragma unroll
            for (int it = 0; it < 8; ++it) { const int idx = c.tid + 256 * (hb * 8 + it); wv[it] = *(const f32x4*)(wsrc + (idx >> 5) * 128 + (idx & 31) * 4); }
#pragma unroll
            for (int it = 0; it < 8; ++it) {
                const int idx = c.tid + 256 * (hb * 8 + it);
                u32x2 o; o[0] = pk2(wv[it][0], wv[it][1]); o[1] = pk2(wv[it][2], wv[it][3]);
                *(u32x2*)(Wsm + (idx >> 5) * 136 + (idx & 31) * 4) = o;
            }
        }
    }
    __syncthreads();
    const int wc = c.w >> 1, wi = c.w & 1;
    f32x16 acc[2][2];
    zero_acc(acc);
#pragma unroll
    for (int ks = 0; ks < 8; ++ks) {
        const bf16x8 a0 = *(const bf16x8*)(Vn + (wc * 64 + c.l31) * 136 + ks * 16 + c.hl * 8);
        const bf16x8 a1 = *(const bf16x8*)(Vn + (wc * 64 + 32 + c.l31) * 136 + ks * 16 + c.hl * 8);
        const bf16x8 b0 = *(const bf16x8*)(Wsm + (wi * 64 + c.l31) * 136 + ks * 16 + c.hl * 8);
        const bf16x8 b1 = *(const bf16x8*)(Wsm + (wi * 64 + 32 + c.l31) * 136 + ks * 16 + c.hl * 8);
        acc[0][0] = MFMA(a0, b0, acc[0][0]); acc[0][1] = MFMA(a0, b1, acc[0][1]);
        acc[1][0] = MFMA(a1, b0, acc[1][0]); acc[1][1] = MFMA(a1, b1, acc[1][1]);
    }
    const bf16_t* MU = (const bf16_t*)(c.ws + OFF_MU);
    const bf16_t* MG = (const bf16_t*)(c.ws + OFF_MG);
    bf16_t* OM = (bf16_t*)(c.ws + OFF_OMLP);
    u32x2 uq[2][2][4], gq[2][2][4];
    float bsq[2];
#pragma unroll
    for (int ii = 0; ii < 2; ++ii) {
        const int i = wi * 64 + ii * 32 + c.l31;
        const size_t tok = tok0 + i;
        bsq[ii] = c.b_s[(l * 4 + g) * 128 + i];
#pragma unroll
        for (int ci = 0; ci < 2; ++ci)
#pragma unroll
            for (int q = 0; q < 4; ++q) {
                const int c0 = g * 128 + wc * 64 + ci * 32 + 8 * q + 4 * c.hl;
                uq[ii][ci][q] = *(const u32x2*)(MU + tok * 512 + c0); gq[ii][ci][q] = *(const u32x2*)(MG + tok * 512 + c0);
            }
    }
#pragma unroll
    for (int ii = 0; ii < 2; ++ii) {
        const int i = wi * 64 + ii * 32 + c.l31;
        const size_t tok = tok0 + i;
        const float bs = bsq[ii];
#pragma unroll
        for (int ci = 0; ci < 2; ++ci)
#pragma unroll
            for (int q = 0; q < 4; ++q) {
                const int c0 = g * 128 + wc * 64 + ci * 32 + 8 * q + 4 * c.hl;
                const u32x2 u = uq[ii][ci][q], gg = gq[ii][ci][q];
                u32x2 ov;
                ov[0] = pk2(bflo(u[0]) * (acc[ci][ii][4 * q + 0] + bs) * bflo(gg[0]), bfhi(u[0]) * (acc[ci][ii][4 * q + 1] + bs) * bfhi(gg[0]));
                ov[1] = pk2(bflo(u[1]) * (acc[ci][ii][4 * q + 2] + bs) * bflo(gg[1]), bfhi(u[1]) * (acc[ci][ii][4 * q + 3] + bs) * bfhi(gg[1]));
                *(u32x2*)(OM + tok * 512 + c0) = ov;
            }
    }
}

DI void retout_item(const Ctx& c, int l, int bl, int h, int m) {
    bf16_t* Ks = (bf16_t*)c.smem;
    bf16_t* Vs = Ks + 128 * 136;
    const size_t tok0 = (size_t)bl * PP + m * 128;
    const bf16_t* RK = (const bf16_t*)(c.ws + OFF_RK) + tok0 * 512 + h * 128;
    const bf16_t* RVT = (const bf16_t*)(c.ws + OFF_RVT) + (size_t)(bl * 4 + h) * 128 * PP + m * 128;
    __syncthreads();
    {
        u32x4 tk[8], tv[8];
#pragma unroll
        for (int it = 0; it < 8; ++it) {
            const int idx = c.tid + 256 * it, row = idx >> 4, seg = idx & 15;
            tk[it] = *(const u32x4*)(RK + (size_t)row * 512 + seg * 8);
            tv[it] = *(const u32x4*)(RVT + (size_t)row * PP + seg * 8);
        }
#pragma unroll
        for (int it = 0; it < 8; ++it) {
            const int idx = c.tid + 256 * it, row = idx >> 4, seg = idx & 15;
            *(u32x4*)(Ks + row * 136 + seg * 8) = tk[it];
            u32x2 lo2, hi2; lo2[0] = tv[it][0]; lo2[1] = tv[it][1]; hi2[0] = tv[it][2]; hi2[1] = tv[it][3];
            *(u32x2*)(Vs + row * 132 + seg * 8) = lo2; *(u32x2*)(Vs + row * 132 + seg * 8 + 4) = hi2;
        }
    }
    __syncthreads();
    const int i = c.w * 32 + c.l31;
    const size_t tok = tok0 + i;
    const float lgf = c.cst[4 + l * 8 + h], lgb = c.cst[4 + l * 8 + 4 + h];
    bf16x8 qf[8];
    const bf16_t* RQ = (const bf16_t*)(c.ws + OFF_RQ) + tok * 512 + h * 128;
#pragma unroll
    for (int ks = 0; ks < 8; ++ks) qf[ks] = *(const bf16x8*)(RQ + ks * 16 + c.hl * 8);
    f32x16 o[4];
    const bf16_t* stf = (const bf16_t*)(c.ws + OFF_ST) + (size_t)(((bl * 4 + h) * 2 + 0) * NCH + m) * 16384;
    const bf16_t* stb = (const bf16_t*)(c.ws + OFF_ST) + (size_t)(((bl * 4 + h) * 2 + 1) * NCH + m) * 16384;
    const float qdf = __builtin_amdgcn_exp2f(lgf * (float)(i + 1)), qdb = __builtin_amdgcn_exp2f(lgb * (float)(128 - i));
#pragma unroll
    for (int et = 0; et < 4; ++et) {
        f32x16 tf, tb;
#pragma unroll
        for (int r = 0; r < 16; ++r) { tf[r] = 0.f; tb[r] = 0.f; }
        bf16x8 sa[8], sb[8];
#pragma unroll
        for (int ks = 0; ks < 8; ++ks) {
            sa[ks] = *(const bf16x8*)(stf + (et * 32 + c.l31) * 128 + ks * 16 + c.hl * 8);
            sb[ks] = *(const bf16x8*)(stb + (et * 32 + c.l31) * 128 + ks * 16 + c.hl * 8);
        }
#pragma unroll
        for (int ks = 0; ks < 8; ++ks) {
            tf = MFMA(sa[ks], qf[ks], tf);
            tb = MFMA(sb[ks], qf[ks], tb);
        }
#pragma unroll
        for (int r = 0; r < 16; ++r) o[et][r] = tf[r] * qdf + tb[r] * qdb;
        __builtin_amdgcn_sched_barrier(0);
    }
#pragma unroll
    for (int jt = 0; jt < 4; ++jt) {
        f32x16 sc;
#pragma unroll
        for (int r = 0; r < 16; ++r) sc[r] = 0.f;
#pragma unroll
        for (int ks = 0; ks < 8; ++ks) {
            const bf16x8 a = *(const bf16x8*)(Ks + (jt * 32 + c.l31) * 136 + ks * 16 + c.hl * 8);
            sc = MFMA(a, qf[ks], sc);
        }
#pragma unroll
        for (int r = 0; r < 16; ++r) {
            const int j = jt * 32 + crow(r, c.hl);
            const int dl = i - j;
            const float arg = dl > 0 ? lgf * (float)dl : -lgb * (float)dl;
            float f = __builtin_amdgcn_exp2f(arg);
            f = dl == 0 ? 2.f : f;
            sc[r] *= f;
        }
#pragma unroll
        for (int s2 = 0; s2 < 2; ++s2) {
            u32x4 pp;
            pp[0] = pk2(sc[8 * s2 + 0], sc[8 * s2 + 1]); pp[1] = pk2(sc[8 * s2 + 2], sc[8 * s2 + 3]);
            pp[2] = pk2(sc[8 * s2 + 4], sc[8 * s2 + 5]); pp[3] = pk2(sc[8 * s2 + 6], sc[8 * s2 + 7]);
            const bf16x8 pf = __builtin_bit_cast(bf16x8, pp);
#pragma unroll
            for (int et = 0; et < 4; ++et) {
                const bf16_t* vp = Vs + (et * 32 + c.l31) * 132 + jt * 32 + 16 * s2 + 4 * c.hl;
                const u32x2 lo = *(const u32x2*)vp, hi = *(const u32x2*)(vp + 8);
                u32x4 av; av[0] = lo[0]; av[1] = lo[1]; av[2] = hi[0]; av[3] = hi[1];
                o[et] = MFMA(__builtin_bit_cast(bf16x8, av), pf, o[et]);
            }
        }
        __builtin_amdgcn_sched_barrier(0);
    }
    float ss = 0.f;
#pragma unroll
    for (int et = 0; et < 4; ++et)
#pragma unroll
        for (int r = 0; r < 16; ++r) ss += o[et][r] * o[et][r];
    ss += __shfl_xor(ss, 32);
    const float rn = rsqrtf(ss * (1.f / 128.f) + EPS);
    const bf16_t* RG = (const bf16_t*)(c.ws + OFF_RG) + tok * 512 + h * 128;
    bf16_t* OR = (bf16_t*)(c.ws + OFF_ORET) + tok * 512 + h * 128;
#pragma unroll
    for (int et = 0; et < 4; ++et)
#pragma unroll
        for (int q = 0; q < 4; ++q) {
            const int e0 = et * 32 + 8 * q + 4 * c.hl;
            const u32x2 g = *(const u32x2*)(RG + e0);
            u32x2 ov;
            ov[0] = pk2(o[et][4 * q + 0] * rn * bflo(g[0]), o[et][4 * q + 1] * rn * bfhi(g[0]));
            ov[1] = pk2(o[et][4 * q + 2] * rn * bflo(g[1]), o[et][4 * q + 3] * rn * bfhi(g[1]));
            *(u32x2*)(OR + e0) = ov;
        }
}

DI void pm_item(const Ctx& c, int l, int rt, int nt) {
    f32x16 y[2][2], acc[2][2];
    zero_acc(y);
    const int wn = c.w >> 1, wm = c.w & 1;
    const bf16_t* MLOG = (const bf16_t*)(c.ws + OFF_MLOG);
#pragma unroll 1
    for (int br = 0; br < 3; ++br) {
        const size_t ooff = br == 0 ? OFF_ORET : (br == 1 ? OFF_OMLP : OFF_ODIFF);
        zero_acc(acc);
        gemm_core(c, (const bf16_t*)(c.ws + OFF_WBO) + ((size_t)(l * 3 + br) * 1024 + (size_t)nt * 128) * 512, 512,
                  (const bf16_t*)(c.ws + ooff) + (size_t)rt * 128 * 512, 512, 512, acc);
#pragma unroll
        for (int j = 0; j < 2; ++j) {
            const size_t tok = (size_t)rt * 128 + wm * 64 + j * 32 + c.l31;
#pragma unroll
            for (int i = 0; i < 2; ++i)
#pragma unroll
                for (int q = 0; q < 4; ++q) {
                    const int n0 = nt * 128 + wn * 64 + i * 32 + 8 * q + 4 * c.hl;
                    const u32x2 g = *(const u32x2*)(MLOG + tok * 3072 + br * 1024 + n0);
                    y[i][j][4 * q + 0] += bflo(g[0]) * acc[i][j][4 * q + 0];
                    y[i][j][4 * q + 1] += bfhi(g[0]) * acc[i][j][4 * q + 1];
                    y[i][j][4 * q + 2] += bflo(g[1]) * acc[i][j][4 * q + 2];
                    y[i][j][4 * q + 3] += bfhi(g[1]) * acc[i][j][4 * q + 3];
                }
        }
    }
    bf16_t* Y = (bf16_t*)(c.ws + OFF_Y);
#pragma unroll
    for (int j = 0; j < 2; ++j) {
        const size_t tok = (size_t)rt * 128 + wm * 64 + j * 32 + c.l31;
#pragma unroll
        for (int i = 0; i < 2; ++i)
#pragma unroll
            for (int q = 0; q < 4; ++q) {
                const int n0 = nt * 128 + wn * 64 + i * 32 + 8 * q + 4 * c.hl;
                u32x2 ov; ov[0] = pk2(y[i][j][4 * q + 0], y[i][j][4 * q + 1]); ov[1] = pk2(y[i][j][4 * q + 2], y[i][j][4 * q + 3]);
                *(u32x2*)(Y + tok * 1024 + n0) = ov;
            }
    }
}
DI void po_item(const Ctx& c, int l, int rt2, int nt) {
    f32x16 acc[2][4];
    zero_acc2(acc);
    gemm_core2(c, (const bf16_t*)(c.ws + OFF_WO) + ((size_t)l * 1024 + (size_t)nt * 128) * 1024, 1024,
               (const bf16_t*)(c.ws + OFF_Y) + (size_t)rt2 * 256 * 1024, 1024, 1024, acc);
    const int wn = c.w >> 1, wm = c.w & 1;
    float* OUT = (float*)(c.ws + OFF_OUT);
#pragma unroll
    for (int j = 0; j < 4; ++j) {
        const size_t tok = (size_t)rt2 * 256 + wm * 128 + j * 32 + c.l31;
#pragma unroll
        for (int i = 0; i < 2; ++i)
#pragma unroll
            for (int q = 0; q < 4; ++q) {
                const int n0 = nt * 128 + wn * 64 + i * 32 + 8 * q + 4 * c.hl;
                f32x4 ov; ov[0] = acc[i][j][4 * q + 0]; ov[1] = acc[i][j][4 * q + 1]; ov[2] = acc[i][j][4 * q + 2]; ov[3] = acc[i][j][4 * q + 3];
                *(f32x4*)(OUT + tok * 1024 + n0) = ov;
            }
    }
}

extern __shared__ __attribute__((aligned(16))) unsigned char dynsmem[];
constexpr int LDS_BYTES = 72 * 1024;

DI Ctx mk_ctx(const Params& p, const float* cst, int wv) {
    Ctx c;
    c.x = p.in[0]; c.c = p.in[1]; c.ctx = p.in[2]; c.c_ctx = p.in[3]; c.w_mod = p.in[4]; c.b_mod = p.in[5]; c.g_pre = p.in[6]; c.g_post = p.in[7];
    c.w_in = p.in[8]; c.decay = p.in[9]; c.w_s = p.in[10]; c.b_s = p.in[11]; c.lq = p.in[12]; c.lk = p.in[13]; c.w_bo = p.in[14]; c.w_out = p.in[15];
    c.out = p.out; c.ws = p.ws; c.smem = dynsmem; c.cst = cst;
    unsigned zl = 0u;
    asm volatile("" : "+v"(zl));
    int tid = wv * 64 + (int)__builtin_amdgcn_mbcnt_hi(~0u, __builtin_amdgcn_mbcnt_lo(~0u, zl));
    asm volatile("" : "+v"(tid));
    size_t zoff = 0;
    asm volatile("" : "+s"(zoff));
    c.ws = p.ws + zoff;
    c.tid = tid; c.lane = tid & 63; c.w = tid >> 6; c.l31 = c.lane & 31; c.hl = c.lane >> 5;
    return c;
}
DI void relaunder(Ctx& c) {
    int t = c.tid;
    asm volatile("" : "+v"(t));
    c.tid = t; c.lane = t & 63; c.w = t >> 6; c.l31 = c.lane & 31; c.hl = c.lane >> 5;
}

__global__ void __launch_bounds__(256, 2) mega(Params p) {
    __shared__ uint4 xbw;
    __shared__ float cst[32];
    const int wv = __builtin_amdgcn_readfirstlane((int)threadIdx.x >> 6);
    Ctx c = mk_ctx(p, cst, wv);
    if (c.tid == 0) xbw = make_uint4(0u, 0u, 0u, 0u);
    if (c.tid < 64) {
        for (int l = 0; l < 2; ++l) {
            float a = c.lq[(l * 2 + 0) * 64 + c.tid] * c.lk[(l * 2 + 0) * 64 + c.tid];
            float b = c.lq[(l * 2 + 1) * 64 + c.tid] * c.lk[(l * 2 + 1) * 64 + c.tid];
            a = wave_sum(a); b = wave_sum(b);
            const float lam_init = 0.8f - 0.6f * expf(-0.3f * (float)l);
            if (c.tid == 0) { cst[l] = expf(a) - expf(b) + lam_init; cst[2 + l] = lam_init; }
        }
        if (c.tid < 16) {
            const float z = c.decay[c.tid];
            cst[4 + c.tid] = -log1pf(expf(-z)) * LOG2E;
        }
    }
    __syncthreads();
    XcdBarrier bar = xcd_barrier_post((unsigned*)(p.ws + OFF_BAR), (volatile LAS unsigned*)&xbw, c.tid == 0);
    const int G = gridDim.x, bid = blockIdx.x;
    constexpr int NPH = 2 + NGRP * 12;
#pragma unroll 1
    for (int ph = 0; ph < NPH; ++ph) {
        c = mk_ctx(p, cst, wv);
        int kind, g = 0, l = 0;
        if (ph == 0) kind = 0;
        else if (ph == 1) kind = 1;
        else { const int q = ph - 2; g = q / 12; const int r = q % 12; l = r / 6; kind = 2 + r % 6; }
#ifndef ECHO_KIND
#define ECHO_KIND -1
#endif
        const unsigned long long tph0 = (ECHO_KIND >= 0) ? __builtin_amdgcn_s_memrealtime() : 0ull;
        switch (kind) {
        case 0:
#pragma unroll 1
            for (int it = bid; it < 2 * 1408 + 192; it += G) { relaunder(c); p0_item(c, it); }
            break;
        case 1:
#pragma unroll 1
            for (int it = bid; it < NT / 4; it += G) { relaunder(c); ph_item(c, g, it); }
            break;
        case 2:
            if ((G & 7) == 0) {
                const int x = bid & 7, jl = bid >> 3, GL = G >> 3;
#pragma unroll 1
                for (int k = jl; k < 306; k += GL) {
                    int ct, rt2;
                    if (k < 288) { ct = 8 * (k & 7) + x; rt2 = k >> 3; }
                    else { ct = 64 + (x >> 1); rt2 = (x & 1) * 18 + (k - 288); }
                    if (l == 1 && (rt2 % 9) == 0 && ct >= 16) continue;
                    relaunder(c);
                    pz_item(c, l, rt2, ct);
                }
            } else {
#pragma unroll 1
                for (int it = bid; it < 36 * 68; it += G) {
                    const int ct = it % 68, rt2 = it / 68;
                    if (l == 1 && (rt2 % 9) == 0 && ct >= 16) continue;
                    relaunder(c);
                    pz_item(c, l, rt2, ct);
                }
            }
            break;
        case 3: {
            const int n_att = 512, n_catt = (l == 0) ? 64 : 0, n_scan = 128, n_mlp = (l == 0) ? 288 : 256;
            const int total = n_att + n_catt + n_scan + n_mlp;
#pragma unroll 1
            for (int it = bid; it < total; it += G) {
                int r = it;
                relaunder(c);
                if (r < n_att + n_catt) {
                    int bl, h, q0, nk;
                    if (r < n_att) {
                        int pr, qb;
                        if ((G & 7) == 0) { const int x = r & 7, k = r >> 3; pr = 2 * x + (k >> 5); qb = k & 31; } else { pr = r >> 5; qb = r & 31; }
                        bl = pr >> 2; h = pr & 3; q0 = CTXL + qb * 64; nk = PP;
                    }
                    else { r -= n_att; bl = r >> 4; h = (r >> 2) & 3; q0 = (r & 3) * 64; nk = CTXL; }
                    attn_item(c, l, bl, h, q0, nk);
                    continue;
                }
                r -= n_att + n_catt;
                if (r < n_scan) {
                    int pr, sub;
                    if ((G & 7) == 0) { const int x = r & 7, k = r >> 3; pr = 2 * x + (k >> 3); sub = k & 7; } else { pr = r >> 3; sub = r & 7; }
                    scan_item(c, l, pr >> 2, pr & 3, sub >> 2, sub & 3); continue;
                }
                r -= n_scan;
                int bl, m, gg;
                int grp;
                if ((G & 7) == 0) { const int x = r & 7, k = r >> 3; grp = x + 8 * (k >> 2); gg = k & 3; } else { grp = r >> 2; gg = r & 3; }
                if (l == 0) { bl = grp / 18; m = grp % 18; }
                else { bl = grp >> 4; m = 2 + (grp & 15); }
                mlp_item(c, l, bl, m, gg);
            }
            break; }
        case 4: {
            const int total = (l == 0) ? 288 : 256;
#pragma unroll 1
            for (int it = bid; it < total; it += G) {
                int bl, m, h;
                if (l == 0) { bl = it / 72; const int q = it % 72; h = q & 3; m = q >> 2; }
                else { bl = it >> 6; const int q = it & 63; h = q & 3; m = 2 + (q >> 2); }
                relaunder(c);
                retout_item(c, l, bl, h, m);
            }
            break; }
        case 5: {
            const int nrt = (l == 0) ? 72 : 64;
#pragma unroll 1
            for (int it = bid; it < nrt * 8; it += G) {
                const int nt = it & 7, rr = it >> 3;
                const int rt = (l == 0) ? rr : (rr >> 4) * NCH + 2 + (rr & 15);
                relaunder(c);
                pm_item(c, l, rt, nt);
            }
            break; }
        case 6: {
            const int nrt = (l == 0) ? 72 : 64;
#pragma unroll 1
            for (int it0 = bid; it0 < (nrt / 2) * 8; it0 += G) {
                int nt = it0 & 7, rr = it0 >> 3;
                if ((G & 7) == 0) {
                    const int x = it0 & 7, k = it0 >> 3;
                    if (k < 32) { rr = x + 8 * (k >> 3); nt = k & 7; }
                    else { rr = 32 + (x >> 1); nt = (x & 1) * 4 + (k - 32); }
                }
                const int rt2 = (l == 0) ? rr : (rr >> 3) * 9 + 1 + (rr & 7);
                relaunder(c);
                po_item(c, l, rt2, nt);
            }
            break; }
        default:
#pragma unroll 1
            for (int it = bid; it < NT / 4; it += G) { relaunder(c); pr_item(c, l, g, it); }
            if (g + 1 < NGRP && l == 1) {
#pragma unroll 1
                for (int it = bid; it < NT / 4; it += G) { relaunder(c); ph_item(c, g + 1, it); }
            }
            break;
        }
        if (ECHO_KIND >= 0 && kind == ECHO_KIND) { __syncthreads(); const unsigned long long tb = __builtin_amdgcn_s_memrealtime(), dt = tb - tph0; while (__builtin_amdgcn_s_memrealtime() - tb < dt) __builtin_amdgcn_s_sleep(8); }
        if (ph + 1 < NPH) xcd_barrier(bar, c.tid == 0);
    }
}

extern "C" void kernel_launch(void* const* d_in, const int* in_sizes, int n_in, void* d_out, int out_size, void* d_ws, size_t ws_size, hipStream_t stream) {
    static int grid = 0;
    if (grid == 0) {
        int dev = 0, cus = 0, per_cu = 0;
        hipGetDevice(&dev);
        hipDeviceGetAttribute(&cus, hipDeviceAttributeMultiprocessorCount, dev);
        hipFuncSetAttribute((const void*)mega, hipFuncAttributeMaxDynamicSharedMemorySize, LDS_BYTES);
        hipOccupancyMaxActiveBlocksPerMultiprocessor(&per_cu, (const void*)mega, 256, LDS_BYTES);
        if (per_cu > 2) per_cu = 2;
        if (per_cu < 1) per_cu = 1;
        grid = cus * per_cu;
        if (ws_size < WS_END) { fprintf(stderr, "workspace too small: %zu < %zu\n", ws_size, (size_t)WS_END); grid = -1; }
    }
    if (grid < 0) return;
    hipMemsetAsync((unsigned char*)d_ws + OFF_BAR, 0, XCD_BAR_WORDS * 4, stream);
    Params p{};
    for (int i = 0; i < 16; ++i) p.in[i] = (const float*)d_in[i];
    p.out = (float*)d_out; p.ws = (unsigned char*)d_ws;
    void* args[] = {&p};
    hipError_t e = hipLaunchCooperativeKernel((const void*)mega, dim3(grid), dim3(256), args, LDS_BYTES, stream);
    if (e != hipSuccess) fprintf(stderr, "cooperative launch failed: %s (grid %d)\n", hipGetErrorString(e), grid);
}
```
